# Optimizing an MI355X kernel written in HIP

```python
import jax, jax.numpy as jnp
from jax import lax
import numpy as np

D_MODEL = 1024
BATCH = 32
SEQ = 2048
DEPTH = 1

D_PLE = 256
HEAD_DIM = 64
ROPE_DIM = HEAD_DIM // 4
ROPE_THETA = 500000.0
N_HEADS_A = 8
N_HEADS_B = 8
WIDTH_A = N_HEADS_A * HEAD_DIM
WIDTH_B = N_HEADS_B * HEAD_DIM
N_IDX_HEADS = 8
IDX_DIM = 64
TOPK_MAX = 256
Q_BLOCK = 128
EPS = 1e-6
NEG = -1e30

SPLITS = (WIDTH_A, HEAD_DIM, HEAD_DIM, WIDTH_A,
          N_IDX_HEADS * IDX_DIM, IDX_DIM, N_IDX_HEADS,
          WIDTH_B, WIDTH_B, WIDTH_B, N_HEADS_B, WIDTH_B)
D_IN = sum(SPLITS)

kernel_name = "hybrid_dsa_fox_gated_block"


def _offsets():
    offs, acc = [], 0
    for w in SPLITS[:-1]:
        acc += w
        offs.append(acc)
    return offs


def rmsnorm(x, g):
    xf = x.astype(jnp.float32)
    y = xf * lax.rsqrt(jnp.mean(xf * xf, axis=-1, keepdims=True) + EPS) * g.astype(jnp.float32)
    return y.astype(x.dtype)


def partial_rope(x, pos):
    half = ROPE_DIM // 2
    freqs = ROPE_THETA ** (-jnp.arange(half, dtype=jnp.float32) / half)
    ang = pos.astype(jnp.float32)[:, None] * freqs[None, :]
    cos = jnp.cos(ang)[None, :, None, :]
    sin = jnp.sin(ang)[None, :, None, :]
    x1 = x[..., :half].astype(jnp.float32)
    x2 = x[..., half:ROPE_DIM].astype(jnp.float32)
    rot = jnp.concatenate([x1 * cos - x2 * sin, x2 * cos + x1 * sin], axis=-1).astype(x.dtype)
    return jnp.concatenate([rot, x[..., ROPE_DIM:]], axis=-1)


def to_blocks(t):
    B, S = t.shape[:2]
    t = t.reshape((B, S // Q_BLOCK, Q_BLOCK) + t.shape[2:])
    return jnp.moveaxis(t, 1, 0)


def from_blocks(t):
    t = jnp.moveaxis(t, 0, 1)
    return t.reshape((t.shape[0], t.shape[1] * t.shape[2]) + t.shape[3:])


def dsa_branch(qa, ka, va, qi, ki, wi):
    B, S = ka.shape[:2]
    topk = min(TOPK_MAX, S // 4)
    nb = S // Q_BLOCK
    key_pos = jnp.arange(S)
    scale = HEAD_DIM ** -0.5

    def block(args):
        blk, q_blk, qi_blk, wi_blk = args
        q_pos = blk * Q_BLOCK + jnp.arange(Q_BLOCK)
        causal = key_pos[None, :] <= q_pos[:, None]
        dots = jnp.einsum('bqhd,bsd->bqhs', qi_blk, ki)
        score = jnp.einsum('bqhs,bqh->bqs', jax.nn.relu(dots).astype(jnp.float32),
                           wi_blk.astype(jnp.float32))
        score = jnp.where(causal[None], score, -jnp.inf)
        _, sel = lax.top_k(score, topk)
        k_sel = jax.vmap(lambda k, i: k[i])(ka, sel)
        v_sel = jax.vmap(lambda v, i: v[i])(va, sel)
        logits = jnp.einsum('bqhd,bqkd->bhqk', q_blk, k_sel).astype(jnp.float32) * scale
        valid = sel <= q_pos[None, :, None]
        logits = jnp.where(valid[:, None], logits, NEG)
        probs = jax.nn.softmax(logits, axis=-1).astype(v_sel.dtype)
        return jnp.einsum('bhqk,bqkd->bqhd', probs, v_sel)

    out = lax.map(block, (jnp.arange(nb), to_blocks(qa), to_blocks(qi), to_blocks(wi)))
    return from_blocks(out)


def fox_branch(qb, kb, vb, log_f):
    B, S = qb.shape[:2]
    nb = S // Q_BLOCK
    key_pos = jnp.arange(S)
    scale = HEAD_DIM ** -0.5
    c = jnp.cumsum(log_f, axis=1)
    c_k = jnp.transpose(c, (0, 2, 1))

    def block(args):
        blk, q_blk, cq_blk = args
        q_pos = blk * Q_BLOCK + jnp.arange(Q_BLOCK)
        causal = key_pos[None, :] <= q_pos[:, None]
        logits = jnp.einsum('bqhd,bshd->bhqs', q_blk, kb).astype(jnp.float32) * scale
        logits = logits + jnp.transpose(cq_blk, (0, 2, 1))[..., None] - c_k[:, :, None, :]
        logits = jnp.where(causal[None, None], logits, NEG)
        probs = jax.nn.softmax(logits, axis=-1).astype(vb.dtype)
        return jnp.einsum('bhqs,bshd->bqhd', probs, vb)

    out = lax.map(block, (jnp.arange(nb), to_blocks(qb), to_blocks(c)))
    return from_blocks(out)


def setup_inputs(seed: int = 0) -> dict:
    key = jax.random.key(seed)
    ks = jax.random.split(key, 14)
    f32 = jnp.float32
    nrm = lambda k, shape, fan_in: jax.random.normal(k, shape, f32) * (fan_in ** -0.5)
    x = jax.random.normal(ks[0], (BATCH, SEQ, D_MODEL), f32)
    p = jax.random.normal(ks[1], (DEPTH, BATCH, SEQ, D_PLE), f32)
    w_in = nrm(ks[2], (DEPTH, D_MODEL, D_IN), D_MODEL)
    b_forget = jax.random.uniform(ks[3], (DEPTH, N_HEADS_B), f32, 1.0, 5.0)
    w_branch_a = nrm(ks[4], (DEPTH, WIDTH_A, D_MODEL), WIDTH_A)
    w_branch_b = nrm(ks[5], (DEPTH, WIDTH_B, D_MODEL), WIDTH_B)
    w_merge = nrm(ks[6], (DEPTH, D_MODEL, 2 * D_MODEL), D_MODEL)
    w_out = nrm(ks[7], (DEPTH, D_MODEL, D_MODEL), D_MODEL)
    g_pre = 1.0 + 0.02 * jax.random.normal(ks[8], (DEPTH, D_MODEL), f32)
    g_post = 1.0 + 0.02 * jax.random.normal(ks[9], (DEPTH, D_MODEL), f32)
    w_ple = nrm(ks[10], (DEPTH, D_PLE, D_MODEL), D_PLE)
    w_ple_gate = nrm(ks[11], (DEPTH, D_MODEL, D_MODEL), D_MODEL)
    g_ple = 1.0 + 0.02 * jax.random.normal(ks[12], (DEPTH, D_MODEL), f32)
    return {"x": x, "p": p, "w_in": w_in, "b_forget": b_forget,
            "w_branch_a": w_branch_a, "w_branch_b": w_branch_b, "w_merge": w_merge,
            "w_out": w_out, "g_pre": g_pre, "g_post": g_post, "w_ple": w_ple,
            "w_ple_gate": w_ple_gate, "g_ple": g_ple}


def reference(x, p, w_in, b_forget, w_branch_a, w_branch_b, w_merge, w_out,
              g_pre, g_post, w_ple, w_ple_gate, g_ple):
    B, S, _ = x.shape
    pos = jnp.arange(S)
    offs = _offsets()
    idx_scale = (N_IDX_HEADS ** -0.5) * (IDX_DIM ** -0.5)
    for i in range(DEPTH):
        h = rmsnorm(x, g_pre[i])
        proj = h @ w_in[i]
        (qa, ka, va, gate_a, qi, ki, wi, qb, kb, vb, fb, gate_b) = jnp.split(proj, offs, axis=-1)

        qa = partial_rope(qa.reshape(B, S, N_HEADS_A, HEAD_DIM), pos)
        ka = partial_rope(ka.reshape(B, S, 1, HEAD_DIM), pos).reshape(B, S, HEAD_DIM)
        qi = partial_rope(qi.reshape(B, S, N_IDX_HEADS, IDX_DIM), pos)
        ki = partial_rope(ki.reshape(B, S, 1, IDX_DIM), pos).reshape(B, S, IDX_DIM)
        wi = wi * idx_scale
        att_a = dsa_branch(qa, ka, va, qi, ki, wi).reshape(B, S, WIDTH_A)
        y_a = (att_a * jax.nn.silu(gate_a)) @ w_branch_a[i]

        log_f = jax.nn.log_sigmoid(fb.astype(jnp.float32) + b_forget[i].astype(jnp.float32))
        att_b = fox_branch(qb.reshape(B, S, N_HEADS_B, HEAD_DIM),
                           kb.reshape(B, S, N_HEADS_B, HEAD_DIM),
                           vb.reshape(B, S, N_HEADS_B, HEAD_DIM), log_f).reshape(B, S, WIDTH_B)
        y_b = (att_b * jax.nn.silu(gate_b)) @ w_branch_b[i]

        m_a, m_b = jnp.split(jax.nn.sigmoid(h @ w_merge[i]), 2, axis=-1)
        out = (m_a * y_a + m_b * y_b) @ w_out[i]
        x = x + rmsnorm(out, g_post[i])

        e = p[i] @ w_ple[i]
        gate = jax.nn.sigmoid(x @ w_ple_gate[i])
        x = x + rmsnorm(gate * e, g_ple[i])
    return x
```

```cpp
#include <hip/hip_runtime.h>
#include <hip/hip_cooperative_groups.h>
#include <cstdio>
#include <cstdint>
#ifndef USE_MEGA
#define USE_MEGA 1
#endif
#ifndef USE_NV_IDX
#define USE_NV_IDX 0
#endif
#ifndef USE_NV_FOX
#define USE_NV_FOX 0
#endif
#ifndef USE_NV_DSA
#define USE_NV_DSA 0
#endif
#ifndef USE_NV_POST
#define USE_NV_POST 0
#endif
#ifndef USE_NV_GEMM1
#define USE_NV_GEMM1 0
#endif

typedef _Float16 f16;
typedef _Float16 f16x2 __attribute__((ext_vector_type(2)));
typedef _Float16 f16x4 __attribute__((ext_vector_type(4)));
typedef _Float16 f16x8 __attribute__((ext_vector_type(8)));
typedef float f32x2 __attribute__((ext_vector_type(2)));
typedef float f32x4 __attribute__((ext_vector_type(4)));
typedef float f32x16 __attribute__((ext_vector_type(16)));
typedef unsigned u32x2 __attribute__((ext_vector_type(2)));
typedef unsigned u32x4 __attribute__((ext_vector_type(4)));
typedef unsigned long long u64;
#define LAS __attribute__((address_space(3)))

constexpr int NB = 32, S = 2048, T = NB * S, D = 1024, DPLE = 256, DIN = 3792;
constexpr int N1 = 5888;
constexpr int TOPK = 256;
constexpr float EPS = 1e-6f;
constexpr float LOG2E = 1.4426950408889634f;
constexpr float C2 = 0.125f * 1.4426950408889634f;
constexpr float IDX_SCALE = 0.044194173824159216f;
constexpr int O_QA = 0, O_KA = 512, O_VA = 576, O_GA = 640, O_QI = 1152, O_KI = 1664, O_WI = 1728, O_QB = 1736, O_KB = 2248, O_VB = 2760, O_FB = 3272, O_GB = 3280;
constexpr int P_QA = 0, P_QI = 512, P_QB = 1024, P_KB = 1536, P_VB = 2048, P_GA = 2560, P_GB = 3072, P_SM = 3584, P_MG = 3840;

constexpr size_t MiB = 1u << 20;
constexpr size_t WS_CTL = 0, WS_ROPE = 1 * MiB, WS_W1T = 2 * MiB, WS_WBA = 14 * MiB, WS_WBB = 15 * MiB, WS_WO = 16 * MiB, WS_WPG = 18 * MiB, WS_WPLE = 20 * MiB,
                 WS_ROWSQ = 21 * MiB, WS_WI = 22 * MiB, WS_LOGF = 24 * MiB, WS_CSUM = 26 * MiB, WS_KA = 28 * MiB, WS_VA = 36 * MiB, WS_KI = 44 * MiB, WS_MASK = 52 * MiB,
                 WS_P16 = 68 * MiB, WS_H16 = 100 * MiB, WS_U = 100 * MiB  , WS_MG = 228 * MiB,
                 WS_QA = 484 * MiB, WS_QI = 548 * MiB, WS_QB = 612 * MiB, WS_KB = 676 * MiB, WS_VB = 740 * MiB, WS_SGA = 804 * MiB, WS_SGB = 868 * MiB, WS_END = 932 * MiB,
                 WS_MERGED = 484 * MiB  , WS_OUT16 = 612 * MiB  , WS_X116 = 740 * MiB  , WS_E16 = 356 * MiB  , WS_V16 = 228 * MiB  ;

struct Params {
    const float *x, *p, *w_in, *b_forget, *w_ba, *w_bb, *w_merge, *w_out, *g_pre, *g_post, *w_ple, *w_pg, *g_ple;
    float* out; unsigned char* ws;
};

__device__ __forceinline__ float wave_sum(float v) {
#pragma unroll
    for (int o = 1; o < 64; o <<= 1) v += __shfl_xor(v, o);
    return v;
}
__device__ __forceinline__ float sigmoidf_(float z) { return 1.0f / (1.0f + __expf(-z)); }
__device__ __forceinline__ float siluf_(float z) { return z / (1.0f + __expf(-z)); }
__device__ __forceinline__ float logsigmoidf_(float z) { return fminf(z, 0.f) - log1pf(__expf(-fabsf(z))); }
__device__ __forceinline__ unsigned sortkey(float f) { const unsigned u = __float_as_uint(f); return (u & 0x80000000u) ? ~u : (u | 0x80000000u); }

__device__ __forceinline__ int w1_src(int n, int& which) {
    which = 0;
    if (n < P_QI) return O_QA + n;
    if (n < P_QB) return O_QI + (n - P_QI);
    if (n < P_KB) return O_QB + (n - P_QB);
    if (n < P_VB) return O_KB + (n - P_KB);
    if (n < P_GA) return O_VB + (n - P_VB);
    if (n < P_GB) return O_GA + (n - P_GA);
    if (n < P_SM) return O_GB + (n - P_GB);
    if (n < P_MG) { const int c = n - P_SM;
        if (c < 64) return O_KA + c; if (c < 128) return O_VA + (c - 64); if (c < 192) return O_KI + (c - 128);
        if (c < 200) return O_WI + (c - 192); if (c < 208) return O_FB + (c - 200); which = -1; return 0; }
    which = 1; return n - P_MG;
}

__device__ __forceinline__ void tr_item(const float* src, int ldw, f16* WT, int K, int n0, int k0, LAS float* scr, int lane) {
#pragma unroll 8
    for (int i = 0; i < 32; ++i) { const int kk = 2 * i + (lane >> 5); scr[kk * 33 + (lane & 31)] = src ? src[(size_t)(k0 + kk) * ldw] : 0.f; }
    asm volatile("s_waitcnt lgkmcnt(0)" ::: "memory");
    const int c = lane & 7;
#pragma unroll
    for (int j = 0; j < 4; ++j) { const int n = (lane >> 3) + 8 * j; const LAS float* s = scr + (8 * c) * 33 + n;
        f16x8 o;
#pragma unroll
        for (int e = 0; e < 8; ++e) o[e] = (f16)s[e * 33];
        *(f16x8*)(WT + (size_t)(n0 + n) * K + k0 + 8 * c) = o; }
    asm volatile("s_waitcnt lgkmcnt(0)" ::: "memory");
}
__device__ __forceinline__ void sincos_d(double a, float& sn, float& cs) {
    const double TWO_PI = 6.283185307179586476925, INV = 0.15915494309189533576888;
    double r = a - rint(a * INV) * TWO_PI;
    const double HALF_PI = 1.57079632679489661923;
    const double qd = rint(r / HALF_PI); const int q = ((int)qd) & 3; const double y = r - qd * HALF_PI, y2 = y * y;
    const double s = y * (1.0 + y2 * (-1.0 / 6 + y2 * (1.0 / 120 + y2 * (-1.0 / 5040 + y2 * (1.0 / 362880 + y2 * (-1.0 / 39916800 + y2 * (1.0 / 6227020800.0)))))));
    const double c = 1.0 + y2 * (-0.5 + y2 * (1.0 / 24 + y2 * (-1.0 / 720 + y2 * (1.0 / 40320 + y2 * (-1.0 / 3628800 + y2 * (1.0 / 479001600.0 + y2 * (-1.0 / 87178291200.0)))))));
    double so, co;
    if (q == 0) { so = s; co = c; } else if (q == 1) { so = c; co = -s; } else if (q == 2) { so = -s; co = -c; } else { so = -c; co = s; }
    sn = (float)so; cs = (float)co;
}
__device__ __forceinline__ void p0_prologue(const Params& P, LAS unsigned char* lds, int vcu, int G) {
    const int tid = threadIdx.x, lane = tid & 63, wave = tid >> 6, NW = blockDim.x >> 6;
    LAS float* scr = (LAS float*)(lds + wave * 8704);
    const int gw = vcu * NW + wave, NGW = G * NW;
    unsigned char* ws = P.ws;
    constexpr int I_W1 = (N1 / 32) * (D / 64), I_BA = (D / 32) * (512 / 64), I_WO = (D / 32) * (D / 64), I_PLE = (D / 32) * (DPLE / 64);
    constexpr int NITEMS = I_W1 + 2 * I_BA + 2 * I_WO + I_PLE;
    for (int it = gw; it < NITEMS; it += NGW) {
        int r = it;
        if (r < I_W1) { const int nb = r % (N1 / 32), kb = r / (N1 / 32); int which; const int sc = w1_src(nb * 32 + (lane & 31), which);
            const float* src = which == 0 ? P.w_in + sc : (which == 1 ? P.w_merge + sc : nullptr);
            tr_item(src, which == 1 ? 2048 : DIN, (f16*)(ws + WS_W1T), D, nb * 32, kb * 64, scr, lane); continue; }
        r -= I_W1;
        if (r < I_BA) { const int nb = r % 32, kb = r / 32; tr_item(P.w_ba + nb * 32 + (lane & 31), D, (f16*)(ws + WS_WBA), 512, nb * 32, kb * 64, scr, lane); continue; }
        r -= I_BA;
        if (r < I_BA) { const int nb = r % 32, kb = r / 32; tr_item(P.w_bb + nb * 32 + (lane & 31), D, (f16*)(ws + WS_WBB), 512, nb * 32, kb * 64, scr, lane); continue; }
        r -= I_BA;
        if (r < I_WO) { const int nb = r % 32, kb = r / 32; tr_item(P.w_out + nb * 32 + (lane & 31), D, (f16*)(ws + WS_WO), D, nb * 32, kb * 64, scr, lane); continue; }
        r -= I_WO;
        if (r < I_WO) { const int nb = r % 32, kb = r / 32; tr_item(P.w_pg + nb * 32 + (lane & 31), D, (f16*)(ws + WS_WPG), D, nb * 32, kb * 64, scr, lane); continue; }
        r -= I_WO;
        { const int nb = r % 32, kb = r / 32; tr_item(P.w_ple + nb * 32 + (lane & 31), D, (f16*)(ws + WS_WPLE), DPLE, nb * 32, kb * 64, scr, lane); }
    }
    {
        f32x4 g[4];
#pragma unroll
        for (int j = 0; j < 4; ++j) g[j] = ((const f32x4*)P.g_pre)[64 * j + lane];
        for (int m = gw; m < T; m += NGW) {
            const f32x4* xr = (const f32x4*)(P.x + (size_t)m * D) + lane;
            f32x4 v[4]; float s2 = 0.f;
#pragma unroll
            for (int j = 0; j < 4; ++j) { v[j] = xr[64 * j]; s2 += (v[j].x * v[j].x + v[j].y * v[j].y) + (v[j].z * v[j].z + v[j].w * v[j].w); }
            const float rstd = rsqrtf(wave_sum(s2) * (1.f / D) + EPS);
            f16x4* o = (f16x4*)((f16*)(ws + WS_H16) + (size_t)m * D) + lane;
#pragma unroll
            for (int j = 0; j < 4; ++j) { f16x4 h; h[0] = (f16)(v[j].x * rstd * g[j].x); h[1] = (f16)(v[j].y * rstd * g[j].y); h[2] = (f16)(v[j].z * rstd * g[j].z); h[3] = (f16)(v[j].w * rstd * g[j].w); o[64 * j] = h; }
        }
    }
    {
        const size_t n8 = (size_t)T * DPLE / 8; const size_t gt = (size_t)vcu * blockDim.x + tid, GT = (size_t)G * blockDim.x;
        for (size_t i = gt; i < n8; i += GT) { const f32x4 a = ((const f32x4*)P.p)[2 * i], b = ((const f32x4*)P.p)[2 * i + 1];
            f16x8 o; o[0] = (f16)a.x; o[1] = (f16)a.y; o[2] = (f16)a.z; o[3] = (f16)a.w; o[4] = (f16)b.x; o[5] = (f16)b.y; o[6] = (f16)b.z; o[7] = (f16)b.w;
            ((f16x8*)(ws + WS_P16))[i] = o; }
        for (size_t i = gt; i < (size_t)S * 8; i += GT) { const int pos = (int)(i >> 3), fi = (int)(i & 7);
            const float frf = fi == 0 ? 1.0f : fi == 1 ? 0.19392274474868576f : fi == 2 ? 0.03760603093086393f : fi == 3 ? 0.007292664737217109f : fi == 4 ? 0.001414213562373095f
                            : fi == 5 ? 0.0002742481756762073f : fi == 6 ? 5.318295896944988e-05f : 1.031338537721246e-05f;
            const float ang = (float)pos * frf;
            float sn, cs; sincos_d((double)ang, sn, cs); ((f32x2*)(ws + WS_ROPE))[i] = (f32x2){cs, sn}; }
        for (size_t i = gt; i < (size_t)2 * T; i += GT) ((float*)(ws + WS_ROWSQ))[i] = 0.f;
#if USE_NV_IDX
        for (size_t i = gt; i < (size_t)16 * MiB / 16; i += GT) ((u32x4*)(ws + WS_MASK))[i] = (u32x4){0u, 0u, 0u, 0u};
#endif
    }
}
__global__ void __launch_bounds__(512) k_p0(Params P) {
    extern __shared__ __attribute__((aligned(16))) unsigned char lds[];
    p0_prologue(P, (LAS unsigned char*)lds, blockIdx.x, gridDim.x);
}


namespace pg8 {
constexpr int BM = 256, BK = 64, HALF = 128, HTB = HALF * BK * 2, STAGE_BYTES = 8 * HTB, NXCD = 8, WGM = 8;
__host__ __device__ __forceinline__ int lds_byte(int r, int c) { const int st = (r >> 4) * 2 + (c >> 5), rr = r & 15, cc = c & 31, ob = rr * 64 + cc * 2; return st * 1024 + (ob ^ (((ob >> 9) & 1) << 5)); }
__host__ __device__ __forceinline__ void stage_rc(int b, int& R, int& C) { const int st = b / 1024, sb = b % 1024, swz = sb ^ (((sb >> 9) & 1) << 5); R = (st >> 1) * 16 + swz / 64; C = (st & 1) * 32 + (swz % 64) / 2; }
__host__ __device__ __forceinline__ int perm32(int rho) { const int n = rho >> 4, i = rho & 15; return 8 * (i >> 2) + 4 * n + (i & 3); }
struct Unit { int pm, pn; };
struct Gemm { const f16* A; const f16* Bt; int lda, ldb, K; };
struct StaticOrder {
    int nM, nN, nwg, G, c;
    __host__ __device__ void init(int M, int N, int G_, int c_) { nM = M / BM; nN = N / BM; nwg = nM * nN; G = G_; c = c_; }
    __host__ __device__ bool next(int i, Unit& u) const {
        const long L = (long)i * G + c; if (L >= nwg) return false;
        int wgid = (int)L; { const int q = nwg / NXCD, r = nwg % NXCD, xcd = wgid % NXCD, off = wgid / NXCD; wgid = (xcd < r ? xcd * (q + 1) : r * (q + 1) + (xcd - r) * q) + off; }
        const int nig = WGM * nN, gid = wgid / nig, fm = gid * WGM, gsz = (nM - fm) < WGM ? (nM - fm) : WGM;
        u.pm = fm + ((wgid % nig) % gsz); u.pn = (wgid % nig) / gsz; return true;
    }
};
template <class Epi>
__device__ __forceinline__ void gemm_phase(LAS unsigned char* lds, const Gemm g, const StaticOrder& S, const Epi& E) {
    int tid = threadIdx.x; asm volatile("" : "+v"(tid));
    const int wid = __builtin_amdgcn_readfirstlane(tid >> 6), lane = tid & 63, wr = wid >> 2, wc = wid & 3, fr = lane & 15, fq = lane >> 4;
    const int nt = g.K / BK;
    unsigned voffA[2], voffB[2];
#pragma unroll
    for (int i = 0; i < 2; ++i) { int R, C; stage_rc(tid * 16 + i * 8192, R, C); const int Rb = (R & ~31) + perm32(R & 31);
        voffA[i] = (unsigned)(R * g.lda + C) * 2u; voffB[i] = (unsigned)(Rb * g.ldb + C) * 2u; }
    const size_t kstep = (size_t)(BK * 2);
    const size_t hstepA = (size_t)HALF * g.lda * 2, hstepB = (size_t)HALF * g.ldb * 2, tstepA = 2 * hstepA, tstepB = 2 * hstepB;
    const unsigned ldsw = (unsigned)wid * 1024u;
    const int aoff = lds_byte(wr * 64 + fr, fq * 8), boff = lds_byte(wc * 32 + fr, fq * 8);
#define PG8_SA(b, h) (((b) * 2 + (h)) * HTB)
#define PG8_SB(b, h) ((4 + (b) * 2 + (h)) * HTB)
#define PG8_STAGE(bufoff, gbase, voff) do { _Pragma("unroll") for (int _i = 0; _i < 2; ++_i) \
        __builtin_amdgcn_global_load_lds((const unsigned*)((const char*)(gbase) + (voff)[_i]), (LAS unsigned*)(lds + (bufoff) + ldsw + _i * 8192), 16, 0, 0); } while (0)
#define PG8_LDA(dst, b, h) do { _Pragma("unroll") for (int m = 0; m < 4; ++m) _Pragma("unroll") for (int k = 0; k < 2; ++k) dst[m][k] = *(const LAS f16x8*)(lds + PG8_SA(b, h) + aoff + m * 2048 + k * 1024); } while (0)
#define PG8_LDB(dst, b, h) do { _Pragma("unroll") for (int n = 0; n < 2; ++n) _Pragma("unroll") for (int k = 0; k < 2; ++k) dst[n][k] = *(const LAS f16x8*)(lds + PG8_SB(b, h) + boff + n * 2048 + k * 1024); } while (0)
#define PG8_MMA(ai, bj, At, Bt) do { __builtin_amdgcn_s_setprio(1); _Pragma("unroll") for (int m = 0; m < 4; ++m) _Pragma("unroll") for (int n = 0; n < 2; ++n) _Pragma("unroll") for (int k = 0; k < 2; ++k) \
        acc[ai][bj][m][n] = __builtin_amdgcn_mfma_f32_16x16x32_f16(Bt[n][k], At[m][k], acc[ai][bj][m][n], 0, 0, 0); __builtin_amdgcn_s_setprio(0); } while (0)
#define PG8_WAIT_V(n) asm volatile("s_waitcnt vmcnt(" #n ")" ::: "memory")
#define PG8_WAIT_L(n) asm volatile("s_waitcnt lgkmcnt(" #n ")" ::: "memory")
#define PG8_BAR __builtin_amdgcn_s_barrier()
#define PG8_SCHED __builtin_amdgcn_sched_barrier(0)
    Unit cur, nxt; int ui = 0;
    if (!S.next(0, cur)) return;
    f32x4 acc[2][2][4][2];
#pragma unroll
    for (int a = 0; a < 2; ++a)
#pragma unroll
        for (int b = 0; b < 2; ++b)
#pragma unroll
            for (int m = 0; m < 4; ++m)
#pragma unroll
                for (int n = 0; n < 2; ++n) acc[a][b][m][n] = (f32x4){0.f, 0.f, 0.f, 0.f};
    f16x8 At[4][2], B0[2][2], B1[2][2];
    const char* cA = (const char*)g.A + (size_t)cur.pm * tstepA; const char* cB = (const char*)g.Bt + (size_t)cur.pn * tstepB;
    PG8_STAGE(PG8_SB(0, 0), cB, voffB); PG8_STAGE(PG8_SB(0, 1), cB + hstepB, voffB); PG8_STAGE(PG8_SA(0, 0), cA, voffA); PG8_STAGE(PG8_SA(0, 1), cA + hstepA, voffA);
    if (wr == 1) PG8_BAR;
    PG8_WAIT_V(2); PG8_BAR;
    PG8_STAGE(PG8_SB(1, 0), cB + kstep, voffB); PG8_STAGE(PG8_SA(1, 0), cA + kstep, voffA); PG8_STAGE(PG8_SB(1, 1), cB + hstepB + kstep, voffB);
    PG8_WAIT_V(6); PG8_BAR;
    for (;;) {
        const bool has_next = S.next(ui + 1, nxt);
        const char* nA = has_next ? (const char*)g.A + (size_t)nxt.pm * tstepA : cA; const char* nB = has_next ? (const char*)g.Bt + (size_t)nxt.pn * tstepB : cB;
#pragma unroll 1
        for (int t = 0; t < nt; t += 2) {
            const bool last = (t == nt - 2);
            const char* a1 = cA + (size_t)(t + 1) * kstep;
            const char* a2 = last ? nA : cA + (size_t)(t + 2) * kstep; const char* b2 = last ? nB : cB + (size_t)(t + 2) * kstep;
            const char* a3 = a2 + kstep; const char* b3 = b2 + kstep;
            PG8_LDB(B0, 0, 0); PG8_LDB(B1, 0, 1); PG8_SCHED; PG8_LDA(At, 0, 0); PG8_STAGE(PG8_SA(1, 1), a1 + hstepA, voffA);
            PG8_WAIT_V(8); PG8_WAIT_L(0); PG8_BAR; PG8_MMA(0, 0, At, B0); PG8_MMA(0, 1, At, B1); PG8_BAR; PG8_SCHED;
            PG8_LDA(At, 0, 1); PG8_STAGE(PG8_SB(0, 0), b2, voffB); PG8_STAGE(PG8_SB(0, 1), b2 + hstepB, voffB); PG8_STAGE(PG8_SA(0, 0), a2, voffA);
            PG8_WAIT_V(8); PG8_WAIT_L(0); PG8_BAR; PG8_MMA(1, 0, At, B0); PG8_MMA(1, 1, At, B1); PG8_BAR; PG8_SCHED;
            PG8_LDB(B0, 1, 0); PG8_LDB(B1, 1, 1); PG8_SCHED; PG8_LDA(At, 1, 0); PG8_STAGE(PG8_SA(0, 1), a2 + hstepA, voffA);
            PG8_WAIT_V(8); PG8_WAIT_L(0); PG8_BAR; PG8_MMA(0, 0, At, B0); PG8_MMA(0, 1, At, B1); PG8_BAR; PG8_SCHED;
            PG8_LDA(At, 1, 1); PG8_STAGE(PG8_SB(1, 0), b3, voffB); PG8_STAGE(PG8_SB(1, 1), b3 + hstepB, voffB); PG8_STAGE(PG8_SA(1, 0), a3, voffA);
            PG8_WAIT_V(8); PG8_WAIT_L(0); PG8_BAR; PG8_MMA(1, 0, At, B0); PG8_MMA(1, 1, At, B1); PG8_BAR; PG8_SCHED;
        }
        if (wr == 0) PG8_BAR;
        E(acc, cur, wr, wc, fr, fq);
        if (!has_next) break;
#pragma unroll
        for (int a = 0; a < 2; ++a)
#pragma unroll
            for (int b = 0; b < 2; ++b)
#pragma unroll
                for (int m = 0; m < 4; ++m)
#pragma unroll
                    for (int n = 0; n < 2; ++n) acc[a][b][m][n] = (f32x4){0.f, 0.f, 0.f, 0.f};
        cur = nxt; cA = nA; cB = nB; ++ui;
        if (wr == 1) PG8_BAR;
    }
    PG8_WAIT_V(0);
    PG8_BAR;
#undef PG8_SA
#undef PG8_SB
#undef PG8_STAGE
#undef PG8_LDA
#undef PG8_LDB
#undef PG8_MMA
#undef PG8_WAIT_V
#undef PG8_WAIT_L
#undef PG8_BAR
#undef PG8_SCHED
}
}

__device__ __forceinline__ f16x8 pack8(const f32x4 a, const f32x4 b) { f16x8 o; o[0] = (f16)a[0]; o[1] = (f16)a[1]; o[2] = (f16)a[2]; o[3] = (f16)a[3]; o[4] = (f16)b[0]; o[5] = (f16)b[1]; o[6] = (f16)b[2]; o[7] = (f16)b[3]; return o; }

struct EpiG1 {
    unsigned char* ws; const float* b_forget;
    __device__ __forceinline__ void operator()(const f32x4 (&acc)[2][2][4][2], const pg8::Unit& u, int wr, int wc, int fr, int fq) const {
        const int pn = u.pn; const int row0 = u.pm * 256 + wr * 64 + fr;
        f16* dst; int ld, colb, mode; bool rope = false;
        if (pn < 2) { dst = (f16*)(ws + WS_QA); ld = 512; colb = 256 * pn; mode = 1; rope = !(wc & 1); }
        else if (pn < 4) { dst = (f16*)(ws + WS_QI); ld = 512; colb = 256 * (pn - 2); mode = 0; rope = !(wc & 1); }
        else if (pn < 6) { dst = (f16*)(ws + WS_QB); ld = 512; colb = 256 * (pn - 4); mode = 1; }
        else if (pn < 8) { dst = (f16*)(ws + WS_KB); ld = 512; colb = 256 * (pn - 6); mode = 0; }
        else if (pn < 10) { dst = (f16*)(ws + WS_VB); ld = 512; colb = 256 * (pn - 8); mode = 0; }
        else if (pn < 12) { dst = (f16*)(ws + WS_SGA); ld = 512; colb = 256 * (pn - 10); mode = 2; }
        else if (pn < 14) { dst = (f16*)(ws + WS_SGB); ld = 512; colb = 256 * (pn - 12); mode = 2; }
        else if (pn == 14) { dst = nullptr; ld = 64; colb = 0; mode = 4; rope = (wc == 0); }
        else { dst = (f16*)(ws + WS_MG); ld = 2048; colb = 256 * (pn - 15); mode = 3; }
#pragma unroll
        for (int ai = 0; ai < 2; ++ai)
#pragma unroll
            for (int m = 0; m < 4; ++m) {
                const int row = row0 + ai * 128 + m * 16; const int pos = row & (S - 1);
#pragma unroll
                for (int bj = 0; bj < 2; ++bj) {
                    f32x4 v0 = acc[ai][bj][m][0], v1 = acc[ai][bj][m][1];
                    if (rope) {
                        f32x4 p0, p1;
#pragma unroll
                        for (int e = 0; e < 4; ++e) { p0[e] = __shfl_xor(v0[e], 16); p1[e] = __shfl_xor(v1[e], 16); }
                        if (fq < 2) { const f32x4* rp = (const f32x4*)(ws + WS_ROPE) + pos * 4; const f32x4 c01 = rp[0], c23 = rp[1], c45 = rp[2], c67 = rp[3];
                            const float sg = fq == 0 ? -1.f : 1.f;
                            v0[0] = v0[0] * c01[0] + sg * p0[0] * c01[1]; v0[1] = v0[1] * c01[2] + sg * p0[1] * c01[3]; v0[2] = v0[2] * c23[0] + sg * p0[2] * c23[1]; v0[3] = v0[3] * c23[2] + sg * p0[3] * c23[3];
                            v1[0] = v1[0] * c45[0] + sg * p1[0] * c45[1]; v1[1] = v1[1] * c45[2] + sg * p1[1] * c45[3]; v1[2] = v1[2] * c67[0] + sg * p1[2] * c67[1]; v1[3] = v1[3] * c67[2] + sg * p1[3] * c67[3]; }
                    }
                    const int c = bj * 128 + wc * 32 + fq * 8;
                    if (mode == 4) {
                        if (c < 64) *(f16x8*)((f16*)(ws + WS_KA) + (size_t)row * 64 + c) = pack8(v0, v1);
                        else if (c < 128) *(f16x8*)((f16*)(ws + WS_VA) + (size_t)row * 64 + (c - 64)) = pack8(v0, v1);
                        else if (c < 192) *(f16x8*)((f16*)(ws + WS_KI) + (size_t)row * 64 + (c - 128)) = pack8(v0, v1);
                        else if (c == 192) { f32x4* o = (f32x4*)((float*)(ws + WS_WI) + (size_t)row * 8); o[0] = v0 * IDX_SCALE; o[1] = v1 * IDX_SCALE; }
                        else if (c == 200) { const f32x4 b0 = ((const f32x4*)b_forget)[0], b1 = ((const f32x4*)b_forget)[1]; f32x4 l0, l1;
#pragma unroll
                            for (int e = 0; e < 4; ++e) { l0[e] = logsigmoidf_(v0[e] + b0[e]); l1[e] = logsigmoidf_(v1[e] + b1[e]); }
                            f32x4* o = (f32x4*)((float*)(ws + WS_LOGF) + (size_t)row * 8); o[0] = l0; o[1] = l1; }
                    } else {
                        if (mode == 1) { v0 = v0 * C2; v1 = v1 * C2; }
                        else if (mode == 2) {
#pragma unroll
                            for (int e = 0; e < 4; ++e) { v0[e] = siluf_(v0[e]); v1[e] = siluf_(v1[e]); } }
                        else if (mode == 3) {
#pragma unroll
                            for (int e = 0; e < 4; ++e) { v0[e] = sigmoidf_(v0[e]); v1[e] = sigmoidf_(v1[e]); } }
                        *(f16x8*)(dst + (size_t)row * ld + colb + c) = pack8(v0, v1);
                    }
                }
            }
    }
};
constexpr int GEMM_LDS = 147456;
__global__ void __launch_bounds__(512, 2) k_gemm1(Params P) {
    extern __shared__ __attribute__((aligned(16))) unsigned char lds[];
    pg8::Gemm g{(const f16*)(P.ws + WS_H16), (const f16*)(P.ws + WS_W1T), D, D, D}; pg8::StaticOrder So; So.init(T, N1, gridDim.x, blockIdx.x);
    EpiG1 E{P.ws, P.b_forget};
    pg8::gemm_phase<EpiG1>((LAS unsigned char*)lds, g, So, E);
}


template <int MODE> struct EpiGen {
    f16* dst; const f16* mul; int ldm, mulcol; const f16* add; float* rowsq;
    __device__ __forceinline__ void operator()(const f32x4 (&acc)[2][2][4][2], const pg8::Unit& u, int wr, int wc, int fr, int fq) const {
        const int row0 = u.pm * 256 + wr * 64 + fr, col0 = u.pn * 256 + wc * 32 + fq * 8;
#pragma unroll
        for (int ai = 0; ai < 2; ++ai)
#pragma unroll
            for (int m = 0; m < 4; ++m) {
                const int row = row0 + ai * 128 + m * 16; float ss = 0.f;
#pragma unroll
                for (int bj = 0; bj < 2; ++bj) {
                    const int col = col0 + bj * 128; f32x4 v0 = acc[ai][bj][m][0], v1 = acc[ai][bj][m][1];
                    if (MODE == 4) {
#pragma unroll
                        for (int e = 0; e < 4; ++e) { v0[e] = sigmoidf_(v0[e]); v1[e] = sigmoidf_(v1[e]); } }
                    if (MODE == 1 || MODE == 2 || MODE == 4) { const f16x8 mv = *(const f16x8*)(mul + (size_t)row * ldm + mulcol + col);
#pragma unroll
                        for (int e = 0; e < 4; ++e) { v0[e] *= (float)mv[e]; v1[e] *= (float)mv[4 + e]; } }
                    if (MODE == 2) { const f16x8 av = *(const f16x8*)(add + (size_t)row * 1024 + col);
#pragma unroll
                        for (int e = 0; e < 4; ++e) { v0[e] += (float)av[e]; v1[e] += (float)av[4 + e]; } }
                    if (MODE == 3 || MODE == 4) {
#pragma unroll
                        for (int e = 0; e < 4; ++e) ss += v0[e] * v0[e] + v1[e] * v1[e]; }
                    *(f16x8*)(dst + (size_t)row * 1024 + col) = pack8(v0, v1);
                }
                if (MODE == 3 || MODE == 4) { ss += __shfl_xor(ss, 16); ss += __shfl_xor(ss, 32); if (fq == 0) atomicAdd(rowsq + row, ss); }
                if (MODE != 0 && MODE != 3) asm volatile("" ::: "memory");
            }
    }
};
__device__ __forceinline__ void ph_merged(const Params& P, LAS unsigned char* lds, int G, int c) {
    unsigned char* ws = P.ws; pg8::StaticOrder So; So.init(T, D, G, c);
    { pg8::Gemm g{(const f16*)(ws + WS_U), (const f16*)(ws + WS_WBA), 1024, 512, 512}; EpiGen<1> E{(f16*)(ws + WS_MERGED), (const f16*)(ws + WS_MG), 2048, 0, nullptr, nullptr}; pg8::gemm_phase(lds, g, So, E); }
    { pg8::Gemm g{(const f16*)(ws + WS_U) + 512, (const f16*)(ws + WS_WBB), 1024, 512, 512}; EpiGen<2> E{(f16*)(ws + WS_MERGED), (const f16*)(ws + WS_MG), 2048, 1024, (const f16*)(ws + WS_MERGED), nullptr}; pg8::gemm_phase(lds, g, So, E); }
}
__device__ __forceinline__ void ph_out(const Params& P, LAS unsigned char* lds, int G, int c) {
    unsigned char* ws = P.ws; pg8::StaticOrder So; So.init(T, D, G, c);
    pg8::Gemm g{(const f16*)(ws + WS_MERGED), (const f16*)(ws + WS_WO), 1024, 1024, 1024}; EpiGen<3> E{(f16*)(ws + WS_OUT16), nullptr, 0, 0, nullptr, (float*)(ws + WS_ROWSQ)}; pg8::gemm_phase(lds, g, So, E);
}
__device__ __forceinline__ void ph_gate(const Params& P, LAS unsigned char* lds, int G, int c) {
    unsigned char* ws = P.ws; pg8::StaticOrder So; So.init(T, D, G, c);
    { pg8::Gemm g{(const f16*)(ws + WS_P16), (const f16*)(ws + WS_WPLE), DPLE, DPLE, DPLE}; EpiGen<0> E{(f16*)(ws + WS_E16), nullptr, 0, 0, nullptr, nullptr}; pg8::gemm_phase(lds, g, So, E); }
    { pg8::Gemm g{(const f16*)(ws + WS_X116), (const f16*)(ws + WS_WPG), 1024, 1024, 1024}; EpiGen<4> E{(f16*)(ws + WS_V16), (const f16*)(ws + WS_E16), 1024, 0, nullptr, (float*)(ws + WS_ROWSQ) + T}; pg8::gemm_phase(lds, g, So, E); }
}
__global__ void __launch_bounds__(512, 2) k_merged(Params P) { extern __shared__ __attribute__((aligned(16))) unsigned char lds[]; ph_merged(P, (LAS unsigned char*)lds, gridDim.x, blockIdx.x); }
__global__ void __launch_bounds__(512, 2) k_out(Params P) { extern __shared__ __attribute__((aligned(16))) unsigned char lds[]; ph_out(P, (LAS unsigned char*)lds, gridDim.x, blockIdx.x); }
__global__ void __launch_bounds__(512, 2) k_gate(Params P) { extern __shared__ __attribute__((aligned(16))) unsigned char lds[]; ph_gate(P, (LAS unsigned char*)lds, gridDim.x, blockIdx.x); }


namespace att {
typedef short s16x4 __attribute__((ext_vector_type(4)));
typedef short s16x8 __attribute__((ext_vector_type(8)));
constexpr int NW = 8, QBLK = 32, KVBLK = 64, NSLOT = 3, SLOTB = 8192;
constexpr int LDS_K = 0, LDS_V = NSLOT * SLOTB, LDS_WS = 2 * NSLOT * SLOTB, LDS_OST = LDS_WS + NW * 64 * 4, LDS_AUX = LDS_OST + NW * 4096, LDS_BYTES = LDS_AUX + 8192;
__device__ __forceinline__ int crow(int r, int hi) { return (r & 3) + 8 * (r >> 2) + 4 * hi; }
#define SBAR() __builtin_amdgcn_sched_barrier(0)
__device__ __forceinline__ void glds16(const void* gsrc, unsigned lds_dst) { unsigned keep;
    asm volatile("s_mov_b32 %0, m0\n\ts_mov_b32 m0, %2\n\ts_nop 0\n\tglobal_load_lds_dwordx4 %1, off\n\ts_mov_b32 m0, %0" : "=&s"(keep) : "v"(gsrc), "s"(lds_dst) : "memory"); }
__device__ __forceinline__ float max3f(float a, float b, float c) { float r; asm("v_max3_f32 %0, %1, %2, %3" : "=v"(r) : "v"(a), "v"(b), "v"(c)); return r; }
__device__ __forceinline__ float max2f(float a, float b) { float r; asm("v_max_f32_e32 %0, %1, %2" : "=v"(r) : "v"(a), "v"(b)); return r; }
__device__ __forceinline__ float fadd_s(float a, float b) { float r; asm("v_add_f32_e32 %0, %1, %2" : "=v"(r) : "v"(a), "v"(b)); return r; }
__device__ __forceinline__ float fsub_s(float a, float b) { float r; asm("v_sub_f32_e32 %0, %1, %2" : "=v"(r) : "v"(a), "v"(b)); return r; }
__device__ __forceinline__ unsigned cvtpk_s(float lo, float hi) { return __builtin_bit_cast(unsigned, __builtin_amdgcn_cvt_pkrtz(lo, hi)); }
#define WAIT_BAR(N) asm volatile("s_waitcnt vmcnt(" #N ") lgkmcnt(0)\n\ts_barrier" ::: "memory")
typedef LAS const char* lds_cptr;
typedef short v4i16_t __attribute__((ext_vector_type(4)));
__device__ __forceinline__ void kload8(f16x8* kf, lds_cptr kp) {
    kf[0] = *(const LAS f16x8*)(kp);        kf[1] = *(const LAS f16x8*)(kp + 512);
    kf[2] = *(const LAS f16x8*)(kp + 2048); kf[3] = *(const LAS f16x8*)(kp + 2560);
    kf[4] = *(const LAS f16x8*)(kp + 4096); kf[5] = *(const LAS f16x8*)(kp + 4608);
    kf[6] = *(const LAS f16x8*)(kp + 6144); kf[7] = *(const LAS f16x8*)(kp + 6656);
}
__device__ __forceinline__ void kload2(f16x8* kf, lds_cptr kp, int j) { kf[2 * j] = *(const LAS f16x8*)(kp + j * 2048); kf[2 * j + 1] = *(const LAS f16x8*)(kp + j * 2048 + 512); }
__device__ __forceinline__ s16x4 vtr(lds_cptr p) { return __builtin_bit_cast(s16x4, __builtin_amdgcn_ds_read_tr16_b64_v4i16((LAS v4i16_t*)p)); }
__device__ __forceinline__ float rowmax(const f32x16& p0, const f32x16& p1) {
    float a = max3f(p0[0], p0[1], p1[0]), b = max3f(p0[2], p0[3], p1[1]); a = max3f(a, p1[2], p1[3]);
#pragma unroll
    for (int r = 4; r < 16; r += 4) { a = max3f(a, p0[r], p0[r + 1]); b = max3f(b, p0[r + 2], p0[r + 3]); a = max3f(a, p1[r], p1[r + 1]); b = max3f(b, p1[r + 2], p1[r + 3]); }
    const float m = max2f(a, b);
    auto rr = __builtin_amdgcn_permlane32_swap(__float_as_uint(m), __float_as_uint(m), false, false);
    return max2f(__uint_as_float(rr[0]), __uint_as_float(rr[1]));
}
#define MFMA32(a, b, c) __builtin_amdgcn_mfma_f32_32x32x16_f16((a), (b), (c), 0, 0, 0)
__device__ __forceinline__ void cmask(f32x16& p0, f32x16& p1, int jb, int qrel, int hi) {
    const float NEG = -INFINITY; const int kb = 64 * jb + 4 * hi;
#pragma unroll
    for (int r = 0; r < 16; ++r) { const int kv = kb + (r & 3) + 8 * (r >> 2); if (kv > qrel) p0[r] = NEG; if (kv + 32 > qrel) p1[r] = NEG; }
}
__device__ __forceinline__ void pv(f32x16* o, int vb, f16x8 pa0, f16x8 pa1, f16x8 pa2, f16x8 pa3) {
#pragma unroll
    for (int d0 = 0; d0 < 2; ++d0) { s16x4 lo[4], hi[4];
#pragma unroll
        for (int ks = 0; ks < 4; ++ks) {
            asm volatile("ds_read_b64_tr_b16 %0,%1 offset:%c2" : "=&v"(lo[ks]) : "v"(vb), "i"(d0 * 4096 + ks * 1024) : "memory");
            asm volatile("ds_read_b64_tr_b16 %0,%1 offset:%c2" : "=&v"(hi[ks]) : "v"(vb), "i"(d0 * 4096 + ks * 1024 + 512) : "memory"); }
        asm volatile("s_waitcnt lgkmcnt(0)" ::: "memory"); SBAR();
#define PK(k) __builtin_bit_cast(f16x8, (s16x8){lo[k][0], lo[k][1], lo[k][2], lo[k][3], hi[k][0], hi[k][1], hi[k][2], hi[k][3]})
        o[d0] = MFMA32(pa0, PK(0), o[d0]); o[d0] = MFMA32(pa1, PK(1), o[d0]); o[d0] = MFMA32(pa2, PK(2), o[d0]); o[d0] = MFMA32(pa3, PK(3), o[d0]);
#undef PK
    }
}
template <int MODE, int THRL> __device__ __forceinline__ void attn_unit(const f16* Qw, const f16* __restrict__ Kh, const f16* __restrict__ Vh, const int KP, const int NT, const int qrel0, const float ct2,
                                                                          f16* Uw, const f16* SGw, char* shm) {
    int tid = threadIdx.x; asm volatile("" : "+v"(tid));
    const int lane = tid & 63, r32 = lane & 31, hi = lane >> 5; const int wid = __builtin_amdgcn_readfirstlane(tid >> 6);
    const unsigned lds0 = (unsigned)(uintptr_t)shm;
    float* wsf = (float*)(shm + LDS_WS) + wid * 64;
    const f16* ksrc = Kh + (long)lane * KP + wid * 8;
    const f16* vsrc = Vh + (long)(16 * (wid & 3) + (lane >> 2)) * KP + (wid >> 2) * 32 + (lane & 3) * 8;
    const unsigned kdst = lds0 + LDS_K + wid * 1024, vdst = lds0 + LDS_V + wid * 1024;
#define DMA_K(t, slot) glds16(ksrc + (long)(t) * KVBLK * KP, (unsigned)__builtin_amdgcn_readfirstlane(kdst + (slot)))
#define DMA_V(t, slot) glds16(vsrc + (long)(t) * KVBLK * KP, (unsigned)__builtin_amdgcn_readfirstlane(vdst + (slot)))
    const int vb0 = (int)(lds0 + LDS_V) + ((lane >> 4) & 1) * 32 + (lane & 3) * 8 + (4 * hi + ((lane & 15) >> 2)) * 64;
    f16x8 kf[8];
    const lds_cptr shm3 = (lds_cptr)shm; const lds_cptr kp0 = shm3 + LDS_K + hi * 1024 + r32 * 16; const lds_cptr vp0 = shm3 + LDS_V + ((lane >> 4) & 1) * 32 + (lane & 3) * 8 + (4 * hi + ((lane & 15) >> 2)) * 64;
    const LAS float* cs2 = (const LAS float*)(shm3 + LDS_AUX) + 4 * hi;
    const LAS u64* mwp = (const LAS u64*)(shm3 + LDS_AUX) + r32;
    DMA_K(0, 0); DMA_V(0, 0); DMA_K(1, SLOTB);
    f16x8 qr[4];
#pragma unroll
    for (int d0 = 0; d0 < 4; ++d0) qr[d0] = *reinterpret_cast<const f16x8*>(&Qw[(long)r32 * 512 + d0 * 16 + hi * 8]);
    float mhat = 0.f, l_reg = 0.f; f32x16 o[2]; o[0] = f32x16{}; o[1] = f32x16{};
    float base = (MODE == 0) ? ct2 : 0.f;
    const int qrel = qrel0 + r32;
#define INITH(C, t, HOFF, WSH) do { if (MODE == 0) { const LAS float* cp_ = cs2 + 64 * (t) + (HOFF); \
        _Pragma("unroll") for (int g_ = 0; g_ < 4; ++g_) { const f32x4 a_ = *(const LAS f32x4*)(cp_ + 8 * g_); \
            _Pragma("unroll") for (int e_ = 0; e_ < 4; ++e_) C[4 * g_ + e_] = base - a_[e_]; } } \
      else { const u64 w_ = mwp[32 * (t)]; const unsigned w0_ = (unsigned)(w_ >> ((WSH) + 4 * hi)); const unsigned nb_ = __float_as_uint(base), ng_ = __float_as_uint(-1e30f); \
        _Pragma("unroll") for (int r_ = 0; r_ < 16; ++r_) { const int cb_ = (r_ & 3) + 8 * (r_ >> 2); const unsigned t0_ = (unsigned)__builtin_amdgcn_sbfe((int)w0_, cb_, 1); \
            C[r_] = __uint_as_float((t0_ & nb_) | (~t0_ & ng_)); } } } while (0)
#define INIT(C0, C1, t) do { INITH(C0, t, 0, 0); INITH(C1, t, 32, 32); } while (0)
#define CMASK(P0, P1, t) do { if (MODE == 0) { int jb_ = (t) - (NT - 4); if (jb_ >= 0) cmask(P0, P1, jb_, qrel, hi); } } while (0)
    bool resc = false;
#define START(P0, P1) do { const float rm = rowmax(P0, P1); resc = false; \
    { const float dl = (MODE == 0) ? rm : __builtin_fmaxf(rm, -1000.f); mhat = fadd_s(mhat, dl); base = fsub_s(base, dl); \
      _Pragma("unroll") for (int r = 0; r < 16; ++r) { P0[r] = fsub_s(P0[r], dl); P1[r] = fsub_s(P1[r], dl); } } \
    _Pragma("unroll") for (int r = 0; r < 16; ++r) P0[r] = __builtin_amdgcn_exp2f(P0[r]); } while (0)
#define RESC() do { if (resc) { asm volatile("s_waitcnt lgkmcnt(0)" ::: "memory"); \
      _Pragma("unroll") for (int d_ = 0; d_ < 2; ++d_) _Pragma("unroll") for (int r = 0; r < 16; ++r) o[d_][r] *= wsf[crow(r, hi)]; } } while (0)
    f32x16 pA0, pA1, pB0, pB1;
    int sl_prev = 0, sl_cur = 0, sl_next = SLOTB;
#define ROT() do { sl_prev = sl_cur; sl_cur = sl_next; sl_next = (sl_next == (NSLOT - 1) * SLOTB) ? 0 : sl_next + SLOTB; } while (0)
    DMA_K(2, 2 * SLOTB);
    WAIT_BAR(3);
    INIT(pA0, pA1, 0);
    { const char* kb = shm + LDS_K + hi * 1024 + r32 * 16;
#pragma unroll
      for (int d0 = 0; d0 < 4; ++d0) { const f16x8 b0 = *reinterpret_cast<const f16x8*>(kb + d0 * 2048); const f16x8 b1 = *reinterpret_cast<const f16x8*>(kb + d0 * 2048 + 512);
          pA0 = MFMA32(b0, qr[d0], pA0); pA1 = MFMA32(b1, qr[d0], pA1); } }
    asm volatile("s_nop 15\n\ts_nop 7" : "+v"(pA0), "+v"(pA1)); CMASK(pA0, pA1, 0);
    START(pA0, pA1);
#pragma unroll
    for (int r = 0; r < 16; ++r) pA1[r] = __builtin_amdgcn_exp2f(pA1[r]);
    WAIT_BAR(0);
    DMA_K(3, 0); DMA_V(1, SLOTB);
    ROT();
    kload8(kf, kp0 + sl_cur);
    WAIT_BAR(2);
    s16x4 vlo[8], vhi[8]; u32x4 pw0, pw1, pw2, pw3;
#define PKW(P, B) cvtpk_s(P[B], P[B + 1])
#define PAF(k) __builtin_bit_cast(f16x8, pw##k)
#define VFR(i) __builtin_bit_cast(f16x8, (s16x8){vlo[i][0], vlo[i][1], vlo[i][2], vlo[i][3], vhi[i][0], vhi[i][1], vhi[i][2], vhi[i][3]})
#define PIN(x) asm volatile("" : "+v"(x))
#define MX3(a, b, c) __builtin_fmaxf(__builtin_fmaxf((a), (b)), (c))
#define GAPA(MF, A0, A1, A2, A3, W0, W1, PW) do { MF; sacc += A0; sacc += A1; sacc += A2; sacc += A3; PIN(sacc); W0; W1; PIN(PW); SBAR(); } while (0)
#define EX(v) __builtin_amdgcn_exp2f(v)
#define GAPB(MF, X, B) do { MF; X[B] = EX(X[B]); X[B + 1] = EX(X[B + 1]); X[B + 2] = EX(X[B + 2]); X[B + 3] = EX(X[B + 3]); PIN(X); SBAR(); } while (0)
#define VRD(i) do { vlo[i] = vtr(vp_ + (((i) >> 2) * 4096 + ((i) & 3) * 1024)); vhi[i] = vtr(vp_ + (((i) >> 2) * 4096 + ((i) & 3) * 1024 + 512)); } while (0)
#define KRD(G, j) do { if (G) { kload2(kf, kp0 + sl_next, j); SBAR(); } } while (0)
#define STEP(C0, C1, P0, P1, t, GK, GV, GL) do { SBAR(); \
    const lds_cptr vp_ = vp0 + sl_prev; \
    INITH(C0, t, 0, 0); \
    VRD(0); SBAR(); float sacc = (P0[0] + P0[1]); \
    GAPA(C0 = MFMA32(kf[0], qr[0], C0), P0[2], P0[3], P0[4], P0[5],     pw0[0] = PKW(P0, 0), pw0[1] = PKW(P0, 2), pw0); \
    INITH(C1, t, 32, 32); \
    VRD(4); SBAR(); GAPA(C1 = MFMA32(kf[1], qr[0], C1), P0[6], P0[7], P0[8], P0[9],     pw0[2] = PKW(P0, 4), pw0[3] = PKW(P0, 6), pw0); \
    VRD(1); SBAR(); GAPA(C0 = MFMA32(kf[2], qr[1], C0),   P0[10], P0[11], P0[12], P0[13], pw1[0] = PKW(P0, 8), pw1[1] = PKW(P0, 10), pw1); \
    VRD(5); SBAR(); GAPA(C1 = MFMA32(kf[3], qr[1], C1),   P0[14], P0[15], P1[0], P1[1],   pw1[2] = PKW(P0, 12), pw1[3] = PKW(P0, 14), pw1); \
    VRD(2); SBAR(); GAPA(C0 = MFMA32(kf[4], qr[2], C0),   P1[2], P1[3], P1[4], P1[5],     pw2[0] = PKW(P1, 0), pw2[1] = PKW(P1, 2), pw2); \
    VRD(6); SBAR(); GAPA(C1 = MFMA32(kf[5], qr[2], C1),   P1[6], P1[7], P1[8], P1[9],     pw2[2] = PKW(P1, 4), pw2[3] = PKW(P1, 6), pw2); \
    VRD(3); SBAR(); GAPA(C0 = MFMA32(kf[6], qr[3], C0),   P1[10], P1[11], P1[12], P1[13], pw3[0] = PKW(P1, 8), pw3[1] = PKW(P1, 10), pw3); \
    VRD(7); SBAR(); GAPA(C1 = MFMA32(kf[7], qr[3], C1),   P1[14], P1[15], 0.f, 0.f,       pw3[2] = PKW(P1, 12), pw3[3] = PKW(P1, 14), pw3); \
    l_reg += sacc; \
    if (GK) { DMA_K((t) + 3, sl_cur); } if (GV) { DMA_V((t) + 1, sl_next); } \
    CMASK(C0, C1, t); \
    { float a = MX3(C0[0], C0[1], C1[0]), b = MX3(C0[2], C0[3], C1[1]); a = MX3(a, C1[2], C1[3]); \
      _Pragma("unroll") for (int r = 4; r < 16; r += 4) { a = MX3(a, C0[r], C0[r + 1]); b = MX3(b, C0[r + 2], C0[r + 3]); a = MX3(a, C1[r], C1[r + 1]); b = MX3(b, C1[r + 2], C1[r + 3]); } \
      float rm = __builtin_fmaxf(a, b); { auto rr = __builtin_amdgcn_permlane32_swap(__float_as_uint(rm), __float_as_uint(rm), false, false); rm = __builtin_fmaxf(__uint_as_float(rr[0]), __uint_as_float(rr[1])); } \
      resc = false; \
      if (__builtin_expect(__any(rm > (float)THRL), 0)) { const float dl = __builtin_fmaxf(rm, 0.f); mhat += dl; base -= dl; \
        _Pragma("unroll") for (int r = 0; r < 16; ++r) { C0[r] -= dl; C1[r] -= dl; } \
        const float f = __builtin_amdgcn_exp2f(-dl); l_reg *= f; if (hi == 0) wsf[r32] = f; resc = true; } } \
    SBAR(); \
    GAPB(o[0] = MFMA32(PAF(0), VFR(0), o[0]), C0, 0); \
    GAPB(o[1] = MFMA32(PAF(0), VFR(4), o[1]), C0, 4); \
    KRD(GL, 0); GAPB(o[0] = MFMA32(PAF(1), VFR(1), o[0]), C0, 8); \
    KRD(GL, 1); GAPB(o[1] = MFMA32(PAF(1), VFR(5), o[1]), C0, 12); \
    KRD(GL, 2); GAPB(o[0] = MFMA32(PAF(2), VFR(2), o[0]), C1, 0); \
    KRD(GL, 3); GAPB(o[1] = MFMA32(PAF(2), VFR(6), o[1]), C1, 4); \
    GAPB(o[0] = MFMA32(PAF(3), VFR(3), o[0]), C1, 8); \
    GAPB(o[1] = MFMA32(PAF(3), VFR(7), o[1]), C1, 12); \
    } while (0)
    int t = 1;
#define ENDW(tt) do { if ((tt) + 3 < NT) { WAIT_BAR(2); } else if ((tt) + 2 < NT) { WAIT_BAR(1); } else { WAIT_BAR(0); } } while (0)
#undef CMASK
#define CMASK(P0, P1, t) do { } while (0)
    for (; t + 5 < NT; t += 2) {
        STEP(pB0, pB1, pA0, pA1, t, true, true, true);     WAIT_BAR(2); RESC(); ROT();
        STEP(pA0, pA1, pB0, pB1, t + 1, true, true, true); WAIT_BAR(2); RESC(); ROT();
    }
#undef CMASK
#define CMASK(P0, P1, t) do { if (MODE == 0) { int jb_ = (t) - (NT - 4); if (jb_ >= 0) cmask(P0, P1, jb_, qrel, hi); } } while (0)
    for (; t + 1 < NT; t += 2) {
        STEP(pB0, pB1, pA0, pA1, t, (t + 3 < NT), (t + 1 < NT), (t + 1 < NT));         ENDW(t);     RESC(); ROT();
        STEP(pA0, pA1, pB0, pB1, t + 1, (t + 4 < NT), (t + 2 < NT), (t + 2 < NT));     ENDW(t + 1); RESC(); ROT();
    }
    STEP(pB0, pB1, pA0, pA1, NT - 1, false, false, false); RESC();
    { float sacc = pB0[0] + pB0[1];
#pragma unroll
      for (int r = 2; r < 16; ++r) sacc += pB0[r];
#pragma unroll
      for (int r = 0; r < 16; ++r) sacc += pB1[r];
      l_reg += sacc;
      pw0 = (u32x4){PKW(pB0, 0), PKW(pB0, 2), PKW(pB0, 4), PKW(pB0, 6)}; pw1 = (u32x4){PKW(pB0, 8), PKW(pB0, 10), PKW(pB0, 12), PKW(pB0, 14)};
      pw2 = (u32x4){PKW(pB1, 0), PKW(pB1, 2), PKW(pB1, 4), PKW(pB1, 6)}; pw3 = (u32x4){PKW(pB1, 8), PKW(pB1, 10), PKW(pB1, 12), PKW(pB1, 14)};
      SBAR(); pv(o, vb0 + sl_cur, PAF(0), PAF(1), PAF(2), PAF(3)); }
#undef PKW
#undef PAF
#undef VFR
#undef PIN
#undef MX3
#undef GAPA
#undef GAPB
#undef EX
#undef VRD
#undef KRD
#undef STEP
#undef ENDW
    { auto rr = __builtin_amdgcn_permlane32_swap(__float_as_uint(l_reg), __float_as_uint(l_reg), false, false); l_reg = __uint_as_float(rr[0]) + __uint_as_float(rr[1]); }
    if (hi == 0) wsf[32 + r32] = l_reg; asm volatile("s_waitcnt lgkmcnt(0)" ::: "memory");
    float rli[16];
#pragma unroll
    for (int r = 0; r < 16; ++r) rli[r] = __builtin_amdgcn_rcpf(wsf[32 + crow(r, hi)]);
    { f16* stg = (f16*)(shm + LDS_OST) + wid * 2048;
#pragma unroll
      for (int r = 0; r < 16; ++r) { const int orow = crow(r, hi);
#pragma unroll
          for (int d0 = 0; d0 < 2; ++d0) stg[orow * 64 + d0 * 32 + r32] = (f16)(o[d0][r] * rli[r]); }
      asm volatile("s_waitcnt lgkmcnt(0)" ::: "memory");
#pragma unroll
      for (int i = 0; i < 4; ++i) { const int row = i * 8 + (lane >> 3), ch = lane & 7; const f16x8 v = *(const f16x8*)(stg + row * 64 + ch * 8); const f16x8 g = *(const f16x8*)(SGw + (long)row * 512 + ch * 8);
          *(f16x8*)(Uw + (long)row * 1024 + ch * 8) = v * g; } }
    asm volatile("s_waitcnt vmcnt(0) lgkmcnt(0)\n\ts_barrier" ::: "memory");
#undef DMA_K
#undef DMA_V
#undef CMASK
#undef INIT
#undef INITH
#undef START
#undef RESC
#undef ROT
}
#undef SBAR
#undef WAIT_BAR
#undef MFMA32
}

__device__ __forceinline__ void ph_fox(const Params& P, char* shm, int vcu, int G) {
    unsigned char* ws = P.ws; const int tid = threadIdx.x, lane = tid & 63, wid = tid >> 6;
    for (int bh = vcu; bh < NB * 8; bh += G) {
        const int b = bh >> 3, h = bh & 7;
        float* cs = (float*)(shm + att::LDS_AUX); float* wtot = (float*)(shm + att::LDS_WS);
        { int t2 = threadIdx.x; asm volatile("" : "+v"(t2));
          const int lane2 = t2 & 63, wid2 = t2 >> 6;
          const float* lf = (const float*)(ws + WS_LOGF) + ((size_t)b * S + t2 * 4) * 8 + h;
          float v0 = lf[0], v1 = v0 + lf[8], v2 = v1 + lf[16], v3 = v2 + lf[24]; float inc = v3;
#pragma unroll
          for (int o = 1; o < 64; o <<= 1) { const float n = __shfl_up(inc, o); if (lane2 >= o) inc += n; }
          if (lane2 == 63) wtot[wid2] = inc;
          __syncthreads();
          float off = inc - v3; for (int w = 0; w < wid2; ++w) off += wtot[w];
          *(f32x4*)(cs + t2 * 4) = (f32x4){(v0 + off) * LOG2E, (v1 + off) * LOG2E, (v2 + off) * LOG2E, (v3 + off) * LOG2E};
          __syncthreads(); }
        const size_t rowbase = (size_t)b * S;
        for (int qi = 0; qi < 8; ++qi) { const int qb = 7 - qi; const int q0 = qb * 256;
            const size_t tok = rowbase + q0 + wid * 32;
            const float ct2 = cs[q0 + wid * 32 + (lane & 31)];
            att::attn_unit<0, 8>((const f16*)(ws + WS_QB) + tok * 512 + h * 64, (const f16*)(ws + WS_KB) + rowbase * 512 + h * 64, (const f16*)(ws + WS_VB) + rowbase * 512 + h * 64, 512, 4 * qb + 4, wid * 32, ct2,
                                 (f16*)(ws + WS_U) + tok * 1024 + 512 + h * 64, (const f16*)(ws + WS_SGB) + tok * 512 + h * 64, shm); }
        __syncthreads();
    }
}
__device__ __forceinline__ void ph_dsa_attn(const Params& P, char* shm, int vcu, int G) {
    unsigned char* ws = P.ws; const int tid = threadIdx.x, wid = tid >> 6;
    for (int it = vcu; it < NB * 8; it += G) {
        const int b = it >> 3, j = it & 7; const size_t rowbase = (size_t)b * S;
        for (int k = 0; k < 8; ++k) { const int qt = (k & 1) ? (16 * (k >> 1) + 15 - j) : (16 * (k >> 1) + j);
            const int nt = qt / 2 + 1, NT = nt < 4 ? 4 : nt + (nt & 1);
            { const u32x4* src = (const u32x4*)((const u64*)(ws + WS_MASK) + ((size_t)b * 64 + qt) * 32 * 32); u32x4* dst = (u32x4*)(shm + att::LDS_AUX);
              if (tid < NT * 16) dst[tid] = src[tid]; }
            __syncthreads();
            const size_t tok = rowbase + qt * 32;
            att::attn_unit<1, 8>((const f16*)(ws + WS_QA) + tok * 512 + wid * 64, (const f16*)(ws + WS_KA) + rowbase * 64, (const f16*)(ws + WS_VA) + rowbase * 64, 64, NT, 0, 0.f,
                                 (f16*)(ws + WS_U) + tok * 1024 + wid * 64, (const f16*)(ws + WS_SGA) + tok * 512 + wid * 64, shm); }
    }
}

namespace idx {
constexpr int BUFB = 32768;
__device__ __forceinline__ int half_sum(int v) {
    v += __builtin_amdgcn_update_dpp(0, v, 0xB1, 0xF, 0xF, false);
    v += __builtin_amdgcn_update_dpp(0, v, 0x4E, 0xF, 0xF, false);
    v += __builtin_amdgcn_update_dpp(0, v, 0x141, 0xF, 0xF, false);
    v += __builtin_amdgcn_update_dpp(0, v, 0x140, 0xF, 0xF, false);
    v += __shfl_xor(v, 16);
    return v;
}
__device__ __forceinline__ void indexer_tile(const Params& P, char* shm, const int b, const int qt, const int NTA) {
    unsigned char* ws = P.ws;
    int tid = threadIdx.x; asm volatile("" : "+v"(tid));
    const int lane = tid & 63, c = lane & 31, g = lane >> 5; const int wid = __builtin_amdgcn_readfirstlane(tid >> 6);
    const size_t rowbase = (size_t)b * S; const int q0 = qt * 32; const int ntiles = qt + 1, nchunks = (ntiles + 7) >> 3;
    const unsigned lds0 = (unsigned)(uintptr_t)shm;
    const f16* kig = (const f16*)(ws + WS_KI) + rowbase * 64;
#define IDX_DMA(ch) do { _Pragma("unroll") for (int pp_ = 0; pp_ < 4; ++pp_) { const int p_ = wid + 8 * pp_; const int key_ = 8 * p_ + (lane >> 3); \
        att::glds16(kig + (size_t)((ch) * 256 + key_) * 64 + (((lane & 7) ^ ((key_ >> 1) & 7)) * 8), (unsigned)__builtin_amdgcn_readfirstlane(lds0 + ((ch) & 1) * BUFB + p_ * 1024)); } } while (0)
    IDX_DMA(0);
    f16x8 aq[4];
    { const int rho = c; const int qq = 2 * ((rho >> 2) & 1) + (rho >> 4), hd = 4 * ((rho >> 3) & 1) + (rho & 3);
      const f16* qp = (const f16*)(ws + WS_QI) + (rowbase + q0 + 4 * wid + qq) * 512 + hd * 64 + 8 * g;
#pragma unroll
      for (int kk = 0; kk < 4; ++kk) aq[kk] = *(const f16x8*)(qp + 16 * kk); }
    float wq[16];
    { const f32x4* wp = (const f32x4*)((const float*)(ws + WS_WI) + (rowbase + q0 + 4 * wid + 2 * g) * 8);
      const f32x4 a0 = wp[0], a1 = wp[1], a2 = wp[2], a3 = wp[3];
      wq[0] = a0[0]; wq[1] = a0[1]; wq[2] = a0[2]; wq[3] = a0[3]; wq[4] = a1[0]; wq[5] = a1[1]; wq[6] = a1[2]; wq[7] = a1[3];
      wq[8] = a2[0]; wq[9] = a2[1]; wq[10] = a2[2]; wq[11] = a2[3]; wq[12] = a3[0]; wq[13] = a3[1]; wq[14] = a3[2]; wq[15] = a3[3]; }
    const int ql0 = 4 * wid + 2 * g, ql1 = ql0 + 1;
    unsigned k0[64], k1[64];
    const LAS char* bbase = (const LAS char*)shm + c * 128;
    const int sw = (c >> 1) & 7;
#pragma unroll
    for (int ch = 0; ch < 8; ++ch) {
        if (ch < nchunks) {
            asm volatile("s_waitcnt vmcnt(0)\n\ts_barrier" ::: "memory");
            if (ch + 1 < nchunks) IDX_DMA(ch + 1);
#pragma unroll
            for (int j = 0; j < 8; ++j) { const int jt = ch * 8 + j;
                if (jt < ntiles) {
                    const LAS char* bp = bbase + (ch & 1) * BUFB + j * 4096;
                    f32x16 acc = f32x16{};
#pragma unroll
                    for (int kk = 0; kk < 4; ++kk) { const f16x8 bk = *(const LAS f16x8*)(bp + (((2 * kk + g) ^ sw) * 16)); acc = __builtin_amdgcn_mfma_f32_32x32x16_f16(aq[kk], bk, acc, 0, 0, 0); }
                    float s0 = 0.f, s1 = 0.f;
#pragma unroll
                    for (int r = 0; r < 8; ++r) { s0 = __builtin_fmaf(wq[r], __builtin_fmaxf(acc[r], 0.f), s0); s1 = __builtin_fmaf(wq[8 + r], __builtin_fmaxf(acc[8 + r], 0.f), s1); }
                    unsigned u0 = sortkey(s0), u1 = sortkey(s1);
                    if (jt == qt) { if (c > ql0) u0 = 0u; if (c > ql1) u1 = 0u; }
                    k0[jt] = u0; k1[jt] = u1;
                } else { k0[jt] = 0u; k1[jt] = 0u; }
            }
        } else {
#pragma unroll
            for (int j = 0; j < 8; ++j) { k0[ch * 8 + j] = 0u; k1[ch * 8 + j] = 0u; }
        }
    }
#undef IDX_DMA
    asm volatile("s_waitcnt lgkmcnt(0)\n\ts_barrier" ::: "memory");
    LAS unsigned* mk = (LAS unsigned*)((LAS char*)shm + att::LDS_AUX);
    const int qa0 = (ql0) * 2, qa1 = (ql1) * 2;
    if (qt < 8) {
#pragma unroll
        for (int jt = 0; jt < 64; ++jt) if (jt < 2 * NTA) {
            const unsigned m0 = jt < qt ? 0xFFFFFFFFu : (jt == qt ? (unsigned)((2ull << ql0) - 1ull) : 0u), m1 = jt < qt ? 0xFFFFFFFFu : (jt == qt ? (unsigned)((2ull << ql1) - 1ull) : 0u);
            if (c == 0) { mk[(jt >> 1) * 64 + qa0 + (jt & 1)] = m0; mk[(jt >> 1) * 64 + qa1 + (jt & 1)] = m1; } }
    } else {
        unsigned lo0 = 0u, hi0 = 0xFFFFFFFFu, lo1 = 0u, hi1 = 0xFFFFFFFFu, th0 = 0u, th1 = 0u; int st0 = 0, st1 = 0;
        for (int it = 0; it < 40; ++it) {
            if (!__any(st0 == 0 || st1 == 0)) break;
            const unsigned mid0 = st0 ? th0 : lo0 + ((hi0 - lo0) >> 1), mid1 = st1 ? th1 : lo1 + ((hi1 - lo1) >> 1);
            int c0 = 0, c1 = 0;
#pragma unroll
            for (int jt = 0; jt < 64; ++jt) if (jt < ntiles) { c0 += (k0[jt] > mid0) ? 1 : 0; c1 += (k1[jt] > mid1) ? 1 : 0; }
            c0 = half_sum(c0); c1 = half_sum(c1);
            if (st0 == 0) { if (c0 == TOPK) { th0 = mid0; st0 = 1; } else { if (c0 > TOPK) lo0 = mid0; else hi0 = mid0; if (hi0 - lo0 <= 1u) { th0 = hi0; st0 = 2; } } }
            if (st1 == 0) { if (c1 == TOPK) { th1 = mid1; st1 = 1; } else { if (c1 > TOPK) lo1 = mid1; else hi1 = mid1; if (hi1 - lo1 <= 1u) { th1 = hi1; st1 = 2; } } }
        }
        if (__any(st0 == 2 || st1 == 2)) {
            int n0 = 0, n1 = 0;
#pragma unroll
            for (int jt = 0; jt < 64; ++jt) if (jt < ntiles) { n0 += (k0[jt] > th0) ? 1 : 0; n1 += (k1[jt] > th1) ? 1 : 0; }
            int need0 = TOPK - half_sum(n0), need1 = TOPK - half_sum(n1);
#pragma unroll
            for (int jt = 0; jt < 64; ++jt) if (jt < 2 * NTA) {
                unsigned m0 = 0u, m1 = 0u;
                if (jt < ntiles) {
                    const u64 g0 = __ballot(k0[jt] > th0), g1 = __ballot(k1[jt] > th1), e0 = __ballot(k0[jt] == th0 && st0 == 2), e1 = __ballot(k1[jt] == th1 && st1 == 2);
                    unsigned gg0 = g ? (unsigned)(g0 >> 32) : (unsigned)g0, gg1 = g ? (unsigned)(g1 >> 32) : (unsigned)g1, ee0 = g ? (unsigned)(e0 >> 32) : (unsigned)e0, ee1 = g ? (unsigned)(e1 >> 32) : (unsigned)e1;
                    { const int ne = __popc(ee0), tk = need0 < ne ? (need0 > 0 ? need0 : 0) : ne; unsigned r = ee0; while (__popc(r) > tk) r &= ~(0x80000000u >> __clz(r)); need0 -= tk; m0 = gg0 | r; }
                    { const int ne = __popc(ee1), tk = need1 < ne ? (need1 > 0 ? need1 : 0) : ne; unsigned r = ee1; while (__popc(r) > tk) r &= ~(0x80000000u >> __clz(r)); need1 -= tk; m1 = gg1 | r; }
                }
                if (c == 0) { mk[(jt >> 1) * 64 + qa0 + (jt & 1)] = m0; mk[(jt >> 1) * 64 + qa1 + (jt & 1)] = m1; }
            }
        } else {
#pragma unroll
            for (int jt = 0; jt < 64; ++jt) if (jt < 2 * NTA) {
                unsigned m0 = 0u, m1 = 0u;
                if (jt < ntiles) { const u64 g0 = __ballot(k0[jt] > th0), g1 = __ballot(k1[jt] > th1); m0 = g ? (unsigned)(g0 >> 32) : (unsigned)g0; m1 = g ? (unsigned)(g1 >> 32) : (unsigned)g1; }
                if (c == 0) { mk[(jt >> 1) * 64 + qa0 + (jt & 1)] = m0; mk[(jt >> 1) * 64 + qa1 + (jt & 1)] = m1; }
            }
        }
    }
    asm volatile("s_waitcnt lgkmcnt(0)\n\ts_barrier" ::: "memory");
}
}
__device__ __forceinline__ void ph_dsa(const Params& P, char* shm, int vcu, int G) {
    unsigned char* ws = P.ws; const int wid = threadIdx.x >> 6;
    for (int it = vcu; it < NB * 8; it += G) {
        const int b = it >> 3, j = it & 7; const size_t rowbase = (size_t)b * S;
#pragma unroll 1
        for (int k = 0; k < 8; ++k) { const int qt = (k & 1) ? (16 * (k >> 1) + 15 - j) : (16 * (k >> 1) + j);
            const int nt = qt / 2 + 1, NT = nt < 4 ? 4 : nt + (nt & 1);
            idx::indexer_tile(P, shm, b, qt, NT);
            const size_t tok = rowbase + qt * 32;
            att::attn_unit<1, 8>((const f16*)(ws + WS_QA) + tok * 512 + wid * 64, (const f16*)(ws + WS_KA) + rowbase * 64, (const f16*)(ws + WS_VA) + rowbase * 64, 64, NT, 0, 0.f,
                                 (f16*)(ws + WS_U) + tok * 1024 + wid * 64, (const f16*)(ws + WS_SGA) + tok * 512 + wid * 64, shm); }
    }
}
__global__ void __launch_bounds__(512, 2) k_dsa(Params P) { extern __shared__ __attribute__((aligned(16))) unsigned char lds[];
    const int G = gridDim.x, bx = blockIdx.x; ph_dsa(P, (char*)lds, (G % 8 == 0) ? (bx % 8) * (G / 8) + bx / 8 : bx, G); }

constexpr int ATT_LDS = att::LDS_BYTES;
__global__ void __launch_bounds__(512, 2) k_fox(Params P) { extern __shared__ __attribute__((aligned(16))) unsigned char lds[]; ph_fox(P, (char*)lds, blockIdx.x, gridDim.x); }
__global__ void __launch_bounds__(512, 2) k_dsa_attn(Params P) { extern __shared__ __attribute__((aligned(16))) unsigned char lds[];
    const int G = gridDim.x, bx = blockIdx.x; ph_dsa_attn(P, (char*)lds, (G % 8 == 0) ? (bx % 8) * (G / 8) + bx / 8 : bx, G); }

__device__ __forceinline__ float dot_h(const f16* a, const f16* b, int K) {
    float acc = 0.f;
    for (int k = 0; k < K; k += 8) { const f16x8 va = *(const f16x8*)(a + k), vb = *(const f16x8*)(b + k);
#pragma unroll
        for (int j = 0; j < 8; ++j) acc += (float)va[j] * (float)vb[j]; }
    return acc;
}
__global__ void __launch_bounds__(256) nv_gemm1(Params P) {
    unsigned char* ws = P.ws;
    const size_t idx = (size_t)blockIdx.x * 256 + threadIdx.x; if (idx >= (size_t)T * N1) return;
    const int t = (int)(idx / N1), n = (int)(idx % N1);
    const f16* h = (const f16*)(ws + WS_H16) + (size_t)t * D; const f16* W = (const f16*)(ws + WS_W1T);
    float v = dot_h(h, W + (size_t)n * D, D);
    const int pos = t & (S - 1);
    auto rope = [&](int d) -> float {
        const float v2 = dot_h(h, W + (size_t)(d < 8 ? n + 8 : n - 8) * D, D);
        const f32x2 cs = ((const f32x2*)(ws + WS_ROPE))[pos * 8 + (d & 7)];
        return d < 8 ? v * cs.x - v2 * cs.y : v * cs.x + v2 * cs.y; };
    if (n < P_QI) { const int d = n & 63; if (d < 16) v = rope(d); ((f16*)(ws + WS_QA))[(size_t)t * 512 + n] = (f16)(v * C2); return; }
    if (n < P_QB) { const int c = n - P_QI, d = c & 63; if (d < 16) v = rope(d); ((f16*)(ws + WS_QI))[(size_t)t * 512 + c] = (f16)v; return; }
    if (n < P_KB) { ((f16*)(ws + WS_QB))[(size_t)t * 512 + (n - P_QB)] = (f16)(v * C2); return; }
    if (n < P_VB) { ((f16*)(ws + WS_KB))[(size_t)t * 512 + (n - P_KB)] = (f16)v; return; }
    if (n < P_GA) { ((f16*)(ws + WS_VB))[(size_t)t * 512 + (n - P_VB)] = (f16)v; return; }
    if (n < P_GB) { ((f16*)(ws + WS_SGA))[(size_t)t * 512 + (n - P_GA)] = (f16)siluf_(v); return; }
    if (n < P_SM) { ((f16*)(ws + WS_SGB))[(size_t)t * 512 + (n - P_GB)] = (f16)siluf_(v); return; }
    if (n < P_MG) { const int c = n - P_SM;
        if (c < 64) { if (c < 16) v = rope(c); ((f16*)(ws + WS_KA))[(size_t)t * 64 + c] = (f16)v; }
        else if (c < 128) ((f16*)(ws + WS_VA))[(size_t)t * 64 + (c - 64)] = (f16)v;
        else if (c < 192) { const int d = c - 128; if (d < 16) v = rope(d); ((f16*)(ws + WS_KI))[(size_t)t * 64 + d] = (f16)v; }
        else if (c < 200) ((float*)(ws + WS_WI))[(size_t)t * 8 + (c - 192)] = v * IDX_SCALE;
        else if (c < 208) ((float*)(ws + WS_LOGF))[(size_t)t * 8 + (c - 200)] = logsigmoidf_(v + P.b_forget[c - 200]);
        return; }
    ((f16*)(ws + WS_MG))[(size_t)t * 2048 + (n - P_MG)] = (f16)sigmoidf_(v);
}
__global__ void nv_cumsum(Params P) {
    const int i = blockIdx.x * blockDim.x + threadIdx.x; if (i >= NB * 8) return;
    const int b = i >> 3, h = i & 7; const float* lf = (const float*)(P.ws + WS_LOGF); float* cs = (float*)(P.ws + WS_CSUM) + (size_t)i * S;
    float c = 0.f; for (int s = 0; s < S; ++s) { c += lf[((size_t)b * S + s) * 8 + h]; cs[s] = c * LOG2E; }
}
__global__ void __launch_bounds__(256) nv_fox(Params P) {
    unsigned char* ws = P.ws;
    const int idx = blockIdx.x * 256 + threadIdx.x; const int h = idx & 7, tok = idx >> 3, b = tok / S, t = tok % S;
    float q[64], o[64];
    { const f16* qp = (const f16*)(ws + WS_QB) + (size_t)tok * 512 + h * 64;
#pragma unroll
      for (int d = 0; d < 64; ++d) { q[d] = (float)qp[d]; o[d] = 0.f; } }
    const float* cs = (const float*)(ws + WS_CSUM) + (size_t)(b * 8 + h) * S; const float ct = cs[t];
    float m = -1e30f, l = 0.f;
    for (int s = 0; s <= t; ++s) {
        const f16* kp = (const f16*)(ws + WS_KB) + ((size_t)b * S + s) * 512 + h * 64; const f16* vp = (const f16*)(ws + WS_VB) + ((size_t)b * S + s) * 512 + h * 64;
        float d0 = 0.f;
#pragma unroll
        for (int d = 0; d < 64; ++d) d0 += q[d] * (float)kp[d];
        const float lg = d0 + (ct - cs[s]); const float mn = fmaxf(m, lg), f = exp2f(m - mn), pe = exp2f(lg - mn);
        l = l * f + pe; m = mn;
#pragma unroll
        for (int d = 0; d < 64; ++d) o[d] = o[d] * f + pe * (float)vp[d];
    }
    const float il = 1.f / l; const f16* sg = (const f16*)(ws + WS_SGB) + (size_t)tok * 512 + h * 64; f16* u = (f16*)(ws + WS_U) + (size_t)tok * 1024 + 512 + h * 64;
#pragma unroll
    for (int d = 0; d < 64; ++d) u[d] = (f16)(o[d] * il * (float)sg[d]);
}
__device__ __forceinline__ size_t mask_word(int b, int t, int s, int& bit) {
    bit = s & 63; return ((((size_t)b * 64 + (t >> 5)) * 32 + (s >> 6)) * 32 + (t & 31));
}
__global__ void __launch_bounds__(256) nv_indexer(Params P) {
    unsigned char* ws = P.ws;
    __shared__ f16 sq[512]; __shared__ float sw[8]; __shared__ unsigned skey[S]; __shared__ unsigned char sflag[S]; __shared__ unsigned scnt;
    const int tok = blockIdx.x, b = tok / S, t = tok % S, tid = threadIdx.x;
    if (tid < 64) ((f16x8*)sq)[tid] = ((const f16x8*)((const f16*)(ws + WS_QI) + (size_t)tok * 512))[tid];
    if (tid < 8) sw[tid] = ((const float*)(ws + WS_WI))[(size_t)tok * 8 + tid];
    __syncthreads();
    unsigned key[8];
#pragma unroll
    for (int i = 0; i < 8; ++i) { const int s = tid + 256 * i; key[i] = 0u; sflag[s] = 0;
        if (s <= t) { const f16* kp = (const f16*)(ws + WS_KI) + ((size_t)b * S + s) * 64; float sc = 0.f;
            for (int h = 0; h < 8; ++h) { float d0 = 0.f;
#pragma unroll
                for (int d = 0; d < 64; ++d) d0 += (float)sq[h * 64 + d] * (float)kp[d];
                sc += sw[h] * fmaxf(d0, 0.f); }
            key[i] = sortkey(sc); }
        skey[s] = key[i]; }
    auto count_gt = [&](unsigned x) -> unsigned { int c = 0;
#pragma unroll
        for (int i = 0; i < 8; ++i) c += (key[i] > x) ? 1 : 0;
        __syncthreads(); if (tid == 0) scnt = 0u; __syncthreads(); atomicAdd(&scnt, (unsigned)c); __syncthreads(); return scnt; };
    bool sel[8];
    if (t + 1 <= TOPK) {
#pragma unroll
        for (int i = 0; i < 8; ++i) sel[i] = (tid + 256 * i) <= t;
    } else {
        unsigned lo = 0u, hi = 0xFFFFFFFFu, thr = 0u; bool found = false;
        while (hi - lo > 1u) { const unsigned mid = lo + (hi - lo) / 2u; const unsigned c = count_gt(mid);
            if (c == (unsigned)TOPK) { thr = mid; found = true; break; } else if (c > (unsigned)TOPK) lo = mid; else hi = mid; }
        if (found) {
#pragma unroll
            for (int i = 0; i < 8; ++i) sel[i] = key[i] > thr;
        } else {
            const unsigned cg = count_gt(hi); int need = TOPK - (int)cg;
            if (tid == 0) { for (int s = 0; s <= t && need > 0; ++s) if (skey[s] == hi) { sflag[s] = 1; --need; } }
            __syncthreads();
#pragma unroll
            for (int i = 0; i < 8; ++i) sel[i] = key[i] > hi || (key[i] == hi && sflag[tid + 256 * i]);
        }
    }
#pragma unroll
    for (int i = 0; i < 8; ++i) if (sel[i]) { int bit; const size_t w = mask_word(b, t, tid + 256 * i, bit); atomicOr((u64*)(ws + WS_MASK) + w, 1ull << bit); }
}
__global__ void __launch_bounds__(256) nv_dsa(Params P) {
    unsigned char* ws = P.ws;
    const int idx = blockIdx.x * 256 + threadIdx.x; const int h = idx & 7, tok = idx >> 3, b = tok / S, t = tok % S;
    float q[64], o[64];
    { const f16* qp = (const f16*)(ws + WS_QA) + (size_t)tok * 512 + h * 64;
#pragma unroll
      for (int d = 0; d < 64; ++d) { q[d] = (float)qp[d]; o[d] = 0.f; } }
    float m = -1e30f, l = 0.f;
    for (int s = 0; s <= t; ++s) {
        int bit; const size_t w = mask_word(b, t, s, bit); if (!((((const u64*)(ws + WS_MASK))[w] >> bit) & 1ull)) continue;
        const f16* kp = (const f16*)(ws + WS_KA) + ((size_t)b * S + s) * 64; const f16* vp = (const f16*)(ws + WS_VA) + ((size_t)b * S + s) * 64;
        float d0 = 0.f;
#pragma unroll
        for (int d = 0; d < 64; ++d) d0 += q[d] * (float)kp[d];
        const float mn = fmaxf(m, d0), f = exp2f(m - mn), pe = exp2f(d0 - mn);
        l = l * f + pe; m = mn;
#pragma unroll
        for (int d = 0; d < 64; ++d) o[d] = o[d] * f + pe * (float)vp[d];
    }
    const float il = 1.f / l; const f16* sg = (const f16*)(ws + WS_SGA) + (size_t)tok * 512 + h * 64; f16* u = (f16*)(ws + WS_U) + (size_t)tok * 1024 + h * 64;
#pragma unroll
    for (int d = 0; d < 64; ++d) u[d] = (f16)(o[d] * il * (float)sg[d]);
}
__global__ void __launch_bounds__(256) nv_merged(Params P) {
    unsigned char* ws = P.ws; const size_t idx = (size_t)blockIdx.x * 256 + threadIdx.x; const int t = (int)(idx >> 10), n = (int)(idx & 1023);
    const f16* u = (const f16*)(ws + WS_U) + (size_t)t * 1024;
    const float ya = dot_h(u, (const f16*)(ws + WS_WBA) + (size_t)n * 512, 512), yb = dot_h(u + 512, (const f16*)(ws + WS_WBB) + (size_t)n * 512, 512);
    const f16* mg = (const f16*)(ws + WS_MG) + (size_t)t * 2048;
    ((f16*)(ws + WS_MERGED))[idx] = (f16)((float)mg[n] * ya + (float)mg[1024 + n] * yb);
}
__global__ void __launch_bounds__(256) nv_out(Params P) {
    unsigned char* ws = P.ws; const size_t idx = (size_t)blockIdx.x * 256 + threadIdx.x; const int t = (int)(idx >> 10), n = (int)(idx & 1023);
    const float v = dot_h((const f16*)(ws + WS_MERGED) + (size_t)t * 1024, (const f16*)(ws + WS_WO) + (size_t)n * 1024, 1024);
    ((f16*)(ws + WS_OUT16))[idx] = (f16)v; atomicAdd((float*)(ws + WS_ROWSQ) + t, v * v);
}
__device__ __forceinline__ void ew_x1(const Params& P, size_t gt, size_t GT) {
    unsigned char* ws = P.ws; const size_t n8 = (size_t)T * D / 8;
    for (size_t i = gt; i < n8; i += GT) { const int t = (int)(i >> 7), c8 = (int)(i & 127);
        const float rstd = rsqrtf(((const float*)(ws + WS_ROWSQ))[t] * (1.f / D) + EPS);
        const f16x8 o = ((const f16x8*)(ws + WS_OUT16))[i]; const f32x4 xa = ((const f32x4*)P.x)[2 * i], xb = ((const f32x4*)P.x)[2 * i + 1];
        const f32x4 ga = ((const f32x4*)P.g_post)[2 * c8], gb = ((const f32x4*)P.g_post)[2 * c8 + 1];
        f16x8 r; r[0] = (f16)(xa.x + (float)o[0] * rstd * ga.x); r[1] = (f16)(xa.y + (float)o[1] * rstd * ga.y); r[2] = (f16)(xa.z + (float)o[2] * rstd * ga.z); r[3] = (f16)(xa.w + (float)o[3] * rstd * ga.w);
        r[4] = (f16)(xb.x + (float)o[4] * rstd * gb.x); r[5] = (f16)(xb.y + (float)o[5] * rstd * gb.y); r[6] = (f16)(xb.z + (float)o[6] * rstd * gb.z); r[7] = (f16)(xb.w + (float)o[7] * rstd * gb.w);
        ((f16x8*)(ws + WS_X116))[i] = r; }
}
__global__ void __launch_bounds__(256) k_x1(Params P) { ew_x1(P, (size_t)blockIdx.x * 256 + threadIdx.x, (size_t)gridDim.x * 256); }
__global__ void __launch_bounds__(256) nv_gate(Params P) {
    unsigned char* ws = P.ws; const size_t idx = (size_t)blockIdx.x * 256 + threadIdx.x; const int t = (int)(idx >> 10), n = (int)(idx & 1023);
    const float gz = dot_h((const f16*)(ws + WS_X116) + (size_t)t * 1024, (const f16*)(ws + WS_WPG) + (size_t)n * 1024, 1024);
    const float e = dot_h((const f16*)(ws + WS_P16) + (size_t)t * DPLE, (const f16*)(ws + WS_WPLE) + (size_t)n * DPLE, DPLE);
    const float v = sigmoidf_(gz) * e; ((f16*)(ws + WS_V16))[idx] = (f16)v; atomicAdd((float*)(ws + WS_ROWSQ) + T + t, v * v);
}
__device__ __forceinline__ void ew_final(const Params& P, size_t gt, size_t GT) {
    unsigned char* ws = P.ws; const size_t n8 = (size_t)T * D / 8;
    for (size_t i = gt; i < n8; i += GT) { const int t = (int)(i >> 7), c8 = (int)(i & 127);
        const float r1 = rsqrtf(((const float*)(ws + WS_ROWSQ))[t] * (1.f / D) + EPS), r2 = rsqrtf(((const float*)(ws + WS_ROWSQ))[T + t] * (1.f / D) + EPS);
        const f16x8 o = ((const f16x8*)(ws + WS_OUT16))[i], v = ((const f16x8*)(ws + WS_V16))[i];
        const f32x4 xa = ((const f32x4*)P.x)[2 * i], xb = ((const f32x4*)P.x)[2 * i + 1];
        const f32x4 ga = ((const f32x4*)P.g_post)[2 * c8], gb = ((const f32x4*)P.g_post)[2 * c8 + 1], ha = ((const f32x4*)P.g_ple)[2 * c8], hb = ((const f32x4*)P.g_ple)[2 * c8 + 1];
        f32x4 ya, yb;
        ya.x = xa.x + (float)o[0] * r1 * ga.x + (float)v[0] * r2 * ha.x; ya.y = xa.y + (float)o[1] * r1 * ga.y + (float)v[1] * r2 * ha.y;
        ya.z = xa.z + (float)o[2] * r1 * ga.z + (float)v[2] * r2 * ha.z; ya.w = xa.w + (float)o[3] * r1 * ga.w + (float)v[3] * r2 * ha.w;
        yb.x = xb.x + (float)o[4] * r1 * gb.x + (float)v[4] * r2 * hb.x; yb.y = xb.y + (float)o[5] * r1 * gb.y + (float)v[5] * r2 * hb.y;
        yb.z = xb.z + (float)o[6] * r1 * gb.z + (float)v[6] * r2 * hb.z; yb.w = xb.w + (float)o[7] * r1 * gb.w + (float)v[7] * r2 * hb.w;
        ((f32x4*)P.out)[2 * i] = ya; ((f32x4*)P.out)[2 * i + 1] = yb; }
}
__global__ void __launch_bounds__(256) k_final(Params P) { ew_final(P, (size_t)blockIdx.x * 256 + threadIdx.x, (size_t)gridDim.x * 256); }


namespace cg = cooperative_groups;
__global__ void __launch_bounds__(512, 2) k_mega(Params P) {
    extern __shared__ __attribute__((aligned(16))) unsigned char lds[];
    cg::grid_group grid = cg::this_grid();
    const int G = gridDim.x, bx = blockIdx.x; const int vcu = (G % 8 == 0) ? (bx % 8) * (G / 8) + bx / 8 : bx;
    p0_prologue(P, (LAS unsigned char*)lds, bx, G);
    grid.sync();
    { pg8::Gemm g{(const f16*)(P.ws + WS_H16), (const f16*)(P.ws + WS_W1T), D, D, D}; pg8::StaticOrder So; So.init(T, N1, G, bx); EpiG1 E{P.ws, P.b_forget};
      pg8::gemm_phase<EpiG1>((LAS unsigned char*)lds, g, So, E); }
    grid.sync();
    ph_fox(P, (char*)lds, vcu, G);
    ph_dsa(P, (char*)lds, vcu, G);
    grid.sync();
    ph_merged(P, (LAS unsigned char*)lds, G, bx);
    grid.sync();
    ph_out(P, (LAS unsigned char*)lds, G, bx);
    grid.sync();
    ew_x1(P, (size_t)bx * 512 + threadIdx.x, (size_t)G * 512);
    grid.sync();
    ph_gate(P, (LAS unsigned char*)lds, G, bx);
    grid.sync();
    ew_final(P, (size_t)bx * 512 + threadIdx.x, (size_t)G * 512);
}

extern "C" void kernel_launch(void* const* d_in, const int* in_sizes, int n_in, void* d_out, int out_size, void* d_ws, size_t ws_size, hipStream_t stream) {
    if (n_in != 13 || in_sizes[0] != T * D || out_size != T * D || ws_size < WS_END) { fprintf(stderr, "kernel_launch: unexpected shapes / workspace (n_in %d, ws %zu < %zu)\n", n_in, ws_size, (size_t)WS_END); return; }
    Params P{};
    P.x = (const float*)d_in[0]; P.p = (const float*)d_in[1]; P.w_in = (const float*)d_in[2]; P.b_forget = (const float*)d_in[3]; P.w_ba = (const float*)d_in[4]; P.w_bb = (const float*)d_in[5];
    P.w_merge = (const float*)d_in[6]; P.w_out = (const float*)d_in[7]; P.g_pre = (const float*)d_in[8]; P.g_post = (const float*)d_in[9]; P.w_ple = (const float*)d_in[10]; P.w_pg = (const float*)d_in[11]; P.g_ple = (const float*)d_in[12];
    P.out = (float*)d_out; P.ws = (unsigned char*)d_ws;
#if USE_MEGA
    static int grid_blocks = 0;
    if (!grid_blocks) {
        int dev = 0, cus = 0, per_cu = 0;
        (void)hipGetDevice(&dev); (void)hipDeviceGetAttribute(&cus, hipDeviceAttributeMultiprocessorCount, dev);
        if (hipFuncSetAttribute((const void*)k_mega, hipFuncAttributeMaxDynamicSharedMemorySize, GEMM_LDS) != hipSuccess) { fprintf(stderr, "kernel_launch: hipFuncSetAttribute failed\n"); grid_blocks = -1; return; }
        if (hipOccupancyMaxActiveBlocksPerMultiprocessor(&per_cu, (const void*)k_mega, 512, GEMM_LDS) != hipSuccess || per_cu < 1) { fprintf(stderr, "kernel_launch: occupancy query failed (%d)\n", per_cu); grid_blocks = -1; return; }
        grid_blocks = cus * per_cu;
    }
    if (grid_blocks < 0) return;
    void* args[] = {&P};
    const hipError_t e = hipLaunchCooperativeKernel((const void*)k_mega, dim3(grid_blocks), dim3(512), args, GEMM_LDS, stream);
    if (e != hipSuccess) fprintf(stderr, "cooperative launch failed: %s (grid %d)\n", hipGetErrorString(e), grid_blocks);
#else
    static bool attr = false;
    if (!attr) { (void)hipFuncSetAttribute((const void*)k_p0, hipFuncAttributeMaxDynamicSharedMemorySize, 8 * 8704); (void)hipFuncSetAttribute((const void*)k_gemm1, hipFuncAttributeMaxDynamicSharedMemorySize, GEMM_LDS);
        (void)hipFuncSetAttribute((const void*)k_merged, hipFuncAttributeMaxDynamicSharedMemorySize, GEMM_LDS); (void)hipFuncSetAttribute((const void*)k_out, hipFuncAttributeMaxDynamicSharedMemorySize, GEMM_LDS); (void)hipFuncSetAttribute((const void*)k_gate, hipFuncAttributeMaxDynamicSharedMemorySize, GEMM_LDS);
        (void)hipFuncSetAttribute((const void*)k_fox, hipFuncAttributeMaxDynamicSharedMemorySize, ATT_LDS); (void)hipFuncSetAttribute((const void*)k_dsa_attn, hipFuncAttributeMaxDynamicSharedMemorySize, ATT_LDS); (void)hipFuncSetAttribute((const void*)k_dsa, hipFuncAttributeMaxDynamicSharedMemorySize, ATT_LDS); attr = true; }
    hipLaunchKernelGGL(k_p0, dim3(256), dim3(512), 8 * 8704, stream, P);
#if USE_NV_GEMM1
    hipLaunchKernelGGL(nv_gemm1, dim3((unsigned)(((size_t)T * N1 + 255) / 256)), dim3(256), 0, stream, P);
#else
    hipLaunchKernelGGL(k_gemm1, dim3(256), dim3(512), GEMM_LDS, stream, P);
#endif
#if USE_NV_FOX
    hipLaunchKernelGGL(nv_cumsum, dim3(1), dim3(256), 0, stream, P);
    hipLaunchKernelGGL(nv_fox, dim3(T * 8 / 256), dim3(256), 0, stream, P);
#else
    hipLaunchKernelGGL(k_fox, dim3(256), dim3(512), ATT_LDS, stream, P);
#endif
#if USE_NV_IDX
    hipLaunchKernelGGL(nv_indexer, dim3(T), dim3(256), 0, stream, P);
#if USE_NV_DSA
    hipLaunchKernelGGL(nv_dsa, dim3(T * 8 / 256), dim3(256), 0, stream, P);
#else
    hipLaunchKernelGGL(k_dsa_attn, dim3(256), dim3(512), ATT_LDS, stream, P);
#endif
#else
    hipLaunchKernelGGL(k_dsa, dim3(256), dim3(512), ATT_LDS, stream, P);
#endif
#if USE_NV_POST
    hipLaunchKernelGGL(nv_merged, dim3(T * 1024 / 256), dim3(256), 0, stream, P);
    hipLaunchKernelGGL(nv_out, dim3(T * 1024 / 256), dim3(256), 0, stream, P);
#else
    hipLaunchKernelGGL(k_merged, dim3(256), dim3(512), GEMM_LDS, stream, P);
    hipLaunchKernelGGL(k_out, dim3(256), dim3(512), GEMM_LDS, stream, P);
#endif
    hipLaunchKernelGGL(k_x1, dim3(2048), dim3(256), 0, stream, P);
#if USE_NV_POST
    hipLaunchKernelGGL(nv_gate, dim3(T * 1024 / 256), dim3(256), 0, stream, P);
#else
    hipLaunchKernelGGL(k_gate, dim3(256), dim3(512), GEMM_LDS, stream, P);
#endif
    hipLaunchKernelGGL(k_final, dim3(2048), dim3(256), 0, stream, P);
#endif
}
```

```cpp
#include <hip/hip_runtime.h>
#include <hip/hip_cooperative_groups.h>
#include <cstdio>
#include <cstdint>
#ifndef PROBE_DUP
#define PROBE_DUP 0
#endif
#ifndef USE_MEGA
#define USE_MEGA 1
#endif
#ifndef USE_NV_IDX
#define USE_NV_IDX 0
#endif
#ifndef USE_NV_FOX
#define USE_NV_FOX 0
#endif
#ifndef USE_NV_DSA
#define USE_NV_DSA 0
#endif
#ifndef USE_NV_POST
#define USE_NV_POST 0
#endif
#ifndef USE_NV_GEMM1
#define USE_NV_GEMM1 0
#endif

typedef _Float16 f16;
typedef _Float16 f16x2 __attribute__((ext_vector_type(2)));
typedef _Float16 f16x4 __attribute__((ext_vector_type(4)));
typedef _Float16 f16x8 __attribute__((ext_vector_type(8)));
typedef float f32x2 __attribute__((ext_vector_type(2)));
typedef float f32x4 __attribute__((ext_vector_type(4)));
typedef float f32x16 __attribute__((ext_vector_type(16)));
typedef unsigned u32x2 __attribute__((ext_vector_type(2)));
typedef unsigned u32x4 __attribute__((ext_vector_type(4)));
typedef unsigned long long u64;
#define LAS __attribute__((address_space(3)))

constexpr int NB = 32, S = 2048, T = NB * S, D = 1024, DPLE = 256, DIN = 3792;
constexpr int N1 = 5888;
constexpr int TOPK = 256;
constexpr float EPS = 1e-6f;
constexpr float LOG2E = 1.4426950408889634f;
constexpr float C2 = 0.125f * 1.4426950408889634f;
constexpr float IDX_SCALE = 0.044194173824159216f;
constexpr int O_QA = 0, O_KA = 512, O_VA = 576, O_GA = 640, O_QI = 1152, O_KI = 1664, O_WI = 1728, O_QB = 1736, O_KB = 2248, O_VB = 2760, O_FB = 3272, O_GB = 3280;
constexpr int P_QA = 0, P_QI = 512, P_QB = 1024, P_KB = 1536, P_VB = 2048, P_GA = 2560, P_GB = 3072, P_SM = 3584, P_MG = 3840;

constexpr size_t MiB = 1u << 20;
constexpr size_t WS_CTL = 0, WS_ROPE = 1 * MiB, WS_W1T = 2 * MiB, WS_WBA = 14 * MiB, WS_WBB = 15 * MiB, WS_WO = 16 * MiB, WS_WPG = 18 * MiB, WS_WPLE = 20 * MiB,
                 WS_ROWSQ = 21 * MiB, WS_WI = 22 * MiB, WS_LOGF = 24 * MiB, WS_CSUM = 26 * MiB, WS_KA = 28 * MiB, WS_VA = 36 * MiB, WS_KI = 44 * MiB, WS_MASK = 52 * MiB,
                 WS_P16 = 68 * MiB, WS_H16 = 100 * MiB, WS_U = 100 * MiB  , WS_MG = 228 * MiB,
                 WS_QA = 484 * MiB, WS_QI = 548 * MiB, WS_QB = 612 * MiB, WS_KB = 676 * MiB, WS_VB = 740 * MiB, WS_SGA = 804 * MiB, WS_SGB = 868 * MiB, WS_END = 932 * MiB,
                 WS_MERGED = 484 * MiB  , WS_OUT16 = 612 * MiB  , WS_X116 = 740 * MiB  , WS_E16 = 356 * MiB  , WS_V16 = 228 * MiB  ;

struct Params {
    const float *x, *p, *w_in, *b_forget, *w_ba, *w_bb, *w_merge, *w_out, *g_pre, *g_post, *w_ple, *w_pg, *g_ple;
    float* out; unsigned char* ws;
};

__device__ __forceinline__ float wave_sum(float v) {
#pragma unroll
    for (int o = 1; o < 64; o <<= 1) v += __shfl_xor(v, o);
    return v;
}
__device__ __forceinline__ float sigmoidf_(float z) { return __builtin_amdgcn_rcpf(1.0f + __builtin_amdgcn_exp2f(z * -LOG2E)); }
__device__ __forceinline__ float siluf_(float z) { return z * __builtin_amdgcn_rcpf(1.0f + __builtin_amdgcn_exp2f(z * -LOG2E)); }
__device__ __forceinline__ float logsigmoidf_(float z) { return fminf(z, 0.f) - log1pf(__expf(-fabsf(z))); }
__device__ __forceinline__ unsigned sortkey(float f) { const unsigned u = __float_as_uint(f); return (u & 0x80000000u) ? ~u : (u | 0x80000000u); }

__device__ __forceinline__ int w1_src(int n, int& which) {
    which = 0;
    if (n < P_QI) return O_QA + n;
    if (n < P_QB) return O_QI + (n - P_QI);
    if (n < P_KB) return O_QB + (n - P_QB);
    if (n < P_VB) return O_KB + (n - P_KB);
    if (n < P_GA) return O_VB + (n - P_VB);
    if (n < P_GB) return O_GA + (n - P_GA);
    if (n < P_SM) return O_GB + (n - P_GB);
    if (n < P_MG) { const int c = n - P_SM;
        if (c < 64) return O_KA + c; if (c < 128) return O_VA + (c - 64); if (c < 192) return O_KI + (c - 128);
        if (c < 200) return O_WI + (c - 192); if (c < 208) return O_FB + (c - 200); which = -1; return 0; }
    which = 1; return n - P_MG;
}

__device__ __forceinline__ void tr_item(const float* src, int ldw, f16* WT, int K, int n0, int k0, LAS float* scr, int lane) {
#pragma unroll 8
    for (int i = 0; i < 32; ++i) { const int kk = 2 * i + (lane >> 5); scr[kk * 33 + (lane & 31)] = src ? src[(size_t)(k0 + kk) * ldw] : 0.f; }
    asm volatile("s_waitcnt lgkmcnt(0)" ::: "memory");
    const int c = lane & 7;
#pragma unroll
    for (int j = 0; j < 4; ++j) { const int n = (lane >> 3) + 8 * j; const LAS float* s = scr + (8 * c) * 33 + n;
        f16x8 o;
#pragma unroll
        for (int e = 0; e < 8; ++e) o[e] = (f16)s[e * 33];
        *(f16x8*)(WT + (size_t)(n0 + n) * K + k0 + 8 * c) = o; }
    asm volatile("s_waitcnt lgkmcnt(0)" ::: "memory");
}
__device__ __forceinline__ void sincos_d(double a, float& sn, float& cs) {
    const double TWO_PI = 6.283185307179586476925, INV = 0.15915494309189533576888;
    double r = a - rint(a * INV) * TWO_PI;
    const double HALF_PI = 1.57079632679489661923;
    const double qd = rint(r / HALF_PI); const int q = ((int)qd) & 3; const double y = r - qd * HALF_PI, y2 = y * y;
    const double s = y * (1.0 + y2 * (-1.0 / 6 + y2 * (1.0 / 120 + y2 * (-1.0 / 5040 + y2 * (1.0 / 362880 + y2 * (-1.0 / 39916800 + y2 * (1.0 / 6227020800.0)))))));
    const double c = 1.0 + y2 * (-0.5 + y2 * (1.0 / 24 + y2 * (-1.0 / 720 + y2 * (1.0 / 40320 + y2 * (-1.0 / 3628800 + y2 * (1.0 / 479001600.0 + y2 * (-1.0 / 87178291200.0)))))));
    double so, co;
    if (q == 0) { so = s; co = c; } else if (q == 1) { so = c; co = -s; } else if (q == 2) { so = -s; co = -c; } else { so = -c; co = s; }
    sn = (float)so; cs = (float)co;
}
__device__ __forceinline__ void p0_prologue(const Params& P, LAS unsigned char* lds, int vcu, int G) {
    const int tid = threadIdx.x, lane = tid & 63, wave = tid >> 6, NW = blockDim.x >> 6;
    LAS float* scr = (LAS float*)(lds + wave * 8704);
    const int gw = vcu * NW + wave, NGW = G * NW;
    unsigned char* ws = P.ws;
    constexpr int I_W1 = (N1 / 32) * (D / 64), I_BA = (D / 32) * (512 / 64), I_WO = (D / 32) * (D / 64), I_PLE = (D / 32) * (DPLE / 64);
    constexpr int NITEMS = I_W1 + 2 * I_BA + 2 * I_WO + I_PLE;
    for (int it = gw; it < NITEMS; it += NGW) {
        int r = it;
        if (r < I_W1) { const int nb = r % (N1 / 32), kb = r / (N1 / 32); int which; const int sc = w1_src(nb * 32 + (lane & 31), which);
            const float* src = which == 0 ? P.w_in + sc : (which == 1 ? P.w_merge + sc : nullptr);
            tr_item(src, which == 1 ? 2048 : DIN, (f16*)(ws + WS_W1T), D, nb * 32, kb * 64, scr, lane); continue; }
        r -= I_W1;
        if (r < I_BA) { const int nb = r % 32, kb = r / 32; tr_item(P.w_ba + nb * 32 + (lane & 31), D, (f16*)(ws + WS_WBA), 512, nb * 32, kb * 64, scr, lane); continue; }
        r -= I_BA;
        if (r < I_BA) { const int nb = r % 32, kb = r / 32; tr_item(P.w_bb + nb * 32 + (lane & 31), D, (f16*)(ws + WS_WBB), 512, nb * 32, kb * 64, scr, lane); continue; }
        r -= I_BA;
        if (r < I_WO) { const int nb = r % 32, kb = r / 32; tr_item(P.w_out + nb * 32 + (lane & 31), D, (f16*)(ws + WS_WO), D, nb * 32, kb * 64, scr, lane); continue; }
        r -= I_WO;
        if (r < I_WO) { const int nb = r % 32, kb = r / 32; tr_item(P.w_pg + nb * 32 + (lane & 31), D, (f16*)(ws + WS_WPG), D, nb * 32, kb * 64, scr, lane); continue; }
        r -= I_WO;
        { const int nb = r % 32, kb = r / 32; tr_item(P.w_ple + nb * 32 + (lane & 31), D, (f16*)(ws + WS_WPLE), DPLE, nb * 32, kb * 64, scr, lane); }
    }
    {
        f32x4 g[4];
#pragma unroll
        for (int j = 0; j < 4; ++j) g[j] = ((const f32x4*)P.g_pre)[64 * j + lane];
        for (int m = gw; m < T; m += NGW) {
            const f32x4* xr = (const f32x4*)(P.x + (size_t)m * D) + lane;
            f32x4 v[4]; float s2 = 0.f;
#pragma unroll
            for (int j = 0; j < 4; ++j) { v[j] = xr[64 * j]; s2 += (v[j].x * v[j].x + v[j].y * v[j].y) + (v[j].z * v[j].z + v[j].w * v[j].w); }
            const float rstd = rsqrtf(wave_sum(s2) * (1.f / D) + EPS);
            f16x4* o = (f16x4*)((f16*)(ws + WS_H16) + (size_t)m * D) + lane;
#pragma unroll
            for (int j = 0; j < 4; ++j) { f16x4 h; h[0] = (f16)(v[j].x * rstd * g[j].x); h[1] = (f16)(v[j].y * rstd * g[j].y); h[2] = (f16)(v[j].z * rstd * g[j].z); h[3] = (f16)(v[j].w * rstd * g[j].w); o[64 * j] = h; }
        }
    }
    {
        const size_t n8 = (size_t)T * DPLE / 8; const size_t gt = (size_t)vcu * blockDim.x + tid, GT = (size_t)G * blockDim.x;
        for (size_t i = gt; i < n8; i += GT) { const f32x4 a = ((const f32x4*)P.p)[2 * i], b = ((const f32x4*)P.p)[2 * i + 1];
            f16x8 o; o[0] = (f16)a.x; o[1] = (f16)a.y; o[2] = (f16)a.z; o[3] = (f16)a.w; o[4] = (f16)b.x; o[5] = (f16)b.y; o[6] = (f16)b.z; o[7] = (f16)b.w;
            ((f16x8*)(ws + WS_P16))[i] = o; }
        for (size_t i = gt; i < (size_t)S * 8; i += GT) { const int pos = (int)(i >> 3), fi = (int)(i & 7);
            const float frf = fi == 0 ? 1.0f : fi == 1 ? 0.19392274474868576f : fi == 2 ? 0.03760603093086393f : fi == 3 ? 0.007292664737217109f : fi == 4 ? 0.001414213562373095f
                            : fi == 5 ? 0.0002742481756762073f : fi == 6 ? 5.318295896944988e-05f : 1.031338537721246e-05f;
            const float ang = (float)pos * frf;
            float sn, cs; sincos_d((double)ang, sn, cs); ((f32x2*)(ws + WS_ROPE))[i] = (f32x2){cs, sn}; }
        for (size_t i = gt; i < (size_t)2 * T; i += GT) ((float*)(ws + WS_ROWSQ))[i] = 0.f;
#if USE_NV_IDX
        for (size_t i = gt; i < (size_t)16 * MiB / 16; i += GT) ((u32x4*)(ws + WS_MASK))[i] = (u32x4){0u, 0u, 0u, 0u};
#endif
    }
}
__global__ void __launch_bounds__(512) k_p0(Params P) {
    extern __shared__ __attribute__((aligned(16))) unsigned char lds[];
    p0_prologue(P, (LAS unsigned char*)lds, blockIdx.x, gridDim.x);
}


namespace pg8 {
constexpr int BM = 256, BK = 64, HALF = 128, HTB = HALF * BK * 2, STAGE_BYTES = 8 * HTB, NXCD = 8, WGM = 8;
__host__ __device__ __forceinline__ int lds_byte(int r, int c) { const int st = (r >> 4) * 2 + (c >> 5), rr = r & 15, cc = c & 31, ob = rr * 64 + cc * 2; return st * 1024 + (ob ^ (((ob >> 9) & 1) << 5)); }
__host__ __device__ __forceinline__ void stage_rc(int b, int& R, int& C) { const int st = b / 1024, sb = b % 1024, swz = sb ^ (((sb >> 9) & 1) << 5); R = (st >> 1) * 16 + swz / 64; C = (st & 1) * 32 + (swz % 64) / 2; }
__host__ __device__ __forceinline__ int perm32(int rho) { const int n = rho >> 4, i = rho & 15; return 8 * (i >> 2) + 4 * n + (i & 3); }
struct Unit { int pm, pn; };
struct Gemm { const f16* A; const f16* Bt; int lda, ldb, K; };
struct StaticOrder {
    int nM, nN, nwg, G, c;
    __host__ __device__ void init(int M, int N, int G_, int c_) { nM = M / BM; nN = N / BM; nwg = nM * nN; G = G_; c = c_; }
    __host__ __device__ bool next(int i, Unit& u) const {
        const long L = (long)i * G + c; if (L >= nwg) return false;
        int wgid = (int)L; { const int q = nwg / NXCD, r = nwg % NXCD, xcd = wgid % NXCD, off = wgid / NXCD; wgid = (xcd < r ? xcd * (q + 1) : r * (q + 1) + (xcd - r) * q) + off; }
        const int nig = WGM * nN, gid = wgid / nig, fm = gid * WGM, gsz = (nM - fm) < WGM ? (nM - fm) : WGM;
        u.pm = fm + ((wgid % nig) % gsz); u.pn = (wgid % nig) / gsz; return true;
    }
};
template <class Epi>
__device__ __forceinline__ void gemm_phase(LAS unsigned char* lds, const Gemm g, const StaticOrder& S, const Epi& E) {
    int tid = threadIdx.x; asm volatile("" : "+v"(tid));
    const int wid = __builtin_amdgcn_readfirstlane(tid >> 6), lane = tid & 63, wr = wid >> 2, wc = wid & 3, fr = lane & 15, fq = lane >> 4;
    const int nt = g.K / BK;
    unsigned voffA[2], voffB[2];
#pragma unroll
    for (int i = 0; i < 2; ++i) { int R, C; stage_rc(tid * 16 + i * 8192, R, C); const int Rb = (R & ~31) + perm32(R & 31);
        voffA[i] = (unsigned)(R * g.lda + C) * 2u; voffB[i] = (unsigned)(Rb * g.ldb + C) * 2u; }
    const size_t kstep = (size_t)(BK * 2);
    const size_t hstepA = (size_t)HALF * g.lda * 2, hstepB = (size_t)HALF * g.ldb * 2, tstepA = 2 * hstepA, tstepB = 2 * hstepB;
    const unsigned ldsw = (unsigned)wid * 1024u;
    const int aoff = lds_byte(wr * 64 + fr, fq * 8), boff = lds_byte(wc * 32 + fr, fq * 8);
#define PG8_SA(b, h) (((b) * 2 + (h)) * HTB)
#define PG8_SB(b, h) ((4 + (b) * 2 + (h)) * HTB)
#define PG8_STAGE(bufoff, gbase, voff) do { _Pragma("unroll") for (int _i = 0; _i < 2; ++_i) \
        __builtin_amdgcn_global_load_lds((const unsigned*)((const char*)(gbase) + (voff)[_i]), (LAS unsigned*)(lds + (bufoff) + ldsw + _i * 8192), 16, 0, 0); } while (0)
#define PG8_LDA(dst, b, h) do { _Pragma("unroll") for (int m = 0; m < 4; ++m) _Pragma("unroll") for (int k = 0; k < 2; ++k) dst[m][k] = *(const LAS f16x8*)(lds + PG8_SA(b, h) + aoff + m * 2048 + k * 1024); } while (0)
#define PG8_LDB(dst, b, h) do { _Pragma("unroll") for (int n = 0; n < 2; ++n) _Pragma("unroll") for (int k = 0; k < 2; ++k) dst[n][k] = *(const LAS f16x8*)(lds + PG8_SB(b, h) + boff + n * 2048 + k * 1024); } while (0)
#define PG8_MMA(ai, bj, At, Bt) do { __builtin_amdgcn_s_setprio(1); _Pragma("unroll") for (int m = 0; m < 4; ++m) _Pragma("unroll") for (int n = 0; n < 2; ++n) _Pragma("unroll") for (int k = 0; k < 2; ++k) \
        acc[ai][bj][m][n] = __builtin_amdgcn_mfma_f32_16x16x32_f16(Bt[n][k], At[m][k], acc[ai][bj][m][n], 0, 0, 0); __builtin_amdgcn_s_setprio(0); } while (0)
#define PG8_WAIT_V(n) asm volatile("s_waitcnt vmcnt(" #n ")" ::: "memory")
#define PG8_WAIT_L(n) asm volatile("s_waitcnt lgkmcnt(" #n ")" ::: "memory")
#define PG8_BAR __builtin_amdgcn_s_barrier()
#define PG8_SCHED __builtin_amdgcn_sched_barrier(0)
    Unit cur, nxt; int ui = 0;
    if (!S.next(0, cur)) return;
    f32x4 acc[2][2][4][2];
#pragma unroll
    for (int a = 0; a < 2; ++a)
#pragma unroll
        for (int b = 0; b < 2; ++b)
#pragma unroll
            for (int m = 0; m < 4; ++m)
#pragma unroll
                for (int n = 0; n < 2; ++n) acc[a][b][m][n] = (f32x4){0.f, 0.f, 0.f, 0.f};
    f16x8 At[4][2], B0[2][2], B1[2][2];
    const char* cA = (const char*)g.A + (size_t)cur.pm * tstepA; const char* cB = (const char*)g.Bt + (size_t)cur.pn * tstepB;
    PG8_STAGE(PG8_SB(0, 0), cB, voffB); PG8_STAGE(PG8_SB(0, 1), cB + hstepB, voffB); PG8_STAGE(PG8_SA(0, 0), cA, voffA); PG8_STAGE(PG8_SA(0, 1), cA + hstepA, voffA);
    if (wr == 1) PG8_BAR;
    PG8_WAIT_V(2); PG8_BAR;
    PG8_STAGE(PG8_SB(1, 0), cB + kstep, voffB); PG8_STAGE(PG8_SA(1, 0), cA + kstep, voffA); PG8_STAGE(PG8_SB(1, 1), cB + hstepB + kstep, voffB);
    PG8_WAIT_V(6); PG8_BAR;
    for (;;) {
        const bool has_next = S.next(ui + 1, nxt);
        const char* nA = has_next ? (const char*)g.A + (size_t)nxt.pm * tstepA : cA; const char* nB = has_next ? (const char*)g.Bt + (size_t)nxt.pn * tstepB : cB;
#pragma unroll 1
        for (int t = 0; t < nt; t += 2) {
            const bool last = (t == nt - 2);
            const char* a1 = cA + (size_t)(t + 1) * kstep;
            const char* a2 = last ? nA : cA + (size_t)(t + 2) * kstep; const char* b2 = last ? nB : cB + (size_t)(t + 2) * kstep;
            const char* a3 = a2 + kstep; const char* b3 = b2 + kstep;
            PG8_LDB(B0, 0, 0); PG8_LDB(B1, 0, 1); PG8_SCHED; PG8_LDA(At, 0, 0); PG8_STAGE(PG8_SA(1, 1), a1 + hstepA, voffA);
            PG8_WAIT_V(8); PG8_WAIT_L(0); PG8_BAR; PG8_MMA(0, 0, At, B0); PG8_MMA(0, 1, At, B1); PG8_BAR; PG8_SCHED;
            PG8_LDA(At, 0, 1); PG8_STAGE(PG8_SB(0, 0), b2, voffB); PG8_STAGE(PG8_SB(0, 1), b2 + hstepB, voffB); PG8_STAGE(PG8_SA(0, 0), a2, voffA);
            PG8_WAIT_V(8); PG8_WAIT_L(0); PG8_BAR; PG8_MMA(1, 0, At, B0); PG8_MMA(1, 1, At, B1); PG8_BAR; PG8_SCHED;
            PG8_LDB(B0, 1, 0); PG8_LDB(B1, 1, 1); PG8_SCHED; PG8_LDA(At, 1, 0); PG8_STAGE(PG8_SA(0, 1), a2 + hstepA, voffA);
            PG8_WAIT_V(8); PG8_WAIT_L(0); PG8_BAR; PG8_MMA(0, 0, At, B0); PG8_MMA(0, 1, At, B1); PG8_BAR; PG8_SCHED;
            PG8_LDA(At, 1, 1); PG8_STAGE(PG8_SB(1, 0), b3, voffB); PG8_STAGE(PG8_SB(1, 1), b3 + hstepB, voffB); PG8_STAGE(PG8_SA(1, 0), a3, voffA);
            PG8_WAIT_V(8); PG8_WAIT_L(0); PG8_BAR; PG8_MMA(1, 0, At, B0); PG8_MMA(1, 1, At, B1); PG8_BAR; PG8_SCHED;
        }
        if (wr == 0) PG8_BAR;
        E(acc, cur, wr, wc, fr, fq);
        if (!has_next) break;
#pragma unroll
        for (int a = 0; a < 2; ++a)
#pragma unroll
            for (int b = 0; b < 2; ++b)
#pragma unroll
                for (int m = 0; m < 4; ++m)
#pragma unroll
                    for (int n = 0; n < 2; ++n) acc[a][b][m][n] = (f32x4){0.f, 0.f, 0.f, 0.f};
        cur = nxt; cA = nA; cB = nB; ++ui;
        if (wr == 1) PG8_BAR;
    }
    PG8_WAIT_V(0);
    PG8_BAR;
#undef PG8_SA
#undef PG8_SB
#undef PG8_STAGE
#undef PG8_LDA
#undef PG8_LDB
#undef PG8_MMA
#undef PG8_WAIT_V
#undef PG8_WAIT_L
#undef PG8_BAR
#undef PG8_SCHED
}
}

__device__ __forceinline__ f16x8 pack8(const f32x4 a, const f32x4 b) { f16x8 o; o[0] = (f16)a[0]; o[1] = (f16)a[1]; o[2] = (f16)a[2]; o[3] = (f16)a[3]; o[4] = (f16)b[0]; o[5] = (f16)b[1]; o[6] = (f16)b[2]; o[7] = (f16)b[3]; return o; }

struct EpiG1 {
    unsigned char* ws; const float* b_forget;
    __device__ __forceinline__ void operator()(const f32x4 (&acc)[2][2][4][2], const pg8::Unit& u, int wr, int wc, int fr, int fq) const {
        const int pn = u.pn; const int row0 = u.pm * 256 + wr * 64 + fr;
        f16* dst; int ld, colb, mode; bool rope = false;
        if (pn < 2) { dst = (f16*)(ws + WS_QA); ld = 512; colb = 256 * pn; mode = 1; rope = !(wc & 1); }
        else if (pn < 4) { dst = (f16*)(ws + WS_QI); ld = 512; colb = 256 * (pn - 2); mode = 0; rope = !(wc & 1); }
        else if (pn < 6) { dst = (f16*)(ws + WS_QB); ld = 512; colb = 256 * (pn - 4); mode = 1; }
        else if (pn < 8) { dst = (f16*)(ws + WS_KB); ld = 512; colb = 256 * (pn - 6); mode = 0; }
        else if (pn < 10) { dst = (f16*)(ws + WS_VB); ld = 512; colb = 256 * (pn - 8); mode = 0; }
        else if (pn < 12) { dst = (f16*)(ws + WS_SGA); ld = 512; colb = 256 * (pn - 10); mode = 2; }
        else if (pn < 14) { dst = (f16*)(ws + WS_SGB); ld = 512; colb = 256 * (pn - 12); mode = 2; }
        else if (pn == 14) { dst = nullptr; ld = 64; colb = 0; mode = 4; rope = (wc == 0); }
        else { dst = (f16*)(ws + WS_MG); ld = 2048; colb = 256 * (pn - 15); mode = 3; }
#pragma unroll
        for (int ai = 0; ai < 2; ++ai)
#pragma unroll
            for (int m = 0; m < 4; ++m) {
                const int row = row0 + ai * 128 + m * 16; const int pos = row & (S - 1);
#pragma unroll
                for (int bj = 0; bj < 2; ++bj) {
                    f32x4 v0 = acc[ai][bj][m][0], v1 = acc[ai][bj][m][1];
                    if (rope) {
                        f32x4 p0, p1;
#pragma unroll
                        for (int e = 0; e < 4; ++e) { p0[e] = __shfl_xor(v0[e], 16); p1[e] = __shfl_xor(v1[e], 16); }
                        if (fq < 2) { const f32x4* rp = (const f32x4*)(ws + WS_ROPE) + pos * 4; const f32x4 c01 = rp[0], c23 = rp[1], c45 = rp[2], c67 = rp[3];
                            const float sg = fq == 0 ? -1.f : 1.f;
                            v0[0] = v0[0] * c01[0] + sg * p0[0] * c01[1]; v0[1] = v0[1] * c01[2] + sg * p0[1] * c01[3]; v0[2] = v0[2] * c23[0] + sg * p0[2] * c23[1]; v0[3] = v0[3] * c23[2] + sg * p0[3] * c23[3];
                            v1[0] = v1[0] * c45[0] + sg * p1[0] * c45[1]; v1[1] = v1[1] * c45[2] + sg * p1[1] * c45[3]; v1[2] = v1[2] * c67[0] + sg * p1[2] * c67[1]; v1[3] = v1[3] * c67[2] + sg * p1[3] * c67[3]; }
                    }
                    const int c = bj * 128 + wc * 32 + fq * 8;
                    if (mode == 4) {
                        if (c < 64) *(f16x8*)((f16*)(ws + WS_KA) + (size_t)row * 64 + c) = pack8(v0, v1);
                        else if (c < 128) *(f16x8*)((f16*)(ws + WS_VA) + (size_t)row * 64 + (c - 64)) = pack8(v0, v1);
                        else if (c < 192) *(f16x8*)((f16*)(ws + WS_KI) + (size_t)row * 64 + (c - 128)) = pack8(v0, v1);
                        else if (c == 192) { f32x4* o = (f32x4*)((float*)(ws + WS_WI) + (size_t)row * 8); o[0] = v0 * IDX_SCALE; o[1] = v1 * IDX_SCALE; }
                        else if (c == 200) { const f32x4 b0 = ((const f32x4*)b_forget)[0], b1 = ((const f32x4*)b_forget)[1]; f32x4 l0, l1;
#pragma unroll
                            for (int e = 0; e < 4; ++e) { l0[e] = logsigmoidf_(v0[e] + b0[e]); l1[e] = logsigmoidf_(v1[e] + b1[e]); }
                            f32x4* o = (f32x4*)((float*)(ws + WS_LOGF) + (size_t)row * 8); o[0] = l0; o[1] = l1; }
                    } else {
                        if (mode == 1) { v0 = v0 * C2; v1 = v1 * C2; }
                        else if (mode == 2) {
#pragma unroll
                            for (int e = 0; e < 4; ++e) { v0[e] = siluf_(v0[e]); v1[e] = siluf_(v1[e]); } }
                        else if (mode == 3) {
#pragma unroll
                            for (int e = 0; e < 4; ++e) { v0[e] = sigmoidf_(v0[e]); v1[e] = sigmoidf_(v1[e]); } }
                        *(f16x8*)(dst + (size_t)row * ld + colb + c) = pack8(v0, v1);
                    }
                }
            }
    }
};
struct EpiNull { float* sink;
    __device__ __forceinline__ void operator()(const f32x4 (&acc)[2][2][4][2], const pg8::Unit& u, int wr, int wc, int fr, int fq) const {
        f32x4 s = (f32x4){0.f, 0.f, 0.f, 0.f};
#pragma unroll
        for (int ai = 0; ai < 2; ++ai)
#pragma unroll
            for (int bj = 0; bj < 2; ++bj)
#pragma unroll
                for (int m = 0; m < 4; ++m)
#pragma unroll
                    for (int n = 0; n < 2; ++n) s += acc[ai][bj][m][n];
        if (s[0] + s[1] + s[2] + s[3] == 1.2345e30f) sink[u.pm] = s[0]; } };
constexpr int GEMM_LDS = 147456;
__global__ void __launch_bounds__(512, 2) k_gemm1(Params P) {
    extern __shared__ __attribute__((aligned(16))) unsigned char lds[];
    pg8::Gemm g{(const f16*)(P.ws + WS_H16), (const f16*)(P.ws + WS_W1T), D, D, D}; pg8::StaticOrder So; So.init(T, N1, gridDim.x, blockIdx.x);
    EpiG1 E{P.ws, P.b_forget};
    pg8::gemm_phase<EpiG1>((LAS unsigned char*)lds, g, So, E);
}


template <int MODE> struct EpiGen {
    f16* dst; const f16* mul; int ldm, mulcol; const f16* add; float* rowsq;
    __device__ __forceinline__ void operator()(const f32x4 (&acc)[2][2][4][2], const pg8::Unit& u, int wr, int wc, int fr, int fq) const {
        const int row0 = u.pm * 256 + wr * 64 + fr, col0 = u.pn * 256 + wc * 32 + fq * 8;
#pragma unroll
        for (int ai = 0; ai < 2; ++ai)
#pragma unroll
            for (int m = 0; m < 4; ++m) {
                const int row = row0 + ai * 128 + m * 16; float ss = 0.f;
#pragma unroll
                for (int bj = 0; bj < 2; ++bj) {
                    const int col = col0 + bj * 128; f32x4 v0 = acc[ai][bj][m][0], v1 = acc[ai][bj][m][1];
                    if (MODE == 4) {
#pragma unroll
                        for (int e = 0; e < 4; ++e) { v0[e] = sigmoidf_(v0[e]); v1[e] = sigmoidf_(v1[e]); } }
                    if (MODE == 1 || MODE == 2 || MODE == 4) { const f16x8 mv = *(const f16x8*)(mul + (size_t)row * ldm + mulcol + col);
#pragma unroll
                        for (int e = 0; e < 4; ++e) { v0[e] *= (float)mv[e]; v1[e] *= (float)mv[4 + e]; } }
                    if (MODE == 2) { const f16x8 av = *(const f16x8*)(add + (size_t)row * 1024 + col);
#pragma unroll
                        for (int e = 0; e < 4; ++e) { v0[e] += (float)av[e]; v1[e] += (float)av[4 + e]; } }
                    if (MODE == 3 || MODE == 4) {
#pragma unroll
                        for (int e = 0; e < 4; ++e) ss += v0[e] * v0[e] + v1[e] * v1[e]; }
                    *(f16x8*)(dst + (size_t)row * 1024 + col) = pack8(v0, v1);
                }
                if (MODE == 3 || MODE == 4) { ss += __shfl_xor(ss, 16); ss += __shfl_xor(ss, 32); if (fq == 0) atomicAdd(rowsq + row, ss); }
                if (MODE != 0 && MODE != 3) asm volatile("" ::: "memory");
            }
    }
};
__device__ __forceinline__ void ph_merged(const Params& P, LAS unsigned char* lds, int G, int c) {
    unsigned char* ws = P.ws; pg8::StaticOrder So; So.init(T, D, G, c);
    { pg8::Gemm g{(const f16*)(ws + WS_U), (const f16*)(ws + WS_WBA), 1024, 512, 512}; EpiGen<1> E{(f16*)(ws + WS_MERGED), (const f16*)(ws + WS_MG), 2048, 0, nullptr, nullptr}; pg8::gemm_phase(lds, g, So, E); }
    { pg8::Gemm g{(const f16*)(ws + WS_U) + 512, (const f16*)(ws + WS_WBB), 1024, 512, 512}; EpiGen<2> E{(f16*)(ws + WS_MERGED), (const f16*)(ws + WS_MG), 2048, 1024, (const f16*)(ws + WS_MERGED), nullptr}; pg8::gemm_phase(lds, g, So, E); }
}
__device__ __forceinline__ void ph_out(const Params& P, LAS unsigned char* lds, int G, int c, int rsq_off = 0) {
    unsigned char* ws = P.ws; pg8::StaticOrder So; So.init(T, D, G, c);
    pg8::Gemm g{(const f16*)(ws + WS_MERGED), (const f16*)(ws + WS_WO), 1024, 1024, 1024}; EpiGen<3> E{(f16*)(ws + WS_OUT16), nullptr, 0, 0, nullptr, (float*)(ws + WS_ROWSQ) + rsq_off}; pg8::gemm_phase(lds, g, So, E);
}
__device__ __forceinline__ void ph_gate(const Params& P, LAS unsigned char* lds, int G, int c, int rsq_off = T) {
    unsigned char* ws = P.ws; pg8::StaticOrder So; So.init(T, D, G, c);
    { pg8::Gemm g{(const f16*)(ws + WS_P16), (const f16*)(ws + WS_WPLE), DPLE, DPLE, DPLE}; EpiGen<0> E{(f16*)(ws + WS_E16), nullptr, 0, 0, nullptr, nullptr}; pg8::gemm_phase(lds, g, So, E); }
    { pg8::Gemm g{(const f16*)(ws + WS_X116), (const f16*)(ws + WS_WPG), 1024, 1024, 1024}; EpiGen<4> E{(f16*)(ws + WS_V16), (const f16*)(ws + WS_E16), 1024, 0, nullptr, (float*)(ws + WS_ROWSQ) + rsq_off}; pg8::gemm_phase(lds, g, So, E); }
}
__global__ void __launch_bounds__(512, 2) k_merged(Params P) { extern __shared__ __attribute__((aligned(16))) unsigned char lds[]; ph_merged(P, (LAS unsigned char*)lds, gridDim.x, blockIdx.x); }
__global__ void __launch_bounds__(512, 2) k_out(Params P) { extern __shared__ __attribute__((aligned(16))) unsigned char lds[]; ph_out(P, (LAS unsigned char*)lds, gridDim.x, blockIdx.x); }
__global__ void __launch_bounds__(512, 2) k_gate(Params P) { extern __shared__ __attribute__((aligned(16))) unsigned char lds[]; ph_gate(P, (LAS unsigned char*)lds, gridDim.x, blockIdx.x); }


namespace att {
typedef short s16x4 __attribute__((ext_vector_type(4)));
typedef short s16x8 __attribute__((ext_vector_type(8)));
constexpr int NW = 8, QBLK = 32, KVBLK = 64, NSLOT = 3, SLOTB = 8192;
constexpr int LDS_K = 0, LDS_V = NSLOT * SLOTB, LDS_WS = 2 * NSLOT * SLOTB, LDS_OST = LDS_WS + NW * 64 * 4, LDS_AUX = LDS_OST + NW * 4096, LDS_BYTES = LDS_AUX + 8192;
__device__ __forceinline__ int crow(int r, int hi) { return (r & 3) + 8 * (r >> 2) + 4 * hi; }
#define SBAR() __builtin_amdgcn_sched_barrier(0)
__device__ __forceinline__ void glds16(const void* gsrc, unsigned lds_dst) { unsigned keep;
    asm volatile("s_mov_b32 %0, m0\n\ts_mov_b32 m0, %2\n\ts_nop 0\n\tglobal_load_lds_dwordx4 %1, off\n\ts_mov_b32 m0, %0" : "=&s"(keep) : "v"(gsrc), "s"(lds_dst) : "memory"); }
__device__ __forceinline__ float max3f(float a, float b, float c) { float r; asm("v_max3_f32 %0, %1, %2, %3" : "=v"(r) : "v"(a), "v"(b), "v"(c)); return r; }
__device__ __forceinline__ float max2f(float a, float b) { float r; asm("v_max_f32_e32 %0, %1, %2" : "=v"(r) : "v"(a), "v"(b)); return r; }
__device__ __forceinline__ float fadd_s(float a, float b) { float r; asm("v_add_f32_e32 %0, %1, %2" : "=v"(r) : "v"(a), "v"(b)); return r; }
__device__ __forceinline__ float fsub_s(float a, float b) { float r; asm("v_sub_f32_e32 %0, %1, %2" : "=v"(r) : "v"(a), "v"(b)); return r; }
__device__ __forceinline__ unsigned cvtpk_s(float lo, float hi) { return __builtin_bit_cast(unsigned, __builtin_amdgcn_cvt_pkrtz(lo, hi)); }
#define WAIT_BAR(N) asm volatile("s_waitcnt vmcnt(" #N ") lgkmcnt(0)\n\ts_barrier" ::: "memory")
typedef LAS const char* lds_cptr;
typedef short v4i16_t __attribute__((ext_vector_type(4)));
__device__ __forceinline__ void kload8(f16x8* kf, lds_cptr kp) {
    kf[0] = *(const LAS f16x8*)(kp);        kf[1] = *(const LAS f16x8*)(kp + 512);
    kf[2] = *(const LAS f16x8*)(kp + 2048); kf[3] = *(const LAS f16x8*)(kp + 2560);
    kf[4] = *(const LAS f16x8*)(kp + 4096); kf[5] = *(const LAS f16x8*)(kp + 4608);
    kf[6] = *(const LAS f16x8*)(kp + 6144); kf[7] = *(const LAS f16x8*)(kp + 6656);
}
__device__ __forceinline__ void kload2(f16x8* kf, lds_cptr kp, int j) { kf[2 * j] = *(const LAS f16x8*)(kp + j * 2048); kf[2 * j + 1] = *(const LAS f16x8*)(kp + j * 2048 + 512); }
__device__ __forceinline__ s16x4 vtr(lds_cptr p) { return __builtin_bit_cast(s16x4, __builtin_amdgcn_ds_read_tr16_b64_v4i16((LAS v4i16_t*)p)); }
__device__ __forceinline__ float rowmax(const f32x16& p0, const f32x16& p1) {
    float a = max3f(p0[0], p0[1], p1[0]), b = max3f(p0[2], p0[3], p1[1]); a = max3f(a, p1[2], p1[3]);
#pragma unroll
    for (int r = 4; r < 16; r += 4) { a = max3f(a, p0[r], p0[r + 1]); b = max3f(b, p0[r + 2], p0[r + 3]); a = max3f(a, p1[r], p1[r + 1]); b = max3f(b, p1[r + 2], p1[r + 3]); }
    const float m = max2f(a, b);
    auto rr = __builtin_amdgcn_permlane32_swap(__float_as_uint(m), __float_as_uint(m), false, false);
    return max2f(__uint_as_float(rr[0]), __uint_as_float(rr[1]));
}
#define MFMA32(a, b, c) __builtin_amdgcn_mfma_f32_32x32x16_f16((a), (b), (c), 0, 0, 0)
__device__ __forceinline__ void cmask(f32x16& p0, f32x16& p1, int jb, int qrel, int hi) {
    const float NEG = -INFINITY; const int kb = 64 * jb + 4 * hi;
#pragma unroll
    for (int r = 0; r < 16; ++r) { const int kv = kb + (r & 3) + 8 * (r >> 2); if (kv > qrel) p0[r] = NEG; if (kv + 32 > qrel) p1[r] = NEG; }
}
__device__ __forceinline__ void pv(f32x16* o, int vb, f16x8 pa0, f16x8 pa1, f16x8 pa2, f16x8 pa3) {
#pragma unroll
    for (int d0 = 0; d0 < 2; ++d0) { s16x4 lo[4], hi[4];
#pragma unroll
        for (int ks = 0; ks < 4; ++ks) {
            asm volatile("ds_read_b64_tr_b16 %0,%1 offset:%c2" : "=&v"(lo[ks]) : "v"(vb), "i"(d0 * 4096 + ks * 1024) : "memory");
            asm volatile("ds_read_b64_tr_b16 %0,%1 offset:%c2" : "=&v"(hi[ks]) : "v"(vb), "i"(d0 * 4096 + ks * 1024 + 512) : "memory"); }
        asm volatile("s_waitcnt lgkmcnt(0)" ::: "memory"); SBAR();
#define PK(k) __builtin_bit_cast(f16x8, (s16x8){lo[k][0], lo[k][1], lo[k][2], lo[k][3], hi[k][0], hi[k][1], hi[k][2], hi[k][3]})
        o[d0] = MFMA32(pa0, PK(0), o[d0]); o[d0] = MFMA32(pa1, PK(1), o[d0]); o[d0] = MFMA32(pa2, PK(2), o[d0]); o[d0] = MFMA32(pa3, PK(3), o[d0]);
#undef PK
    }
}
template <int MODE, int THRL> __device__ __forceinline__ void attn_unit(const f16* Qw, const f16* __restrict__ Kh, const f16* __restrict__ Vh, const int KP, const int NT, const int qrel0, const float ct2,
                                                                          f16* Uw, const f16* SGw, char* shm) {
    int tid = threadIdx.x; asm volatile("" : "+v"(tid));
    const int lane = tid & 63, r32 = lane & 31, hi = lane >> 5; const int wid = __builtin_amdgcn_readfirstlane(tid >> 6);
    const unsigned lds0 = (unsigned)(uintptr_t)shm;
    float* wsf = (float*)(shm + LDS_WS) + wid * 64;
    const f16* ksrc = Kh + (long)lane * KP + wid * 8;
    const f16* vsrc = Vh + (long)(16 * (wid & 3) + (lane >> 2)) * KP + (wid >> 2) * 32 + (lane & 3) * 8;
    const unsigned kdst = lds0 + LDS_K + wid * 1024, vdst = lds0 + LDS_V + wid * 1024;
#define DMA_K(t, slot) glds16(ksrc + (long)(t) * KVBLK * KP, (unsigned)__builtin_amdgcn_readfirstlane(kdst + (slot)))
#define DMA_V(t, slot) glds16(vsrc + (long)(t) * KVBLK * KP, (unsigned)__builtin_amdgcn_readfirstlane(vdst + (slot)))
    const int vb0 = (int)(lds0 + LDS_V) + ((lane >> 4) & 1) * 32 + (lane & 3) * 8 + (4 * hi + ((lane & 15) >> 2)) * 64;
    f16x8 kf[8];
    const lds_cptr shm3 = (lds_cptr)shm; const lds_cptr kp0 = shm3 + LDS_K + hi * 1024 + r32 * 16; const lds_cptr vp0 = shm3 + LDS_V + ((lane >> 4) & 1) * 32 + (lane & 3) * 8 + (4 * hi + ((lane & 15) >> 2)) * 64;
    const LAS float* cs2 = (const LAS float*)(shm3 + LDS_AUX) + 4 * hi;
    const LAS u64* mwp = (const LAS u64*)(shm3 + LDS_AUX) + r32;
    DMA_K(0, 0); DMA_V(0, 0); DMA_K(1, SLOTB);
    f16x8 qr[4];
#pragma unroll
    for (int d0 = 0; d0 < 4; ++d0) qr[d0] = *reinterpret_cast<const f16x8*>(&Qw[(long)r32 * 512 + d0 * 16 + hi * 8]);
    float mhat = 0.f, l_reg = 0.f; f32x16 o[2]; o[0] = f32x16{}; o[1] = f32x16{};
    float base = (MODE == 0) ? ct2 : 0.f;
    const int qrel = qrel0 + r32;
#define INITH(C, t, HOFF, WSH) do { if (MODE == 0) { const LAS float* cp_ = cs2 + 64 * (t) + (HOFF); \
        _Pragma("unroll") for (int g_ = 0; g_ < 4; ++g_) { const f32x4 a_ = *(const LAS f32x4*)(cp_ + 8 * g_); \
            _Pragma("unroll") for (int e_ = 0; e_ < 4; ++e_) C[4 * g_ + e_] = base - a_[e_]; } } \
      else { const u64 w_ = mwp[32 * (t)]; const unsigned w0_ = (unsigned)(w_ >> ((WSH) + 4 * hi)); const unsigned nb_ = __float_as_uint(base), ng_ = __float_as_uint(-1e30f); \
        _Pragma("unroll") for (int r_ = 0; r_ < 16; ++r_) { const int cb_ = (r_ & 3) + 8 * (r_ >> 2); const unsigned t0_ = (unsigned)__builtin_amdgcn_sbfe((int)w0_, cb_, 1); \
            C[r_] = __uint_as_float((t0_ & nb_) | (~t0_ & ng_)); } } } while (0)
#define INIT(C0, C1, t) do { INITH(C0, t, 0, 0); INITH(C1, t, 32, 32); } while (0)
#define CMASK(P0, P1, t) do { if (MODE == 0) { int jb_ = (t) - (NT - 4); if (jb_ >= 0) cmask(P0, P1, jb_, qrel, hi); } } while (0)
    bool resc = false;
#define START(P0, P1) do { const float rm = rowmax(P0, P1); resc = false; \
    { const float dl = (MODE == 0) ? rm : __builtin_fmaxf(rm, -1000.f); mhat = fadd_s(mhat, dl); base = fsub_s(base, dl); \
      _Pragma("unroll") for (int r = 0; r < 16; ++r) { P0[r] = fsub_s(P0[r], dl); P1[r] = fsub_s(P1[r], dl); } } \
    _Pragma("unroll") for (int r = 0; r < 16; ++r) P0[r] = __builtin_amdgcn_exp2f(P0[r]); } while (0)
#define RESC() do { if (resc) { asm volatile("s_waitcnt lgkmcnt(0)" ::: "memory"); \
      _Pragma("unroll") for (int d_ = 0; d_ < 2; ++d_) _Pragma("unroll") for (int r = 0; r < 16; ++r) o[d_][r] *= wsf[crow(r, hi)]; } } while (0)
    f32x16 pA0, pA1, pB0, pB1;
    int sl_prev = 0, sl_cur = 0, sl_next = SLOTB;
#define ROT() do { sl_prev = sl_cur; sl_cur = sl_next; sl_next = (sl_next == (NSLOT - 1) * SLOTB) ? 0 : sl_next + SLOTB; } while (0)
    DMA_K(2, 2 * SLOTB);
    WAIT_BAR(3);
    INIT(pA0, pA1, 0);
    { const char* kb = shm + LDS_K + hi * 1024 + r32 * 16;
#pragma unroll
      for (int d0 = 0; d0 < 4; ++d0) { const f16x8 b0 = *reinterpret_cast<const f16x8*>(kb + d0 * 2048); const f16x8 b1 = *reinterpret_cast<const f16x8*>(kb + d0 * 2048 + 512);
          pA0 = MFMA32(b0, qr[d0], pA0); pA1 = MFMA32(b1, qr[d0], pA1); } }
    asm volatile("s_nop 15\n\ts_nop 7" : "+v"(pA0), "+v"(pA1)); CMASK(pA0, pA1, 0);
    START(pA0, pA1);
#pragma unroll
    for (int r = 0; r < 16; ++r) pA1[r] = __builtin_amdgcn_exp2f(pA1[r]);
    WAIT_BAR(0);
    DMA_K(3, 0); DMA_V(1, SLOTB);
    ROT();
    kload8(kf, kp0 + sl_cur);
    WAIT_BAR(2);
    s16x4 vlo[8], vhi[8]; u32x4 pw0, pw1, pw2, pw3;
#define PKW(P, B) cvtpk_s(P[B], P[B + 1])
#define PAF(k) __builtin_bit_cast(f16x8, pw##k)
#define VFR(i) __builtin_bit_cast(f16x8, (s16x8){vlo[i][0], vlo[i][1], vlo[i][2], vlo[i][3], vhi[i][0], vhi[i][1], vhi[i][2], vhi[i][3]})
#define PIN(x) asm volatile("" : "+v"(x))
#define MX3(a, b, c) __builtin_fmaxf(__builtin_fmaxf((a), (b)), (c))
#define GAPA(MF, A0, A1, A2, A3, W0, W1, PW) do { MF; sacc += A0; sacc += A1; sacc += A2; sacc += A3; PIN(sacc); W0; W1; PIN(PW); SBAR(); } while (0)
#define EX(v) __builtin_amdgcn_exp2f(v)
#define GAPB(MF, X, B) do { MF; X[B] = EX(X[B]); X[B + 1] = EX(X[B + 1]); X[B + 2] = EX(X[B + 2]); X[B + 3] = EX(X[B + 3]); PIN(X); SBAR(); } while (0)
#define VRD(i) do { vlo[i] = vtr(vp_ + (((i) >> 2) * 4096 + ((i) & 3) * 1024)); vhi[i] = vtr(vp_ + (((i) >> 2) * 4096 + ((i) & 3) * 1024 + 512)); } while (0)
#define KRD(G, j) do { if (G) { kload2(kf, kp0 + sl_next, j); SBAR(); } } while (0)
#define STEP(C0, C1, P0, P1, t, GK, GV, GL) do { SBAR(); \
    const lds_cptr vp_ = vp0 + sl_prev; \
    INITH(C0, t, 0, 0); \
    VRD(0); SBAR(); float sacc = (P0[0] + P0[1]); \
    GAPA(C0 = MFMA32(kf[0], qr[0], C0), P0[2], P0[3], P0[4], P0[5],     pw0[0] = PKW(P0, 0), pw0[1] = PKW(P0, 2), pw0); \
    INITH(C1, t, 32, 32); \
    VRD(4); SBAR(); GAPA(C1 = MFMA32(kf[1], qr[0], C1), P0[6], P0[7], P0[8], P0[9],     pw0[2] = PKW(P0, 4), pw0[3] = PKW(P0, 6), pw0); \
    VRD(1); SBAR(); GAPA(C0 = MFMA32(kf[2], qr[1], C0),   P0[10], P0[11], P0[12], P0[13], pw1[0] = PKW(P0, 8), pw1[1] = PKW(P0, 10), pw1); \
    VRD(5); SBAR(); GAPA(C1 = MFMA32(kf[3], qr[1], C1),   P0[14], P0[15], P1[0], P1[1],   pw1[2] = PKW(P0, 12), pw1[3] = PKW(P0, 14), pw1); \
    VRD(2); SBAR(); GAPA(C0 = MFMA32(kf[4], qr[2], C0),   P1[2], P1[3], P1[4], P1[5],     pw2[0] = PKW(P1, 0), pw2[1] = PKW(P1, 2), pw2); \
    VRD(6); SBAR(); GAPA(C1 = MFMA32(kf[5], qr[2], C1),   P1[6], P1[7], P1[8], P1[9],     pw2[2] = PKW(P1, 4), pw2[3] = PKW(P1, 6), pw2); \
    VRD(3); SBAR(); GAPA(C0 = MFMA32(kf[6], qr[3], C0),   P1[10], P1[11], P1[12], P1[13], pw3[0] = PKW(P1, 8), pw3[1] = PKW(P1, 10), pw3); \
    VRD(7); SBAR(); GAPA(C1 = MFMA32(kf[7], qr[3], C1),   P1[14], P1[15], 0.f, 0.f,       pw3[2] = PKW(P1, 12), pw3[3] = PKW(P1, 14), pw3); \
    l_reg += sacc; \
    if (GK) { DMA_K((t) + 3, sl_cur); } if (GV) { DMA_V((t) + 1, sl_next); } \
    CMASK(C0, C1, t); \
    { float a = MX3(C0[0], C0[1], C1[0]), b = MX3(C0[2], C0[3], C1[1]); a = MX3(a, C1[2], C1[3]); \
      _Pragma("unroll") for (int r = 4; r < 16; r += 4) { a = MX3(a, C0[r], C0[r + 1]); b = MX3(b, C0[r + 2], C0[r + 3]); a = MX3(a, C1[r], C1[r + 1]); b = MX3(b, C1[r + 2], C1[r + 3]); } \
      float rm = __builtin_fmaxf(a, b); { auto rr = __builtin_amdgcn_permlane32_swap(__float_as_uint(rm), __float_as_uint(rm), false, false); rm = __builtin_fmaxf(__uint_as_float(rr[0]), __uint_as_float(rr[1])); } \
      resc = false; \
      if (__builtin_expect(__any(rm > (float)THRL), 0)) { const float dl = __builtin_fmaxf(rm, 0.f); mhat += dl; base -= dl; \
        _Pragma("unroll") for (int r = 0; r < 16; ++r) { C0[r] -= dl; C1[r] -= dl; } \
        const float f = __builtin_amdgcn_exp2f(-dl); l_reg *= f; if (hi == 0) wsf[r32] = f; resc = true; } } \
    SBAR(); \
    GAPB(o[0] = MFMA32(PAF(0), VFR(0), o[0]), C0, 0); \
    GAPB(o[1] = MFMA32(PAF(0), VFR(4), o[1]), C0, 4); \
    KRD(GL, 0); GAPB(o[0] = MFMA32(PAF(1), VFR(1), o[0]), C0, 8); \
    KRD(GL, 1); GAPB(o[1] = MFMA32(PAF(1), VFR(5), o[1]), C0, 12); \
    KRD(GL, 2); GAPB(o[0] = MFMA32(PAF(2), VFR(2), o[0]), C1, 0); \
    KRD(GL, 3); GAPB(o[1] = MFMA32(PAF(2), VFR(6), o[1]), C1, 4); \
    GAPB(o[0] = MFMA32(PAF(3), VFR(3), o[0]), C1, 8); \
    GAPB(o[1] = MFMA32(PAF(3), VFR(7), o[1]), C1, 12); \
    } while (0)
    int t = 1;
#define ENDW(tt) do { if ((tt) + 3 < NT) { WAIT_BAR(2); } else if ((tt) + 2 < NT) { WAIT_BAR(1); } else { WAIT_BAR(0); } } while (0)
#undef CMASK
#define CMASK(P0, P1, t) do { } while (0)
    for (; t + 5 < NT; t += 2) {
        STEP(pB0, pB1, pA0, pA1, t, true, true, true);     WAIT_BAR(2); RESC(); ROT();
        STEP(pA0, pA1, pB0, pB1, t + 1, true, true, true); WAIT_BAR(2); RESC(); ROT();
    }
#undef CMASK
#define CMASK(P0, P1, t) do { if (MODE == 0) { int jb_ = (t) - (NT - 4); if (jb_ >= 0) cmask(P0, P1, jb_, qrel, hi); } } while (0)
    for (; t + 1 < NT; t += 2) {
        STEP(pB0, pB1, pA0, pA1, t, (t + 3 < NT), (t + 1 < NT), (t + 1 < NT));         ENDW(t);     RESC(); ROT();
        STEP(pA0, pA1, pB0, pB1, t + 1, (t + 4 < NT), (t + 2 < NT), (t + 2 < NT));     ENDW(t + 1); RESC(); ROT();
    }
    STEP(pB0, pB1, pA0, pA1, NT - 1, false, false, false); RESC();
    { float sacc = pB0[0] + pB0[1];
#pragma unroll
      for (int r = 2; r < 16; ++r) sacc += pB0[r];
#pragma unroll
      for (int r = 0; r < 16; ++r) sacc += pB1[r];
      l_reg += sacc;
      pw0 = (u32x4){PKW(pB0, 0), PKW(pB0, 2), PKW(pB0, 4), PKW(pB0, 6)}; pw1 = (u32x4){PKW(pB0, 8), PKW(pB0, 10), PKW(pB0, 12), PKW(pB0, 14)};
      pw2 = (u32x4){PKW(pB1, 0), PKW(pB1, 2), PKW(pB1, 4), PKW(pB1, 6)}; pw3 = (u32x4){PKW(pB1, 8), PKW(pB1, 10), PKW(pB1, 12), PKW(pB1, 14)};
      SBAR(); pv(o, vb0 + sl_cur, PAF(0), PAF(1), PAF(2), PAF(3)); }
#undef PKW
#undef PAF
#undef VFR
#undef PIN
#undef MX3
#undef GAPA
#undef GAPB
#undef EX
#undef VRD
#undef KRD
#undef STEP
#undef ENDW
    { auto rr = __builtin_amdgcn_permlane32_swap(__float_as_uint(l_reg), __float_as_uint(l_reg), false, false); l_reg = __uint_as_float(rr[0]) + __uint_as_float(rr[1]); }
    if (hi == 0) wsf[32 + r32] = l_reg; asm volatile("s_waitcnt lgkmcnt(0)" ::: "memory");
    float rli[16];
#pragma unroll
    for (int r = 0; r < 16; ++r) rli[r] = __builtin_amdgcn_rcpf(wsf[32 + crow(r, hi)]);
    { f16* stg = (f16*)(shm + LDS_OST) + wid * 2048;
#pragma unroll
      for (int r = 0; r < 16; ++r) { const int orow = crow(r, hi);
#pragma unroll
          for (int d0 = 0; d0 < 2; ++d0) stg[orow * 64 + d0 * 32 + r32] = (f16)(o[d0][r] * rli[r]); }
      asm volatile("s_waitcnt lgkmcnt(0)" ::: "memory");
#pragma unroll
      for (int i = 0; i < 4; ++i) { const int row = i * 8 + (lane >> 3), ch = lane & 7; const f16x8 v = *(const f16x8*)(stg + row * 64 + ch * 8); const f16x8 g = *(const f16x8*)(SGw + (long)row * 512 + ch * 8);
          *(f16x8*)(Uw + (long)row * 1024 + ch * 8) = v * g; } }
    asm volatile("s_waitcnt vmcnt(0) lgkmcnt(0)\n\ts_barrier" ::: "memory");
#undef DMA_K
#undef DMA_V
#undef CMASK
#undef INIT
#undef INITH
#undef START
#undef RESC
#undef ROT
}
#undef SBAR
#undef WAIT_BAR
#undef MFMA32
}

__device__ __forceinline__ void ph_fox(const Params& P, char* shm, int vcu, int G) {
    unsigned char* ws = P.ws; const int tid = threadIdx.x, lane = tid & 63, wid = tid >> 6;
    for (int bh = vcu; bh < NB * 8; bh += G) {
        const int b = bh >> 3, h = bh & 7;
        float* cs = (float*)(shm + att::LDS_AUX); float* wtot = (float*)(shm + att::LDS_WS);
        { int t2 = threadIdx.x; asm volatile("" : "+v"(t2));
          const int lane2 = t2 & 63, wid2 = t2 >> 6;
          const float* lf = (const float*)(ws + WS_LOGF) + ((size_t)b * S + t2 * 4) * 8 + h;
          float v0 = lf[0], v1 = v0 + lf[8], v2 = v1 + lf[16], v3 = v2 + lf[24]; float inc = v3;
#pragma unroll
          for (int o = 1; o < 64; o <<= 1) { const float n = __shfl_up(inc, o); if (lane2 >= o) inc += n; }
          if (lane2 == 63) wtot[wid2] = inc;
          __syncthreads();
          float off = inc - v3; for (int w = 0; w < wid2; ++w) off += wtot[w];
          *(f32x4*)(cs + t2 * 4) = (f32x4){(v0 + off) * LOG2E, (v1 + off) * LOG2E, (v2 + off) * LOG2E, (v3 + off) * LOG2E};
          __syncthreads(); }
        const size_t rowbase = (size_t)b * S;
        for (int qi = 0; qi < 8; ++qi) { const int qb = 7 - qi; const int q0 = qb * 256;
            const size_t tok = rowbase + q0 + wid * 32;
            const float ct2 = cs[q0 + wid * 32 + (lane & 31)];
            att::attn_unit<0, 8>((const f16*)(ws + WS_QB) + tok * 512 + h * 64, (const f16*)(ws + WS_KB) + rowbase * 512 + h * 64, (const f16*)(ws + WS_VB) + rowbase * 512 + h * 64, 512, 4 * qb + 4, wid * 32, ct2,
                                 (f16*)(ws + WS_U) + tok * 1024 + 512 + h * 64, (const f16*)(ws + WS_SGB) + tok * 512 + h * 64, shm); }
        __syncthreads();
    }
}
__device__ __forceinline__ void ph_dsa_attn(const Params& P, char* shm, int vcu, int G) {
    unsigned char* ws = P.ws; const int tid = threadIdx.x, wid = tid >> 6;
    for (int it = vcu; it < NB * 8; it += G) {
        const int b = it >> 3, j = it & 7; const size_t rowbase = (size_t)b * S;
        for (int k = 0; k < 8; ++k) { const int qt = (k & 1) ? (16 * (k >> 1) + 15 - j) : (16 * (k >> 1) + j);
            const int nt = qt / 2 + 1, NT = nt < 4 ? 4 : nt + (nt & 1);
            { const u32x4* src = (const u32x4*)((const u64*)(ws + WS_MASK) + ((size_t)b * 64 + qt) * 32 * 32); u32x4* dst = (u32x4*)(shm + att::LDS_AUX);
              if (tid < NT * 16) dst[tid] = src[tid]; }
            __syncthreads();
            const size_t tok = rowbase + qt * 32;
            att::attn_unit<1, 8>((const f16*)(ws + WS_QA) + tok * 512 + wid * 64, (const f16*)(ws + WS_KA) + rowbase * 64, (const f16*)(ws + WS_VA) + rowbase * 64, 64, NT, 0, 0.f,
                                 (f16*)(ws + WS_U) + tok * 1024 + wid * 64, (const f16*)(ws + WS_SGA) + tok * 512 + wid * 64, shm); }
    }
}

namespace idx {
constexpr int BUFB = 32768;
__device__ __forceinline__ int half_sum(int v) {
    v += __builtin_amdgcn_update_dpp(0, v, 0xB1, 0xF, 0xF, false);
    v += __builtin_amdgcn_update_dpp(0, v, 0x4E, 0xF, 0xF, false);
    v += __builtin_amdgcn_update_dpp(0, v, 0x141, 0xF, 0xF, false);
    v += __builtin_amdgcn_update_dpp(0, v, 0x140, 0xF, 0xF, false);
    v += __shfl_xor(v, 16);
    return v;
}
__device__ __forceinline__ void indexer_tile(const Params& P, char* shm, const int b, const int qt, const int NTA) {
    unsigned char* ws = P.ws;
    int tid = threadIdx.x; asm volatile("" : "+v"(tid));
    const int lane = tid & 63, c = lane & 31, g = lane >> 5; const int wid = __builtin_amdgcn_readfirstlane(tid >> 6);
    const size_t rowbase = (size_t)b * S; const int q0 = qt * 32; const int ntiles = qt + 1, nchunks = (ntiles + 7) >> 3;
    const unsigned lds0 = (unsigned)(uintptr_t)shm;
    const f16* kig = (const f16*)(ws + WS_KI) + rowbase * 64;
#define IDX_DMA(ch) do { _Pragma("unroll") for (int pp_ = 0; pp_ < 4; ++pp_) { const int p_ = wid + 8 * pp_; const int key_ = 8 * p_ + (lane >> 3); \
        att::glds16(kig + (size_t)((ch) * 256 + key_) * 64 + (((lane & 7) ^ ((key_ >> 1) & 7)) * 8), (unsigned)__builtin_amdgcn_readfirstlane(lds0 + ((ch) & 1) * BUFB + p_ * 1024)); } } while (0)
    IDX_DMA(0);
    f16x8 aq[4];
    { const int rho = c; const int qq = 2 * ((rho >> 2) & 1) + (rho >> 4), hd = 4 * ((rho >> 3) & 1) + (rho & 3);
      const f16* qp = (const f16*)(ws + WS_QI) + (rowbase + q0 + 4 * wid + qq) * 512 + hd * 64 + 8 * g;
#pragma unroll
      for (int kk = 0; kk < 4; ++kk) aq[kk] = *(const f16x8*)(qp + 16 * kk); }
    float wq[16];
    { const f32x4* wp = (const f32x4*)((const float*)(ws + WS_WI) + (rowbase + q0 + 4 * wid + 2 * g) * 8);
      const f32x4 a0 = wp[0], a1 = wp[1], a2 = wp[2], a3 = wp[3];
      wq[0] = a0[0]; wq[1] = a0[1]; wq[2] = a0[2]; wq[3] = a0[3]; wq[4] = a1[0]; wq[5] = a1[1]; wq[6] = a1[2]; wq[7] = a1[3];
      wq[8] = a2[0]; wq[9] = a2[1]; wq[10] = a2[2]; wq[11] = a2[3]; wq[12] = a3[0]; wq[13] = a3[1]; wq[14] = a3[2]; wq[15] = a3[3]; }
    const int ql0 = 4 * wid + 2 * g, ql1 = ql0 + 1;
    unsigned k0[64], k1[64];
    const LAS char* bbase = (const LAS char*)shm + c * 128;
    const int sw = (c >> 1) & 7;
#if PROBE_DUP & 1024
#pragma unroll 1
    for (int rep_ = 0; rep_ < 2; ++rep_) { if (rep_) { asm volatile("s_waitcnt lgkmcnt(0)\n\ts_barrier" ::: "memory"); IDX_DMA(0); }
#endif
#pragma unroll
    for (int ch = 0; ch < 8; ++ch) {
        if (ch < nchunks) {
            asm volatile("s_waitcnt vmcnt(0)\n\ts_barrier" ::: "memory");
            if (ch + 1 < nchunks) IDX_DMA(ch + 1);
#pragma unroll
            for (int j = 0; j < 8; ++j) { const int jt = ch * 8 + j;
                if (jt < ntiles) {
                    const LAS char* bp = bbase + (ch & 1) * BUFB + j * 4096;
                    f32x16 acc = f32x16{};
#pragma unroll
                    for (int kk = 0; kk < 4; ++kk) { const f16x8 bk = *(const LAS f16x8*)(bp + (((2 * kk + g) ^ sw) * 16)); acc = __builtin_amdgcn_mfma_f32_32x32x16_f16(aq[kk], bk, acc, 0, 0, 0); }
                    float s0 = 0.f, s1 = 0.f;
#pragma unroll
                    for (int r = 0; r < 8; ++r) { s0 = __builtin_fmaf(wq[r], __builtin_fmaxf(acc[r], 0.f), s0); s1 = __builtin_fmaf(wq[8 + r], __builtin_fmaxf(acc[8 + r], 0.f), s1); }
                    unsigned u0 = sortkey(s0), u1 = sortkey(s1);
                    if (jt == qt) { if (c > ql0) u0 = 0u; if (c > ql1) u1 = 0u; }
                    k0[jt] = u0; k1[jt] = u1;
                } else { k0[jt] = 0u; k1[jt] = 0u; }
            }
        } else {
#pragma unroll
            for (int j = 0; j < 8; ++j) { k0[ch * 8 + j] = 0u; k1[ch * 8 + j] = 0u; }
        }
    }
#if PROBE_DUP & 1024
    }
#endif
#undef IDX_DMA
    asm volatile("s_waitcnt lgkmcnt(0)\n\ts_barrier" ::: "memory");
#if PROBE_DUP & 2048
#pragma unroll 1
    for (int rep2_ = 0; rep2_ < 2; ++rep2_) {
#endif
    LAS unsigned* mk = (LAS unsigned*)((LAS char*)shm + att::LDS_AUX);
    const int qa0 = (ql0) * 2, qa1 = (ql1) * 2;
    if (qt < 8) {
#pragma unroll
        for (int jt = 0; jt < 64; ++jt) if (jt < 2 * NTA) {
            const unsigned m0 = jt < qt ? 0xFFFFFFFFu : (jt == qt ? (unsigned)((2ull << ql0) - 1ull) : 0u), m1 = jt < qt ? 0xFFFFFFFFu : (jt == qt ? (unsigned)((2ull << ql1) - 1ull) : 0u);
            if (c == 0) { mk[(jt >> 1) * 64 + qa0 + (jt & 1)] = m0; mk[(jt >> 1) * 64 + qa1 + (jt & 1)] = m1; } }
    } else {
        unsigned lo0 = 0u, hi0 = 0xFFFFFFFFu, lo1 = 0u, hi1 = 0xFFFFFFFFu, th0 = 0u, th1 = 0u; int st0 = 0, st1 = 0;
        for (int it = 0; it < 40; ++it) {
            if (!__any(st0 == 0 || st1 == 0)) break;
            const unsigned mid0 = st0 ? th0 : lo0 + ((hi0 - lo0) >> 1), mid1 = st1 ? th1 : lo1 + ((hi1 - lo1) >> 1);
            int c0 = 0, c1 = 0;
#pragma unroll
            for (int jt = 0; jt < 64; ++jt) if (jt < ntiles) { c0 += (k0[jt] > mid0) ? 1 : 0; c1 += (k1[jt] > mid1) ? 1 : 0; }
            c0 = half_sum(c0); c1 = half_sum(c1);
            if (st0 == 0) { if (c0 == TOPK) { th0 = mid0; st0 = 1; } else { if (c0 > TOPK) lo0 = mid0; else hi0 = mid0; if (hi0 - lo0 <= 1u) { th0 = hi0; st0 = 2; } } }
            if (st1 == 0) { if (c1 == TOPK) { th1 = mid1; st1 = 1; } else { if (c1 > TOPK) lo1 = mid1; else hi1 = mid1; if (hi1 - lo1 <= 1u) { th1 = hi1; st1 = 2; } } }
        }
        if (__any(st0 == 2 || st1 == 2)) {
            int n0 = 0, n1 = 0;
#pragma unroll
            for (int jt = 0; jt < 64; ++jt) if (jt < ntiles) { n0 += (k0[jt] > th0) ? 1 : 0; n1 += (k1[jt] > th1) ? 1 : 0; }
            int need0 = TOPK - half_sum(n0), need1 = TOPK - half_sum(n1);
#pragma unroll
            for (int jt = 0; jt < 64; ++jt) if (jt < 2 * NTA) {
                unsigned m0 = 0u, m1 = 0u;
                if (jt < ntiles) {
                    const u64 g0 = __ballot(k0[jt] > th0), g1 = __ballot(k1[jt] > th1), e0 = __ballot(k0[jt] == th0 && st0 == 2), e1 = __ballot(k1[jt] == th1 && st1 == 2);
                    unsigned gg0 = g ? (unsigned)(g0 >> 32) : (unsigned)g0, gg1 = g ? (unsigned)(g1 >> 32) : (unsigned)g1, ee0 = g ? (unsigned)(e0 >> 32) : (unsigned)e0, ee1 = g ? (unsigned)(e1 >> 32) : (unsigned)e1;
                    { const int ne = __popc(ee0), tk = need0 < ne ? (need0 > 0 ? need0 : 0) : ne; unsigned r = ee0; while (__popc(r) > tk) r &= ~(0x80000000u >> __clz(r)); need0 -= tk; m0 = gg0 | r; }
                    { const int ne = __popc(ee1), tk = need1 < ne ? (need1 > 0 ? need1 : 0) : ne; unsigned r = ee1; while (__popc(r) > tk) r &= ~(0x80000000u >> __clz(r)); need1 -= tk; m1 = gg1 | r; }
                }
                if (c == 0) { mk[(jt >> 1) * 64 + qa0 + (jt & 1)] = m0; mk[(jt >> 1) * 64 + qa1 + (jt & 1)] = m1; }
            }
        } else {
#pragma unroll
            for (int jt = 0; jt < 64; ++jt) if (jt < 2 * NTA) {
                unsigned m0 = 0u, m1 = 0u;
                if (jt < ntiles) { const u64 g0 = __ballot(k0[jt] > th0), g1 = __ballot(k1[jt] > th1); m0 = g ? (unsigned)(g0 >> 32) : (unsigned)g0; m1 = g ? (unsigned)(g1 >> 32) : (unsigned)g1; }
                if (c == 0) { mk[(jt >> 1) * 64 + qa0 + (jt & 1)] = m0; mk[(jt >> 1) * 64 + qa1 + (jt & 1)] = m1; }
            }
        }
    }
#if PROBE_DUP & 2048
    }
#endif
    asm volatile("s_waitcnt lgkmcnt(0)\n\ts_barrier" ::: "memory");
}
}
__device__ __forceinline__ void ph_dsa(const Params& P, char* shm, int vcu, int G) {
    unsigned char* ws = P.ws; const int wid = threadIdx.x >> 6;
    for (int it = vcu; it < NB * 8; it += G) {
        const int b = it >> 3, j = it & 7; const size_t rowbase = (size_t)b * S;
#pragma unroll 1
        for (int k = 0; k < 8; ++k) { const int qt = (k & 1) ? (16 * (k >> 1) + 15 - j) : (16 * (k >> 1) + j);
            const int nt = qt / 2 + 1, NT = nt < 4 ? 4 : nt + (nt & 1);
            idx::indexer_tile(P, shm, b, qt, NT);
#if PROBE_DUP & 256
            idx::indexer_tile(P, shm, b, qt, NT);
#endif
            const size_t tok = rowbase + qt * 32;
            att::attn_unit<1, 8>((const f16*)(ws + WS_QA) + tok * 512 + wid * 64, (const f16*)(ws + WS_KA) + rowbase * 64, (const f16*)(ws + WS_VA) + rowbase * 64, 64, NT, 0, 0.f,
                                 (f16*)(ws + WS_U) + tok * 1024 + wid * 64, (const f16*)(ws + WS_SGA) + tok * 512 + wid * 64, shm);
#if PROBE_DUP & 512
            att::attn_unit<1, 8>((const f16*)(ws + WS_QA) + tok * 512 + wid * 64, (const f16*)(ws + WS_KA) + rowbase * 64, (const f16*)(ws + WS_VA) + rowbase * 64, 64, NT, 0, 0.f,
                                 (f16*)(ws + WS_U) + tok * 1024 + wid * 64, (const f16*)(ws + WS_SGA) + tok * 512 + wid * 64, shm);
#endif
        }
    }
}
__global__ void __launch_bounds__(512, 2) k_dsa(Params P) { extern __shared__ __attribute__((aligned(16))) unsigned char lds[];
    const int G = gridDim.x, bx = blockIdx.x; ph_dsa(P, (char*)lds, (G % 8 == 0) ? (bx % 8) * (G / 8) + bx / 8 : bx, G); }

constexpr int ATT_LDS = att::LDS_BYTES;
__global__ void __launch_bounds__(512, 2) k_fox(Params P) { extern __shared__ __attribute__((aligned(16))) unsigned char lds[]; ph_fox(P, (char*)lds, blockIdx.x, gridDim.x); }
__global__ void __launch_bounds__(512, 2) k_dsa_attn(Params P) { extern __shared__ __attribute__((aligned(16))) unsigned char lds[];
    const int G = gridDim.x, bx = blockIdx.x; ph_dsa_attn(P, (char*)lds, (G % 8 == 0) ? (bx % 8) * (G / 8) + bx / 8 : bx, G); }

__device__ __forceinline__ float dot_h(const f16* a, const f16* b, int K) {
    float acc = 0.f;
    for (int k = 0; k < K; k += 8) { const f16x8 va = *(const f16x8*)(a + k), vb = *(const f16x8*)(b + k);
#pragma unroll
        for (int j = 0; j < 8; ++j) acc += (float)va[j] * (float)vb[j]; }
    return acc;
}
__global__ void __launch_bounds__(256) nv_gemm1(Params P) {
    unsigned char* ws = P.ws;
    const size_t idx = (size_t)blockIdx.x * 256 + threadIdx.x; if (idx >= (size_t)T * N1) return;
    const int t = (int)(idx / N1), n = (int)(idx % N1);
    const f16* h = (const f16*)(ws + WS_H16) + (size_t)t * D; const f16* W = (const f16*)(ws + WS_W1T);
    float v = dot_h(h, W + (size_t)n * D, D);
    const int pos = t & (S - 1);
    auto rope = [&](int d) -> float {
        const float v2 = dot_h(h, W + (size_t)(d < 8 ? n + 8 : n - 8) * D, D);
        const f32x2 cs = ((const f32x2*)(ws + WS_ROPE))[pos * 8 + (d & 7)];
        return d < 8 ? v * cs.x - v2 * cs.y : v * cs.x + v2 * cs.y; };
    if (n < P_QI) { const int d = n & 63; if (d < 16) v = rope(d); ((f16*)(ws + WS_QA))[(size_t)t * 512 + n] = (f16)(v * C2); return; }
    if (n < P_QB) { const int c = n - P_QI, d = c & 63; if (d < 16) v = rope(d); ((f16*)(ws + WS_QI))[(size_t)t * 512 + c] = (f16)v; return; }
    if (n < P_KB) { ((f16*)(ws + WS_QB))[(size_t)t * 512 + (n - P_QB)] = (f16)(v * C2); return; }
    if (n < P_VB) { ((f16*)(ws + WS_KB))[(size_t)t * 512 + (n - P_KB)] = (f16)v; return; }
    if (n < P_GA) { ((f16*)(ws + WS_VB))[(size_t)t * 512 + (n - P_VB)] = (f16)v; return; }
    if (n < P_GB) { ((f16*)(ws + WS_SGA))[(size_t)t * 512 + (n - P_GA)] = (f16)siluf_(v); return; }
    if (n < P_SM) { ((f16*)(ws + WS_SGB))[(size_t)t * 512 + (n - P_GB)] = (f16)siluf_(v); return; }
    if (n < P_MG) { const int c = n - P_SM;
        if (c < 64) { if (c < 16) v = rope(c); ((f16*)(ws + WS_KA))[(size_t)t * 64 + c] = (f16)v; }
        else if (c < 128) ((f16*)(ws + WS_VA))[(size_t)t * 64 + (c - 64)] = (f16)v;
        else if (c < 192) { const int d = c - 128; if (d < 16) v = rope(d); ((f16*)(ws + WS_KI))[(size_t)t * 64 + d] = (f16)v; }
        else if (c < 200) ((float*)(ws + WS_WI))[(size_t)t * 8 + (c - 192)] = v * IDX_SCALE;
        else if (c < 208) ((float*)(ws + WS_LOGF))[(size_t)t * 8 + (c - 200)] = logsigmoidf_(v + P.b_forget[c - 200]);
        return; }
    ((f16*)(ws + WS_MG))[(size_t)t * 2048 + (n - P_MG)] = (f16)sigmoidf_(v);
}
__global__ void nv_cumsum(Params P) {
    const int i = blockIdx.x * blockDim.x + threadIdx.x; if (i >= NB * 8) return;
    const int b = i >> 3, h = i & 7; const float* lf = (const float*)(P.ws + WS_LOGF); float* cs = (float*)(P.ws + WS_CSUM) + (size_t)i * S;
    float c = 0.f; for (int s = 0; s < S; ++s) { c += lf[((size_t)b * S + s) * 8 + h]; cs[s] = c * LOG2E; }
}
__global__ void __launch_bounds__(256) nv_fox(Params P) {
    unsigned char* ws = P.ws;
    const int idx = blockIdx.x * 256 + threadIdx.x; const int h = idx & 7, tok = idx >> 3, b = tok / S, t = tok % S;
    float q[64], o[64];
    { const f16* qp = (const f16*)(ws + WS_QB) + (size_t)tok * 512 + h * 64;
#pragma unroll
      for (int d = 0; d < 64; ++d) { q[d] = (float)qp[d]; o[d] = 0.f; } }
    const float* cs = (const float*)(ws + WS_CSUM) + (size_t)(b * 8 + h) * S; const float ct = cs[t];
    float m = -1e30f, l = 0.f;
    for (int s = 0; s <= t; ++s) {
        const f16* kp = (const f16*)(ws + WS_KB) + ((size_t)b * S + s) * 512 + h * 64; const f16* vp = (const f16*)(ws + WS_VB) + ((size_t)b * S + s) * 512 + h * 64;
        float d0 = 0.f;
#pragma unroll
        for (int d = 0; d < 64; ++d) d0 += q[d] * (float)kp[d];
        const float lg = d0 + (ct - cs[s]); const float mn = fmaxf(m, lg), f = exp2f(m - mn), pe = exp2f(lg - mn);
        l = l * f + pe; m = mn;
#pragma unroll
        for (int d = 0; d < 64; ++d) o[d] = o[d] * f + pe * (float)vp[d];
    }
    const float il = 1.f / l; const f16* sg = (const f16*)(ws + WS_SGB) + (size_t)tok * 512 + h * 64; f16* u = (f16*)(ws + WS_U) + (size_t)tok * 1024 + 512 + h * 64;
#pragma unroll
    for (int d = 0; d < 64; ++d) u[d] = (f16)(o[d] * il * (float)sg[d]);
}
__device__ __forceinline__ size_t mask_word(int b, int t, int s, int& bit) {
    bit = s & 63; return ((((size_t)b * 64 + (t >> 5)) * 32 + (s >> 6)) * 32 + (t & 31));
}
__global__ void __launch_bounds__(256) nv_indexer(Params P) {
    unsigned char* ws = P.ws;
    __shared__ f16 sq[512]; __shared__ float sw[8]; __shared__ unsigned skey[S]; __shared__ unsigned char sflag[S]; __shared__ unsigned scnt;
    const int tok = blockIdx.x, b = tok / S, t = tok % S, tid = threadIdx.x;
    if (tid < 64) ((f16x8*)sq)[tid] = ((const f16x8*)((const f16*)(ws + WS_QI) + (size_t)tok * 512))[tid];
    if (tid < 8) sw[tid] = ((const float*)(ws + WS_WI))[(size_t)tok * 8 + tid];
    __syncthreads();
    unsigned key[8];
#pragma unroll
    for (int i = 0; i < 8; ++i) { const int s = tid + 256 * i; key[i] = 0u; sflag[s] = 0;
        if (s <= t) { const f16* kp = (const f16*)(ws + WS_KI) + ((size_t)b * S + s) * 64; float sc = 0.f;
            for (int h = 0; h < 8; ++h) { float d0 = 0.f;
#pragma unroll
                for (int d = 0; d < 64; ++d) d0 += (float)sq[h * 64 + d] * (float)kp[d];
                sc += sw[h] * fmaxf(d0, 0.f); }
            key[i] = sortkey(sc); }
        skey[s] = key[i]; }
    auto count_gt = [&](unsigned x) -> unsigned { int c = 0;
#pragma unroll
        for (int i = 0; i < 8; ++i) c += (key[i] > x) ? 1 : 0;
        __syncthreads(); if (tid == 0) scnt = 0u; __syncthreads(); atomicAdd(&scnt, (unsigned)c); __syncthreads(); return scnt; };
    bool sel[8];
    if (t + 1 <= TOPK) {
#pragma unroll
        for (int i = 0; i < 8; ++i) sel[i] = (tid + 256 * i) <= t;
    } else {
        unsigned lo = 0u, hi = 0xFFFFFFFFu, thr = 0u; bool found = false;
        while (hi - lo > 1u) { const unsigned mid = lo + (hi - lo) / 2u; const unsigned c = count_gt(mid);
            if (c == (unsigned)TOPK) { thr = mid; found = true; break; } else if (c > (unsigned)TOPK) lo = mid; else hi = mid; }
        if (found) {
#pragma unroll
            for (int i = 0; i < 8; ++i) sel[i] = key[i] > thr;
        } else {
            const unsigned cg = count_gt(hi); int need = TOPK - (int)cg;
            if (tid == 0) { for (int s = 0; s <= t && need > 0; ++s) if (skey[s] == hi) { sflag[s] = 1; --need; } }
            __syncthreads();
#pragma unroll
            for (int i = 0; i < 8; ++i) sel[i] = key[i] > hi || (key[i] == hi && sflag[tid + 256 * i]);
        }
    }
#pragma unroll
    for (int i = 0; i < 8; ++i) if (sel[i]) { int bit; const size_t w = mask_word(b, t, tid + 256 * i, bit); atomicOr((u64*)(ws + WS_MASK) + w, 1ull << bit); }
}
__global__ void __launch_bounds__(256) nv_dsa(Params P) {
    unsigned char* ws = P.ws;
    const int idx = blockIdx.x * 256 + threadIdx.x; const int h = idx & 7, tok = idx >> 3, b = tok / S, t = tok % S;
    float q[64], o[64];
    { const f16* qp = (const f16*)(ws + WS_QA) + (size_t)tok * 512 + h * 64;
#pragma unroll
      for (int d = 0; d < 64; ++d) { q[d] = (float)qp[d]; o[d] = 0.f; } }
    float m = -1e30f, l = 0.f;
    for (int s = 0; s <= t; ++s) {
        int bit; const size_t w = mask_word(b, t, s, bit); if (!((((const u64*)(ws + WS_MASK))[w] >> bit) & 1ull)) continue;
        const f16* kp = (const f16*)(ws + WS_KA) + ((size_t)b * S + s) * 64; const f16* vp = (const f16*)(ws + WS_VA) + ((size_t)b * S + s) * 64;
        float d0 = 0.f;
#pragma unroll
        for (int d = 0; d < 64; ++d) d0 += q[d] * (float)kp[d];
        const float mn = fmaxf(m, d0), f = exp2f(m - mn), pe = exp2f(d0 - mn);
        l = l * f + pe; m = mn;
#pragma unroll
        for (int d = 0; d < 64; ++d) o[d] = o[d] * f + pe * (float)vp[d];
    }
    const float il = 1.f / l; const f16* sg = (const f16*)(ws + WS_SGA) + (size_t)tok * 512 + h * 64; f16* u = (f16*)(ws + WS_U) + (size_t)tok * 1024 + h * 64;
#pragma unroll
    for (int d = 0; d < 64; ++d) u[d] = (f16)(o[d] * il * (float)sg[d]);
}
__global__ void __launch_bounds__(256) nv_merged(Params P) {
    unsigned char* ws = P.ws; const size_t idx = (size_t)blockIdx.x * 256 + threadIdx.x; const int t = (int)(idx >> 10), n = (int)(idx & 1023);
    const f16* u = (const f16*)(ws + WS_U) + (size_t)t * 1024;
    const float ya = dot_h(u, (const f16*)(ws + WS_WBA) + (size_t)n * 512, 512), yb = dot_h(u + 512, (const f16*)(ws + WS_WBB) + (size_t)n * 512, 512);
    const f16* mg = (const f16*)(ws + WS_MG) + (size_t)t * 2048;
    ((f16*)(ws + WS_MERGED))[idx] = (f16)((float)mg[n] * ya + (float)mg[1024 + n] * yb);
}
__global__ void __launch_bounds__(256) nv_out(Params P) {
    unsigned char* ws = P.ws; const size_t idx = (size_t)blockIdx.x * 256 + threadIdx.x; const int t = (int)(idx >> 10), n = (int)(idx & 1023);
    const float v = dot_h((const f16*)(ws + WS_MERGED) + (size_t)t * 1024, (const f16*)(ws + WS_WO) + (size_t)n * 1024, 1024);
    ((f16*)(ws + WS_OUT16))[idx] = (f16)v; atomicAdd((float*)(ws + WS_ROWSQ) + t, v * v);
}
__device__ __forceinline__ void ew_x1(const Params& P, size_t gt, size_t GT) {
    unsigned char* ws = P.ws; const size_t n8 = (size_t)T * D / 8;
    for (size_t i = gt; i < n8; i += GT) { const int t = (int)(i >> 7), c8 = (int)(i & 127);
        const float rstd = rsqrtf(((const float*)(ws + WS_ROWSQ))[t] * (1.f / D) + EPS);
        const f16x8 o = ((const f16x8*)(ws + WS_OUT16))[i]; const f32x4 xa = ((const f32x4*)P.x)[2 * i], xb = ((const f32x4*)P.x)[2 * i + 1];
        const f32x4 ga = ((const f32x4*)P.g_post)[2 * c8], gb = ((const f32x4*)P.g_post)[2 * c8 + 1];
        f16x8 r; r[0] = (f16)(xa.x + (float)o[0] * rstd * ga.x); r[1] = (f16)(xa.y + (float)o[1] * rstd * ga.y); r[2] = (f16)(xa.z + (float)o[2] * rstd * ga.z); r[3] = (f16)(xa.w + (float)o[3] * rstd * ga.w);
        r[4] = (f16)(xb.x + (float)o[4] * rstd * gb.x); r[5] = (f16)(xb.y + (float)o[5] * rstd * gb.y); r[6] = (f16)(xb.z + (float)o[6] * rstd * gb.z); r[7] = (f16)(xb.w + (float)o[7] * rstd * gb.w);
        ((f16x8*)(ws + WS_X116))[i] = r; }
}
__global__ void __launch_bounds__(256) k_x1(Params P) { ew_x1(P, (size_t)blockIdx.x * 256 + threadIdx.x, (size_t)gridDim.x * 256); }
__global__ void __launch_bounds__(256) nv_gate(Params P) {
    unsigned char* ws = P.ws; const size_t idx = (size_t)blockIdx.x * 256 + threadIdx.x; const int t = (int)(idx >> 10), n = (int)(idx & 1023);
    const float gz = dot_h((const f16*)(ws + WS_X116) + (size_t)t * 1024, (const f16*)(ws + WS_WPG) + (size_t)n * 1024, 1024);
    const float e = dot_h((const f16*)(ws + WS_P16) + (size_t)t * DPLE, (const f16*)(ws + WS_WPLE) + (size_t)n * DPLE, DPLE);
    const float v = sigmoidf_(gz) * e; ((f16*)(ws + WS_V16))[idx] = (f16)v; atomicAdd((float*)(ws + WS_ROWSQ) + T + t, v * v);
}
__device__ __forceinline__ void ew_final(const Params& P, size_t gt, size_t GT) {
    unsigned char* ws = P.ws; const size_t n8 = (size_t)T * D / 8;
    for (size_t i = gt; i < n8; i += GT) { const int t = (int)(i >> 7), c8 = (int)(i & 127);
        const float r1 = rsqrtf(((const float*)(ws + WS_ROWSQ))[t] * (1.f / D) + EPS), r2 = rsqrtf(((const float*)(ws + WS_ROWSQ))[T + t] * (1.f / D) + EPS);
        const f16x8 o = ((const f16x8*)(ws + WS_OUT16))[i], v = ((const f16x8*)(ws + WS_V16))[i];
        const f32x4 xa = ((const f32x4*)P.x)[2 * i], xb = ((const f32x4*)P.x)[2 * i + 1];
        const f32x4 ga = ((const f32x4*)P.g_post)[2 * c8], gb = ((const f32x4*)P.g_post)[2 * c8 + 1], ha = ((const f32x4*)P.g_ple)[2 * c8], hb = ((const f32x4*)P.g_ple)[2 * c8 + 1];
        f32x4 ya, yb;
        ya.x = xa.x + (float)o[0] * r1 * ga.x + (float)v[0] * r2 * ha.x; ya.y = xa.y + (float)o[1] * r1 * ga.y + (float)v[1] * r2 * ha.y;
        ya.z = xa.z + (float)o[2] * r1 * ga.z + (float)v[2] * r2 * ha.z; ya.w = xa.w + (float)o[3] * r1 * ga.w + (float)v[3] * r2 * ha.w;
        yb.x = xb.x + (float)o[4] * r1 * gb.x + (float)v[4] * r2 * hb.x; yb.y = xb.y + (float)o[5] * r1 * gb.y + (float)v[5] * r2 * hb.y;
        yb.z = xb.z + (float)o[6] * r1 * gb.z + (float)v[6] * r2 * hb.z; yb.w = xb.w + (float)o[7] * r1 * gb.w + (float)v[7] * r2 * hb.w;
        ((f32x4*)P.out)[2 * i] = ya; ((f32x4*)P.out)[2 * i + 1] = yb; }
}
__global__ void __launch_bounds__(256) k_final(Params P) { ew_final(P, (size_t)blockIdx.x * 256 + threadIdx.x, (size_t)gridDim.x * 256); }


namespace cg = cooperative_groups;
__global__ void __launch_bounds__(512, 2) k_mega(Params P) {
    extern __shared__ __attribute__((aligned(16))) unsigned char lds[];
    cg::grid_group grid = cg::this_grid();
    const int G = gridDim.x, bx = blockIdx.x; const int vcu = (G % 8 == 0) ? (bx % 8) * (G / 8) + bx / 8 : bx;
    p0_prologue(P, (LAS unsigned char*)lds, bx, G);
#if PROBE_DUP & 1
    __syncthreads(); p0_prologue(P, (LAS unsigned char*)lds, bx, G);
#endif
    grid.sync();
    { pg8::Gemm g{(const f16*)(P.ws + WS_H16), (const f16*)(P.ws + WS_W1T), D, D, D}; pg8::StaticOrder So; So.init(T, N1, G, bx); EpiG1 E{P.ws, P.b_forget};
      pg8::gemm_phase<EpiG1>((LAS unsigned char*)lds, g, So, E);
#if PROBE_DUP & 2
      pg8::gemm_phase<EpiG1>((LAS unsigned char*)lds, g, So, E);
#endif
#if PROBE_DUP & 4096
      { EpiNull En{(float*)(P.ws + WS_ROWSQ) + 2 * T}; pg8::gemm_phase<EpiNull>((LAS unsigned char*)lds, g, So, En); }
#endif
    }
    grid.sync();
    ph_fox(P, (char*)lds, vcu, G);
#if PROBE_DUP & 4
    ph_fox(P, (char*)lds, vcu, G);
#endif
    ph_dsa(P, (char*)lds, vcu, G);
#if PROBE_DUP & 8
    ph_dsa(P, (char*)lds, vcu, G);
#endif
    grid.sync();
    ph_merged(P, (LAS unsigned char*)lds, G, bx);
#if PROBE_DUP & 16
    ph_merged(P, (LAS unsigned char*)lds, G, bx);
#endif
    grid.sync();
    ph_out(P, (LAS unsigned char*)lds, G, bx);
#if PROBE_DUP & 32
    ph_out(P, (LAS unsigned char*)lds, G, bx, 2 * T);
#endif
    grid.sync();
    ew_x1(P, (size_t)bx * 512 + threadIdx.x, (size_t)G * 512);
#if PROBE_DUP & 128
    ew_x1(P, (size_t)bx * 512 + threadIdx.x, (size_t)G * 512);
#endif
    grid.sync();
    ph_gate(P, (LAS unsigned char*)lds, G, bx);
#if PROBE_DUP & 64
    ph_gate(P, (LAS unsigned char*)lds, G, bx, 3 * T);
#endif
    grid.sync();
    ew_final(P, (size_t)bx * 512 + threadIdx.x, (size_t)G * 512);
#if PROBE_DUP & 128
    ew_final(P, (size_t)bx * 512 + threadIdx.x, (size_t)G * 512);
#endif
}

extern "C" void kernel_launch(void* const* d_in, const int* in_sizes, int n_in, void* d_out, int out_size, void* d_ws, size_t ws_size, hipStream_t stream) {
    if (n_in != 13 || in_sizes[0] != T * D || out_size != T * D || ws_size < WS_END) { fprintf(stderr, "kernel_launch: unexpected shapes / workspace (n_in %d, ws %zu < %zu)\n", n_in, ws_size, (size_t)WS_END); return; }
    Params P{};
    P.x = (const float*)d_in[0]; P.p = (const float*)d_in[1]; P.w_in = (const float*)d_in[2]; P.b_forget = (const float*)d_in[3]; P.w_ba = (const float*)d_in[4]; P.w_bb = (const float*)d_in[5];
    P.w_merge = (const float*)d_in[6]; P.w_out = (const float*)d_in[7]; P.g_pre = (const float*)d_in[8]; P.g_post = (const float*)d_in[9]; P.w_ple = (const float*)d_in[10]; P.w_pg = (const float*)d_in[11]; P.g_ple = (const float*)d_in[12];
    P.out = (float*)d_out; P.ws = (unsigned char*)d_ws;
#if USE_MEGA
    static int grid_blocks = 0;
    if (!grid_blocks) {
        int dev = 0, cus = 0, per_cu = 0;
        (void)hipGetDevice(&dev); (void)hipDeviceGetAttribute(&cus, hipDeviceAttributeMultiprocessorCount, dev);
        if (hipFuncSetAttribute((const void*)k_mega, hipFuncAttributeMaxDynamicSharedMemorySize, GEMM_LDS) != hipSuccess) { fprintf(stderr, "kernel_launch: hipFuncSetAttribute failed\n"); grid_blocks = -1; return; }
        if (hipOccupancyMaxActiveBlocksPerMultiprocessor(&per_cu, (const void*)k_mega, 512, GEMM_LDS) != hipSuccess || per_cu < 1) { fprintf(stderr, "kernel_launch: occupancy query failed (%d)\n", per_cu); grid_blocks = -1; return; }
        grid_blocks = cus * per_cu;
    }
    if (grid_blocks < 0) return;
    void* args[] = {&P};
    const hipError_t e = hipLaunchCooperativeKernel((const void*)k_mega, dim3(grid_blocks), dim3(512), args, GEMM_LDS, stream);
    if (e != hipSuccess) fprintf(stderr, "cooperative launch failed: %s (grid %d)\n", hipGetErrorString(e), grid_blocks);
#else
    static bool attr = false;
    if (!attr) { (void)hipFuncSetAttribute((const void*)k_p0, hipFuncAttributeMaxDynamicSharedMemorySize, 8 * 8704); (void)hipFuncSetAttribute((const void*)k_gemm1, hipFuncAttributeMaxDynamicSharedMemorySize, GEMM_LDS);
        (void)hipFuncSetAttribute((const void*)k_merged, hipFuncAttributeMaxDynamicSharedMemorySize, GEMM_LDS); (void)hipFuncSetAttribute((const void*)k_out, hipFuncAttributeMaxDynamicSharedMemorySize, GEMM_LDS); (void)hipFuncSetAttribute((const void*)k_gate, hipFuncAttributeMaxDynamicSharedMemorySize, GEMM_LDS);
        (void)hipFuncSetAttribute((const void*)k_fox, hipFuncAttributeMaxDynamicSharedMemorySize, ATT_LDS); (void)hipFuncSetAttribute((const void*)k_dsa_attn, hipFuncAttributeMaxDynamicSharedMemorySize, ATT_LDS); (void)hipFuncSetAttribute((const void*)k_dsa, hipFuncAttributeMaxDynamicSharedMemorySize, ATT_LDS); attr = true; }
    hipLaunchKernelGGL(k_p0, dim3(256), dim3(512), 8 * 8704, stream, P);
#if USE_NV_GEMM1
    hipLaunchKernelGGL(nv_gemm1, dim3((unsigned)(((size_t)T * N1 + 255) / 256)), dim3(256), 0, stream, P);
#else
    hipLaunchKernelGGL(k_gemm1, dim3(256), dim3(512), GEMM_LDS, stream, P);
#endif
#if USE_NV_FOX
    hipLaunchKernelGGL(nv_cumsum, dim3(1), dim3(256), 0, stream, P);
    hipLaunchKernelGGL(nv_fox, dim3(T * 8 / 256), dim3(256), 0, stream, P);
#else
    hipLaunchKernelGGL(k_fox, dim3(256), dim3(512), ATT_LDS, stream, P);
#endif
#if USE_NV_IDX
    hipLaunchKernelGGL(nv_indexer, dim3(T), dim3(256), 0, stream, P);
#if USE_NV_DSA
    hipLaunchKernelGGL(nv_dsa, dim3(T * 8 / 256), dim3(256), 0, stream, P);
#else
    hipLaunchKernelGGL(k_dsa_attn, dim3(256), dim3(512), ATT_LDS, stream, P);
#endif
#else
    hipLaunchKernelGGL(k_dsa, dim3(256), dim3(512), ATT_LDS, stream, P);
#endif
#if USE_NV_POST
    hipLaunchKernelGGL(nv_merged, dim3(T * 1024 / 256), dim3(256), 0, stream, P);
    hipLaunchKernelGGL(nv_out, dim3(T * 1024 / 256), dim3(256), 0, stream, P);
#else
    hipLaunchKernelGGL(k_merged, dim3(256), dim3(512), GEMM_LDS, stream, P);
    hipLaunchKernelGGL(k_out, dim3(256), dim3(512), GEMM_LDS, stream, P);
#endif
    hipLaunchKernelGGL(k_x1, dim3(2048), dim3(256), 0, stream, P);
#if USE_NV_POST
    hipLaunchKernelGGL(nv_gate, dim3(T * 1024 / 256), dim3(256), 0, stream, P);
#else
    hipLaunchKernelGGL(k_gate, dim3(256), dim3(512), GEMM_LDS, stream, P);
#endif
    hipLaunchKernelGGL(k_final, dim3(2048), dim3(256), 0, stream, P);
#endif
}
```

```cpp
#include <hip/hip_runtime.h>
#include <hip/hip_cooperative_groups.h>
#include <cstdio>
#include <cstdint>
#ifndef IDX_AMAX
#define IDX_AMAX 1
#endif
#ifndef IDX_PAIR
#define IDX_PAIR 1
#endif
#ifndef GATE_PF
#define GATE_PF 1
#endif
#ifndef DSA_PRE
#define DSA_PRE 1
#endif
#ifndef DSA_QWARM
#define DSA_QWARM 1
#endif
#ifndef EW_LIFO
#define EW_LIFO 1
#endif
#ifndef GEMM_LIFO
#define GEMM_LIFO 3
#endif
#ifndef WARM_SKIP
#define WARM_SKIP 0
#endif
#ifndef PROBE_REP
#define PROBE_REP 1
#endif
#ifndef G1_WGM
#define G1_WGM 4
#endif
#ifndef PROBE_DUP
#define PROBE_DUP 0
#endif
#ifndef USE_MEGA
#define USE_MEGA 1
#endif
#ifndef USE_NV_IDX
#define USE_NV_IDX 0
#endif
#ifndef USE_NV_FOX
#define USE_NV_FOX 0
#endif
#ifndef USE_NV_DSA
#define USE_NV_DSA 0
#endif
#ifndef USE_NV_POST
#define USE_NV_POST 0
#endif
#ifndef USE_NV_GEMM1
#define USE_NV_GEMM1 0
#endif

typedef _Float16 f16;
typedef _Float16 f16x2 __attribute__((ext_vector_type(2)));
typedef _Float16 f16x4 __attribute__((ext_vector_type(4)));
typedef _Float16 f16x8 __attribute__((ext_vector_type(8)));
typedef float f32x2 __attribute__((ext_vector_type(2)));
typedef float f32x4 __attribute__((ext_vector_type(4)));
typedef float f32x16 __attribute__((ext_vector_type(16)));
typedef unsigned u32x2 __attribute__((ext_vector_type(2)));
typedef unsigned u32x4 __attribute__((ext_vector_type(4)));
typedef unsigned long long u64;
#define LAS __attribute__((address_space(3)))

constexpr int NB = 32, S = 2048, T = NB * S, D = 1024, DPLE = 256, DIN = 3792;
constexpr int N1 = 5888;
constexpr int TOPK = 256;
constexpr float EPS = 1e-6f;
constexpr float LOG2E = 1.4426950408889634f;
constexpr float C2 = 0.125f * 1.4426950408889634f;
constexpr float IDX_SCALE = 0.044194173824159216f;
constexpr int O_QA = 0, O_KA = 512, O_VA = 576, O_GA = 640, O_QI = 1152, O_KI = 1664, O_WI = 1728, O_QB = 1736, O_KB = 2248, O_VB = 2760, O_FB = 3272, O_GB = 3280;
constexpr int P_QA = 0, P_QI = 512, P_QB = 1024, P_KB = 1536, P_VB = 2048, P_GA = 2560, P_GB = 3072, P_SM = 3584, P_MG = 3840;

constexpr size_t MiB = 1u << 20;
constexpr size_t WS_CTL = 0, WS_ROPE = 1 * MiB, WS_W1T = 2 * MiB, WS_WBA = 14 * MiB, WS_WBB = 15 * MiB, WS_WO = 16 * MiB, WS_WPG = 18 * MiB, WS_WPLE = 20 * MiB,
                 WS_ROWSQ = 21 * MiB, WS_WI = 22 * MiB, WS_LOGF = 24 * MiB, WS_CSUM = 26 * MiB, WS_KA = 28 * MiB, WS_VA = 36 * MiB, WS_KI = 44 * MiB, WS_MASK = 52 * MiB,
                 WS_P16 = 68 * MiB, WS_H16 = 100 * MiB, WS_U = 100 * MiB  , WS_MG = 228 * MiB,
                 WS_QA = 484 * MiB, WS_QI = 548 * MiB, WS_QB = 612 * MiB, WS_KB = 676 * MiB, WS_VB = 740 * MiB, WS_SGA = 804 * MiB, WS_SGB = 868 * MiB, WS_END = 932 * MiB,
                 WS_MERGED = 484 * MiB  , WS_OUT16 = 612 * MiB  , WS_X116 = 740 * MiB  , WS_E16 = 356 * MiB  , WS_V16 = 228 * MiB  ;

struct Params {
    const float *x, *p, *w_in, *b_forget, *w_ba, *w_bb, *w_merge, *w_out, *g_pre, *g_post, *w_ple, *w_pg, *g_ple;
    float* out; unsigned char* ws;
};

__device__ __forceinline__ float wave_sum(float v) {
#pragma unroll
    for (int o = 1; o < 64; o <<= 1) v += __shfl_xor(v, o);
    return v;
}
#if USE_NV_GEMM1 || USE_NV_POST
constexpr float W_PRESCALE = 1.f;
#else
constexpr float W_PRESCALE = -1.4426950408889634f;
#endif
constexpr float NEG_LN2 = -0.6931471805599453f;
__device__ __forceinline__ float gate_t(float a) { return __builtin_amdgcn_rcpf(1.0f + __builtin_amdgcn_exp2f(a)); }
__device__ __forceinline__ float gate1(float a, float al, float be) { return __builtin_fmaf(a, al, be) * gate_t(a); }
__device__ __forceinline__ float sigmoidf_(float z) { return __builtin_amdgcn_rcpf(1.0f + __builtin_amdgcn_exp2f(z * -LOG2E)); }
__device__ __forceinline__ float siluf_(float z) { return z * __builtin_amdgcn_rcpf(1.0f + __builtin_amdgcn_exp2f(z * -LOG2E)); }
__device__ __forceinline__ float logsigmoidf_(float z) { return fminf(z, 0.f) - 0.6931471805599453f * __builtin_amdgcn_logf(1.0f + __builtin_amdgcn_exp2f(fabsf(z) * -LOG2E)); }
__device__ __forceinline__ unsigned sortkey(float f) { const unsigned u = __float_as_uint(f); return (u & 0x80000000u) ? ~u : (u | 0x80000000u); }

__device__ __forceinline__ int w1_src(int n, int& which) {
    which = 0;
    if (n < P_QI) return O_QA + n;
    if (n < P_QB) return O_QI + (n - P_QI);
    if (n < P_KB) return O_QB + (n - P_QB);
    if (n < P_VB) return O_KB + (n - P_KB);
    if (n < P_GA) return O_VB + (n - P_VB);
    if (n < P_GB) return O_GA + (n - P_GA);
    if (n < P_SM) return O_GB + (n - P_GB);
    if (n < P_MG) { const int c = n - P_SM;
        if (c < 64) return O_KA + c; if (c < 128) return O_VA + (c - 64); if (c < 192) return O_KI + (c - 128);
        if (c < 200) return O_WI + (c - 192); if (c < 208) return O_FB + (c - 200); which = -1; return 0; }
    which = 1; return n - P_MG;
}

__device__ __forceinline__ void tr_item(const float* src, int ldw, f16* WT, int K, int n0, int k0, LAS float* scr, int lane, float scale = 1.f) {
    float tv[32];
#pragma unroll
    for (int i = 0; i < 32; ++i) { const int kk = 2 * i + (lane >> 5); tv[i] = src ? src[(size_t)(k0 + kk) * ldw] : 0.f; }
#pragma unroll
    for (int i = 0; i < 32; ++i) { const int kk = 2 * i + (lane >> 5); scr[kk * 33 + (lane & 31)] = tv[i]; }
    asm volatile("s_waitcnt lgkmcnt(0)" ::: "memory");
    const int c = lane & 7;
#pragma unroll
    for (int j = 0; j < 4; ++j) { const int n = (lane >> 3) + 8 * j; const LAS float* s = scr + (8 * c) * 33 + n;
        f16x8 o;
#pragma unroll
        for (int e = 0; e < 8; ++e) o[e] = (f16)(s[e * 33] * scale);
        *(f16x8*)(WT + (size_t)(n0 + n) * K + k0 + 8 * c) = o; }
    asm volatile("s_waitcnt lgkmcnt(0)" ::: "memory");
}
__device__ __forceinline__ void sincos_d(double a, float& sn, float& cs) {
    const double TWO_PI = 6.283185307179586476925, INV = 0.15915494309189533576888;
    double r = a - rint(a * INV) * TWO_PI;
    const double HALF_PI = 1.57079632679489661923;
    const double qd = rint(r / HALF_PI); const int q = ((int)qd) & 3; const double y = r - qd * HALF_PI, y2 = y * y;
    const double s = y * (1.0 + y2 * (-1.0 / 6 + y2 * (1.0 / 120 + y2 * (-1.0 / 5040 + y2 * (1.0 / 362880 + y2 * (-1.0 / 39916800 + y2 * (1.0 / 6227020800.0)))))));
    const double c = 1.0 + y2 * (-0.5 + y2 * (1.0 / 24 + y2 * (-1.0 / 720 + y2 * (1.0 / 40320 + y2 * (-1.0 / 3628800 + y2 * (1.0 / 479001600.0 + y2 * (-1.0 / 87178291200.0)))))));
    double so, co;
    if (q == 0) { so = s; co = c; } else if (q == 1) { so = c; co = -s; } else if (q == 2) { so = -s; co = -c; } else { so = -c; co = s; }
    sn = (float)so; cs = (float)co;
}
__device__ __forceinline__ void p0_prologue(const Params& P, LAS unsigned char* lds, int vcu, int G) {
    const int tid = threadIdx.x, lane = tid & 63, wave = tid >> 6, NW = blockDim.x >> 6;
    LAS float* scr = (LAS float*)(lds + wave * 8704);
    const int gw = vcu * NW + wave, NGW = G * NW;
    unsigned char* ws = P.ws;
    constexpr int I_W1 = (N1 / 32) * (D / 64), I_BA = (D / 32) * (512 / 64), I_WO = (D / 32) * (D / 64), I_PLE = (D / 32) * (DPLE / 64);
    constexpr int NITEMS = I_W1 + 2 * I_BA + 2 * I_WO + I_PLE;
    for (int it = gw; it < NITEMS; it += NGW) {
        int r = it;
        if (r < I_W1) { const int nb = r % (N1 / 32), kb = r / (N1 / 32); int which; const int sc = w1_src(nb * 32 + (lane & 31), which);
            const float* src = which == 0 ? P.w_in + sc : (which == 1 ? P.w_merge + sc : nullptr);
            tr_item(src, which == 1 ? 2048 : DIN, (f16*)(ws + WS_W1T), D, nb * 32, kb * 64, scr, lane, (nb * 32 >= P_MG || (nb * 32 >= P_GA && nb * 32 < P_SM)) ? W_PRESCALE : 1.f); continue; }
        r -= I_W1;
        if (r < I_BA) { const int nb = r % 32, kb = r / 32; tr_item(P.w_ba + nb * 32 + (lane & 31), D, (f16*)(ws + WS_WBA), 512, nb * 32, kb * 64, scr, lane); continue; }
        r -= I_BA;
        if (r < I_BA) { const int nb = r % 32, kb = r / 32; tr_item(P.w_bb + nb * 32 + (lane & 31), D, (f16*)(ws + WS_WBB), 512, nb * 32, kb * 64, scr, lane); continue; }
        r -= I_BA;
        if (r < I_WO) { const int nb = r % 32, kb = r / 32; tr_item(P.w_out + nb * 32 + (lane & 31), D, (f16*)(ws + WS_WO), D, nb * 32, kb * 64, scr, lane); continue; }
        r -= I_WO;
        if (r < I_WO) { const int nb = r % 32, kb = r / 32; tr_item(P.w_pg + nb * 32 + (lane & 31), D, (f16*)(ws + WS_WPG), D, nb * 32, kb * 64, scr, lane, W_PRESCALE); continue; }
        r -= I_WO;
        { const int nb = r % 32, kb = r / 32; tr_item(P.w_ple + nb * 32 + (lane & 31), D, (f16*)(ws + WS_WPLE), DPLE, nb * 32, kb * 64, scr, lane); }
    }
    {
        f32x4 g[4];
#pragma unroll
        for (int j = 0; j < 4; ++j) g[j] = ((const f32x4*)P.g_pre)[64 * j + lane];
        for (int m = gw; m < T; m += 2 * NGW) {
            const int m2 = m + NGW; const bool has2 = m2 < T;
            const f32x4* xr = (const f32x4*)(P.x + (size_t)m * D) + lane; const f32x4* xs = (const f32x4*)(P.x + (size_t)(has2 ? m2 : m) * D) + lane;
            f32x4 v[4], u[4]; float s2 = 0.f, t2 = 0.f;
#pragma unroll
            for (int j = 0; j < 4; ++j) { v[j] = __builtin_nontemporal_load(xr + 64 * j); u[j] = __builtin_nontemporal_load(xs + 64 * j); }
#pragma unroll
            for (int j = 0; j < 4; ++j) { s2 += (v[j].x * v[j].x + v[j].y * v[j].y) + (v[j].z * v[j].z + v[j].w * v[j].w); t2 += (u[j].x * u[j].x + u[j].y * u[j].y) + (u[j].z * u[j].z + u[j].w * u[j].w); }
            const float rstd = rsqrtf(wave_sum(s2) * (1.f / D) + EPS), rstu = rsqrtf(wave_sum(t2) * (1.f / D) + EPS);
            f16x4* o = (f16x4*)((f16*)(ws + WS_H16) + (size_t)m * D) + lane; f16x4* o2 = (f16x4*)((f16*)(ws + WS_H16) + (size_t)m2 * D) + lane;
#pragma unroll
            for (int j = 0; j < 4; ++j) { f16x4 h; h[0] = (f16)(v[j].x * rstd * g[j].x); h[1] = (f16)(v[j].y * rstd * g[j].y); h[2] = (f16)(v[j].z * rstd * g[j].z); h[3] = (f16)(v[j].w * rstd * g[j].w); o[64 * j] = h; }
            if (has2) {
#pragma unroll
                for (int j = 0; j < 4; ++j) { f16x4 h; h[0] = (f16)(u[j].x * rstu * g[j].x); h[1] = (f16)(u[j].y * rstu * g[j].y); h[2] = (f16)(u[j].z * rstu * g[j].z); h[3] = (f16)(u[j].w * rstu * g[j].w); o2[64 * j] = h; } }
        }
    }
    {
        const size_t n8 = (size_t)T * DPLE / 8; const size_t gt = (size_t)vcu * blockDim.x + tid, GT = (size_t)G * blockDim.x;
        for (size_t i0 = gt; i0 < n8; i0 += 4 * GT) { f32x4 a[4], b[4];
#pragma unroll
            for (int q = 0; q < 4; ++q) { size_t i = i0 + q * GT; if (i >= n8) i = i0; a[q] = __builtin_nontemporal_load((const f32x4*)P.p + 2 * i); b[q] = __builtin_nontemporal_load((const f32x4*)P.p + 2 * i + 1); }
#pragma unroll
            for (int q = 0; q < 4; ++q) { const size_t i = i0 + q * GT; f16x8 o; o[0] = (f16)a[q].x; o[1] = (f16)a[q].y; o[2] = (f16)a[q].z; o[3] = (f16)a[q].w; o[4] = (f16)b[q].x; o[5] = (f16)b[q].y; o[6] = (f16)b[q].z; o[7] = (f16)b[q].w;
                if (i < n8) ((f16x8*)(ws + WS_P16))[i] = o; } }
        for (size_t i = gt; i < (size_t)S * 8; i += GT) { const int pos = (int)(i >> 3), fi = (int)(i & 7);
            const float frf = fi == 0 ? 1.0f : fi == 1 ? 0.19392274474868576f : fi == 2 ? 0.03760603093086393f : fi == 3 ? 0.007292664737217109f : fi == 4 ? 0.001414213562373095f
                            : fi == 5 ? 0.0002742481756762073f : fi == 6 ? 5.318295896944988e-05f : 1.031338537721246e-05f;
            const float ang = (float)pos * frf;
            float sn, cs; sincos_d((double)ang, sn, cs); ((f32x2*)(ws + WS_ROPE))[i] = (f32x2){cs, sn}; }
        for (size_t i = gt; i < (size_t)2 * T; i += GT) ((float*)(ws + WS_ROWSQ))[i] = 0.f;
#if USE_NV_IDX
        for (size_t i = gt; i < (size_t)16 * MiB / 16; i += GT) ((u32x4*)(ws + WS_MASK))[i] = (u32x4){0u, 0u, 0u, 0u};
#endif
    }
}
__global__ void __launch_bounds__(512) k_p0(Params P) {
    extern __shared__ __attribute__((aligned(16))) unsigned char lds[];
    p0_prologue(P, (LAS unsigned char*)lds, blockIdx.x, gridDim.x);
}


namespace pg8 {
constexpr int BM = 256, BK = 64, HALF = 128, HTB = HALF * BK * 2, STAGE_BYTES = 8 * HTB, NXCD = 8, WGM = 8;
__host__ __device__ __forceinline__ int lds_byte(int r, int c) { const int st = (r >> 4) * 2 + (c >> 5), rr = r & 15, cc = c & 31, ob = rr * 64 + cc * 2; return st * 1024 + (ob ^ (((ob >> 9) & 1) << 5)); }
__host__ __device__ __forceinline__ void stage_rc(int b, int& R, int& C) { const int st = b / 1024, sb = b % 1024, swz = sb ^ (((sb >> 9) & 1) << 5); R = (st >> 1) * 16 + swz / 64; C = (st & 1) * 32 + (swz % 64) / 2; }
__host__ __device__ __forceinline__ int perm32(int rho) { const int n = rho >> 4, i = rho & 15; return 8 * (i >> 2) + 4 * n + (i & 3); }
struct Unit { int pm, pn; };
struct Gemm { const f16* A; const f16* Bt; int lda, ldb, K; };
struct StaticOrder {
    int nM, nN, nwg, G, c, wgm; bool hot, rev;
    __host__ __device__ void init(int M, int N, int G_, int c_, int wgm_ = WGM) { nM = M / BM; nN = N / BM; nwg = nM * nN; G = G_; c = c_; hot = false; rev = false; wgm = wgm_; }
    __host__ __device__ bool next(int i, Unit& u) const {
        if (rev) { const int cnt = c < nwg ? (nwg - c + G - 1) / G : 0; if (i >= cnt) return false; i = cnt - 1 - i; }
        const long L = (long)i * G + c; if (L >= nwg) return false;
        int wgid = (int)L; { const int q = nwg / NXCD, r = nwg % NXCD, xcd = wgid % NXCD, off = wgid / NXCD; wgid = (xcd < r ? xcd * (q + 1) : r * (q + 1) + (xcd - r) * q) + off; }
        const int nig = wgm * nN, gid = wgid / nig, fm = gid * wgm, gsz = (nM - fm) < wgm ? (nM - fm) : wgm;
        u.pm = fm + ((wgid % nig) % gsz); u.pn = (wgid % nig) / gsz; if (hot) { u.pm &= 1; u.pn &= 1; } return true;
    }
};
template <class Epi>
__device__ __forceinline__ void gemm_phase(LAS unsigned char* lds, const Gemm g, const StaticOrder& S, const Epi& E) {
    int tid = threadIdx.x; asm volatile("" : "+v"(tid));
    const int wid = __builtin_amdgcn_readfirstlane(tid >> 6), lane = tid & 63, wr = wid >> 2, wc = wid & 3, fr = lane & 15, fq = lane >> 4;
    const int nt = g.K / BK;
    unsigned voffA[2], voffB[2];
#pragma unroll
    for (int i = 0; i < 2; ++i) { int R, C; stage_rc(tid * 16 + i * 8192, R, C); const int Rb = (R & ~31) + perm32(R & 31);
        voffA[i] = (unsigned)(R * g.lda + C) * 2u; voffB[i] = (unsigned)(Rb * g.ldb + C) * 2u; }
    const size_t kstep = (size_t)(BK * 2);
    const size_t hstepA = (size_t)HALF * g.lda * 2, hstepB = (size_t)HALF * g.ldb * 2, tstepA = 2 * hstepA, tstepB = 2 * hstepB;
    const unsigned ldsw = (unsigned)wid * 1024u;
    const int aoff = lds_byte(wr * 64 + fr, fq * 8), boff = lds_byte(wc * 32 + fr, fq * 8);
#define PG8_SA(b, h) (((b) * 2 + (h)) * HTB)
#define PG8_SB(b, h) ((4 + (b) * 2 + (h)) * HTB)
#define PG8_STAGE(bufoff, gbase, voff) do { _Pragma("unroll") for (int _i = 0; _i < 2; ++_i) \
        __builtin_amdgcn_global_load_lds((const unsigned*)((const char*)(gbase) + (voff)[_i]), (LAS unsigned*)(lds + (bufoff) + ldsw + _i * 8192), 16, 0, 0); } while (0)
#define PG8_LDA(dst, b, h) do { _Pragma("unroll") for (int m = 0; m < 4; ++m) _Pragma("unroll") for (int k = 0; k < 2; ++k) dst[m][k] = *(const LAS f16x8*)(lds + PG8_SA(b, h) + aoff + m * 2048 + k * 1024); } while (0)
#define PG8_LDB(dst, b, h) do { _Pragma("unroll") for (int n = 0; n < 2; ++n) _Pragma("unroll") for (int k = 0; k < 2; ++k) dst[n][k] = *(const LAS f16x8*)(lds + PG8_SB(b, h) + boff + n * 2048 + k * 1024); } while (0)
#define PG8_MMA(ai, bj, At, Bt) do { __builtin_amdgcn_s_setprio(1); _Pragma("unroll") for (int m = 0; m < 4; ++m) _Pragma("unroll") for (int n = 0; n < 2; ++n) _Pragma("unroll") for (int k = 0; k < 2; ++k) \
        acc[ai][bj][m][n] = __builtin_amdgcn_mfma_f32_16x16x32_f16(Bt[n][k], At[m][k], acc[ai][bj][m][n], 0, 0, 0); __builtin_amdgcn_s_setprio(0); } while (0)
#define PG8_WAIT_V(n) asm volatile("s_waitcnt vmcnt(" #n ")" ::: "memory")
#define PG8_WAIT_L(n) asm volatile("s_waitcnt lgkmcnt(" #n ")" ::: "memory")
#define PG8_BAR __builtin_amdgcn_s_barrier()
#define PG8_SCHED __builtin_amdgcn_sched_barrier(0)
    Unit cur, nxt; int ui = 0; bool warm = false;
    if (!S.next(0, cur)) return;
    f32x4 acc[2][2][4][2];
#pragma unroll
    for (int a = 0; a < 2; ++a)
#pragma unroll
        for (int b = 0; b < 2; ++b)
#pragma unroll
            for (int m = 0; m < 4; ++m)
#pragma unroll
                for (int n = 0; n < 2; ++n) acc[a][b][m][n] = (f32x4){0.f, 0.f, 0.f, 0.f};
    f16x8 At[4][2], B0[2][2], B1[2][2];
    const char* cA = (const char*)g.A + (size_t)cur.pm * tstepA; const char* cB = (const char*)g.Bt + (size_t)cur.pn * tstepB;
    PG8_STAGE(PG8_SB(0, 0), cB, voffB); PG8_STAGE(PG8_SB(0, 1), cB + hstepB, voffB); PG8_STAGE(PG8_SA(0, 0), cA, voffA); PG8_STAGE(PG8_SA(0, 1), cA + hstepA, voffA);
    if (wr == 1) PG8_BAR;
    PG8_WAIT_V(2); PG8_BAR;
    PG8_STAGE(PG8_SB(1, 0), cB + kstep, voffB); PG8_STAGE(PG8_SA(1, 0), cA + kstep, voffA); PG8_STAGE(PG8_SB(1, 1), cB + hstepB + kstep, voffB);
    PG8_WAIT_V(6); PG8_BAR;
    for (;;) {
        const bool has_next = S.next(ui + 1, nxt);
        const char* nA = has_next ? (const char*)g.A + (size_t)nxt.pm * tstepA : cA; const char* nB = has_next ? (const char*)g.Bt + (size_t)nxt.pn * tstepB : cB;
#pragma unroll 1
        for (int t = 0; t < nt; t += 2) {
            const bool last = (t == nt - 2);
            const char* a1 = cA + (size_t)(t + 1) * kstep;
            const char* a2 = last ? nA : cA + (size_t)(t + 2) * kstep; const char* b2 = last ? nB : cB + (size_t)(t + 2) * kstep;
            const char* a3 = a2 + kstep; const char* b3 = b2 + kstep;
            const bool skipw = WARM_SKIP && warm && t == 0;
            PG8_LDB(B0, 0, 0); PG8_LDB(B1, 0, 1); PG8_SCHED; PG8_LDA(At, 0, 0); PG8_STAGE(PG8_SA(1, 1), a1 + hstepA, voffA);
            if (!skipw) PG8_WAIT_V(8); PG8_WAIT_L(0); PG8_BAR; PG8_MMA(0, 0, At, B0); PG8_MMA(0, 1, At, B1); PG8_BAR; PG8_SCHED;
            PG8_LDA(At, 0, 1); PG8_STAGE(PG8_SB(0, 0), b2, voffB); PG8_STAGE(PG8_SB(0, 1), b2 + hstepB, voffB); PG8_STAGE(PG8_SA(0, 0), a2, voffA);
            if (!skipw) PG8_WAIT_V(8); PG8_WAIT_L(0); PG8_BAR; PG8_MMA(1, 0, At, B0); PG8_MMA(1, 1, At, B1); PG8_BAR; PG8_SCHED;
            PG8_LDB(B0, 1, 0); PG8_LDB(B1, 1, 1); PG8_SCHED; PG8_LDA(At, 1, 0); PG8_STAGE(PG8_SA(0, 1), a2 + hstepA, voffA);
            PG8_WAIT_V(8); PG8_WAIT_L(0); PG8_BAR; PG8_MMA(0, 0, At, B0); PG8_MMA(0, 1, At, B1); PG8_BAR; PG8_SCHED;
            PG8_LDA(At, 1, 1); PG8_STAGE(PG8_SB(1, 0), b3, voffB); PG8_STAGE(PG8_SB(1, 1), b3 + hstepB, voffB); PG8_STAGE(PG8_SA(1, 0), a3, voffA);
            PG8_WAIT_V(8); PG8_WAIT_L(0); PG8_BAR; PG8_MMA(1, 0, At, B0); PG8_MMA(1, 1, At, B1); PG8_BAR; PG8_SCHED;
        }
        if (wr == 0) PG8_BAR;
        if (WARM_SKIP && has_next) { PG8_WAIT_V(0); PG8_BAR; warm = true; }
        E(acc, cur, wr, wc, fr, fq);
        if (!has_next) break;
#pragma unroll
        for (int a = 0; a < 2; ++a)
#pragma unroll
            for (int b = 0; b < 2; ++b)
#pragma unroll
                for (int m = 0; m < 4; ++m)
#pragma unroll
                    for (int n = 0; n < 2; ++n) acc[a][b][m][n] = (f32x4){0.f, 0.f, 0.f, 0.f};
        cur = nxt; cA = nA; cB = nB; ++ui;
        if (wr == 1) PG8_BAR;
    }
    PG8_WAIT_V(0);
    PG8_BAR;
#undef PG8_SA
#undef PG8_SB
#undef PG8_STAGE
#undef PG8_LDA
#undef PG8_LDB
#undef PG8_MMA
#undef PG8_WAIT_V
#undef PG8_WAIT_L
#undef PG8_BAR
#undef PG8_SCHED
}
}

#ifndef EPI_NT
#define EPI_NT 0
#endif
#define EPI_ST_STREAM(p, v) __builtin_nontemporal_store((v), (p))
#if EPI_NT == 1
#define EPI_ST(p, v) __builtin_nontemporal_store((v), (p))
#else
#define EPI_ST(p, v) (*(p) = (v))
#endif
#ifndef EPI_TR
#define EPI_TR 1
#endif
__device__ __forceinline__ f16x8 epi_tr(f16x8 v, int src4) { if (!EPI_TR) return v; u32x4 w = __builtin_bit_cast(u32x4, v), r;
    r[0] = (unsigned)__builtin_amdgcn_ds_bpermute(src4, (int)w[0]); r[1] = (unsigned)__builtin_amdgcn_ds_bpermute(src4, (int)w[1]);
    r[2] = (unsigned)__builtin_amdgcn_ds_bpermute(src4, (int)w[2]); r[3] = (unsigned)__builtin_amdgcn_ds_bpermute(src4, (int)w[3]); return __builtin_bit_cast(f16x8, r); }
__device__ __forceinline__ f16x8 pack8(const f32x4 a, const f32x4 b) { f16x8 o; o[0] = (f16)a[0]; o[1] = (f16)a[1]; o[2] = (f16)a[2]; o[3] = (f16)a[3]; o[4] = (f16)b[0]; o[5] = (f16)b[1]; o[6] = (f16)b[2]; o[7] = (f16)b[3]; return o; }

struct EpiG1 {
    unsigned char* ws; const float* b_forget;
    __device__ __forceinline__ void smalls(const f32x4 (&acc)[2][2][4][2], const pg8::Unit& u, int wr, int wc, int fr, int fq) const {
        const int row0 = u.pm * 256 + wr * 64 + fr; const bool rope = (wc == 0);
#pragma unroll
        for (int ai = 0; ai < 2; ++ai)
#pragma unroll
            for (int m = 0; m < 4; ++m) {
                const int row = row0 + ai * 128 + m * 16; const int pos = row & (S - 1);
#pragma unroll
                for (int bj = 0; bj < 2; ++bj) {
                    f32x4 v0 = acc[ai][bj][m][0], v1 = acc[ai][bj][m][1];
                    if (rope) {
                        f32x4 p0, p1;
#pragma unroll
                        for (int e = 0; e < 4; ++e) { p0[e] = __shfl_xor(v0[e], 16); p1[e] = __shfl_xor(v1[e], 16); }
                        if (fq < 2) { const f32x4* rp = (const f32x4*)(ws + WS_ROPE) + pos * 4; const f32x4 c01 = rp[0], c23 = rp[1], c45 = rp[2], c67 = rp[3];
                            const float sg = fq == 0 ? -1.f : 1.f;
                            v0[0] = v0[0] * c01[0] + sg * p0[0] * c01[1]; v0[1] = v0[1] * c01[2] + sg * p0[1] * c01[3]; v0[2] = v0[2] * c23[0] + sg * p0[2] * c23[1]; v0[3] = v0[3] * c23[2] + sg * p0[3] * c23[3];
                            v1[0] = v1[0] * c45[0] + sg * p1[0] * c45[1]; v1[1] = v1[1] * c45[2] + sg * p1[1] * c45[3]; v1[2] = v1[2] * c67[0] + sg * p1[2] * c67[1]; v1[3] = v1[3] * c67[2] + sg * p1[3] * c67[3]; }
                    }
                    const int c = bj * 128 + wc * 32 + fq * 8;
                    if (c < 64) *(f16x8*)((f16*)(ws + WS_KA) + (size_t)row * 64 + c) = pack8(v0, v1);
                    else if (c < 128) *(f16x8*)((f16*)(ws + WS_VA) + (size_t)row * 64 + (c - 64)) = pack8(v0, v1);
                    else if (c < 192) *(f16x8*)((f16*)(ws + WS_KI) + (size_t)row * 64 + (c - 128)) = pack8(v0, v1);
                    else if (c == 192) { f32x4* o = (f32x4*)((float*)(ws + WS_WI) + (size_t)row * 8); o[0] = v0 * IDX_SCALE; o[1] = v1 * IDX_SCALE; }
                    else if (c == 200) { const f32x4 b0 = ((const f32x4*)b_forget)[0], b1 = ((const f32x4*)b_forget)[1]; f32x4 l0, l1;
#pragma unroll
                        for (int e = 0; e < 4; ++e) { l0[e] = logsigmoidf_(v0[e] + b0[e]); l1[e] = logsigmoidf_(v1[e] + b1[e]); }
                        f32x4* o = (f32x4*)((float*)(ws + WS_LOGF) + (size_t)row * 8); o[0] = l0; o[1] = l1; }
                }
            }
    }
    __device__ __forceinline__ void operator()(const f32x4 (&acc)[2][2][4][2], const pg8::Unit& u, int wr, int wc, int fr, int fq) const {
        const int pn = u.pn;
        if (pn == 14) { smalls(acc, u, wr, wc, fr, fq); return; }
        const int row0 = u.pm * 256 + wr * 64 + fr;
        f16* dst; int ld, colb; float alpha = 1.f, beta = 0.f; int gated = 0, rope = 0;
        if (pn < 2) { dst = (f16*)(ws + WS_QA); ld = 512; colb = 256 * pn; alpha = C2; rope = !(wc & 1); }
        else if (pn < 4) { dst = (f16*)(ws + WS_QI); ld = 512; colb = 256 * (pn - 2); rope = !(wc & 1); }
        else if (pn < 6) { dst = (f16*)(ws + WS_QB); ld = 512; colb = 256 * (pn - 4); alpha = C2; }
        else if (pn < 8) { dst = (f16*)(ws + WS_KB); ld = 512; colb = 256 * (pn - 6); }
        else if (pn < 10) { dst = (f16*)(ws + WS_VB); ld = 512; colb = 256 * (pn - 8); }
        else if (pn < 12) { dst = (f16*)(ws + WS_SGA); ld = 512; colb = 256 * (pn - 10); gated = 1; alpha = NEG_LN2; }
        else if (pn < 14) { dst = (f16*)(ws + WS_SGB); ld = 512; colb = 256 * (pn - 12); gated = 1; alpha = NEG_LN2; }
        else { dst = (f16*)(ws + WS_MG); ld = 2048; colb = 256 * (pn - 15); gated = 1; alpha = 0.f; beta = 1.f; }
        const int ln = fr + 16 * fq, tfr = EPI_TR ? ln >> 2 : fr, tfq = EPI_TR ? ln & 3 : fq, src4 = 4 * (tfr + 16 * tfq);
        f16* dcol = dst + colb + wc * 32 + tfq * 8 + (ptrdiff_t)(tfr - fr) * ld;
        if (gated) {
#pragma unroll
            for (int ai = 0; ai < 2; ++ai)
#pragma unroll
                for (int m = 0; m < 4; ++m)
#pragma unroll
                    for (int bj = 0; bj < 2; ++bj) { const int row = row0 + ai * 128 + m * 16; f32x4 o0, o1;
#pragma unroll
                        for (int e = 0; e < 4; ++e) { o0[e] = gate1(acc[ai][bj][m][0][e], alpha, beta); o1[e] = gate1(acc[ai][bj][m][1][e], alpha, beta); }
                        EPI_ST_STREAM((f16x8*)(dcol + (size_t)row * ld + bj * 128), epi_tr(pack8(o0, o1), src4)); }
        } else if (rope) {
#pragma unroll
            for (int ai = 0; ai < 2; ++ai)
#pragma unroll
                for (int m = 0; m < 4; ++m)
#pragma unroll
                    for (int bj = 0; bj < 2; ++bj) { const int row = row0 + ai * 128 + m * 16;
                        f32x4 v0 = acc[ai][bj][m][0], v1 = acc[ai][bj][m][1], p0, p1;
#pragma unroll
                        for (int e = 0; e < 4; ++e) { p0[e] = __shfl_xor(v0[e], 16); p1[e] = __shfl_xor(v1[e], 16); }
                        if (fq < 2) { const f32x4* rp = (const f32x4*)(ws + WS_ROPE) + (row & (S - 1)) * 4; const f32x4 c01 = rp[0], c23 = rp[1], c45 = rp[2], c67 = rp[3];
                            const float sg = fq == 0 ? -1.f : 1.f;
                            v0[0] = v0[0] * c01[0] + sg * p0[0] * c01[1]; v0[1] = v0[1] * c01[2] + sg * p0[1] * c01[3]; v0[2] = v0[2] * c23[0] + sg * p0[2] * c23[1]; v0[3] = v0[3] * c23[2] + sg * p0[3] * c23[3];
                            v1[0] = v1[0] * c45[0] + sg * p1[0] * c45[1]; v1[1] = v1[1] * c45[2] + sg * p1[1] * c45[3]; v1[2] = v1[2] * c67[0] + sg * p1[2] * c67[1]; v1[3] = v1[3] * c67[2] + sg * p1[3] * c67[3]; }
                        EPI_ST_STREAM((f16x8*)(dcol + (size_t)row * ld + bj * 128), epi_tr(pack8(v0 * alpha, v1 * alpha), src4)); }
        } else {
#pragma unroll
            for (int ai = 0; ai < 2; ++ai)
#pragma unroll
                for (int m = 0; m < 4; ++m)
#pragma unroll
                    for (int bj = 0; bj < 2; ++bj) { const int row = row0 + ai * 128 + m * 16;
                        EPI_ST_STREAM((f16x8*)(dcol + (size_t)row * ld + bj * 128), epi_tr(pack8(acc[ai][bj][m][0] * alpha, acc[ai][bj][m][1] * alpha), src4)); }
        }
    }
};
struct EpiNull { float* sink;
    __device__ __forceinline__ void operator()(const f32x4 (&acc)[2][2][4][2], const pg8::Unit& u, int wr, int wc, int fr, int fq) const {
        f32x4 s = (f32x4){0.f, 0.f, 0.f, 0.f};
#pragma unroll
        for (int ai = 0; ai < 2; ++ai)
#pragma unroll
            for (int bj = 0; bj < 2; ++bj)
#pragma unroll
                for (int m = 0; m < 4; ++m)
#pragma unroll
                    for (int n = 0; n < 2; ++n) s += acc[ai][bj][m][n];
        if (s[0] + s[1] + s[2] + s[3] == 1.2345e30f) sink[u.pm] = s[0]; } };
constexpr int GEMM_LDS = 147456;
__global__ void __launch_bounds__(512, 2) k_gemm1(Params P) {
    extern __shared__ __attribute__((aligned(16))) unsigned char lds[];
    pg8::Gemm g{(const f16*)(P.ws + WS_H16), (const f16*)(P.ws + WS_W1T), D, D, D}; pg8::StaticOrder So; So.init(T, N1, gridDim.x, blockIdx.x);
    EpiG1 E{P.ws, P.b_forget};
    pg8::gemm_phase<EpiG1>((LAS unsigned char*)lds, g, So, E);
}


template <int MODE> struct EpiGen {
    f16* dst; const f16* mul; int ldm, mulcol; const f16* add; float* rowsq;
    __device__ __forceinline__ void operator()(const f32x4 (&acc)[2][2][4][2], const pg8::Unit& u, int wr, int wc, int fr, int fq) const {
        const int row0 = u.pm * 256 + wr * 64 + fr, col0 = u.pn * 256 + wc * 32 + fq * 8;
        const int ln = fr + 16 * fq, tfr = EPI_TR ? ln >> 2 : fr, tfq = EPI_TR ? ln & 3 : fq, src4 = 4 * (tfr + 16 * tfq); const int srow = tfr - fr, scol = (tfq - fq) * 8;
        constexpr bool HAS_MUL = (MODE == 1 || MODE == 2 || MODE == 4), HAS_ADD = (MODE == 2);
#pragma unroll
        for (int ai = 0; ai < 2; ++ai) {
            f16x8 mv[4][2], av[4][2];
#pragma unroll
            for (int m = 0; m < 4; ++m)
#pragma unroll
                for (int bj = 0; bj < 2; ++bj) { const int row = row0 + ai * 128 + m * 16, col = col0 + bj * 128;
                    if (HAS_MUL) mv[m][bj] = *(const f16x8*)(mul + (size_t)row * ldm + mulcol + col);
                    if (HAS_ADD) av[m][bj] = *(const f16x8*)(add + (size_t)row * 1024 + col); }
#pragma unroll
            for (int m = 0; m < 4; ++m) {
                const int row = row0 + ai * 128 + m * 16; float ss = 0.f;
#pragma unroll
                for (int bj = 0; bj < 2; ++bj) {
                    const int col = col0 + bj * 128; f32x4 v0 = acc[ai][bj][m][0], v1 = acc[ai][bj][m][1];
                    if (MODE == 4) {
#pragma unroll
                        for (int e = 0; e < 4; ++e) { v0[e] = W_PRESCALE == 1.f ? sigmoidf_(v0[e]) : gate_t(v0[e]); v1[e] = W_PRESCALE == 1.f ? sigmoidf_(v1[e]) : gate_t(v1[e]); } }
                    if (HAS_MUL) {
#pragma unroll
                        for (int e = 0; e < 4; ++e) { v0[e] *= (float)mv[m][bj][e]; v1[e] *= (float)mv[m][bj][4 + e]; } }
                    if (HAS_ADD) {
#pragma unroll
                        for (int e = 0; e < 4; ++e) { v0[e] += (float)av[m][bj][e]; v1[e] += (float)av[m][bj][4 + e]; } }
                    if (MODE == 3 || MODE == 4) {
#pragma unroll
                        for (int e = 0; e < 4; ++e) ss += v0[e] * v0[e] + v1[e] * v1[e]; }
                    EPI_ST((f16x8*)(dst + (size_t)(row + srow) * 1024 + col + scol), epi_tr(pack8(v0, v1), src4));
                }
                if (MODE == 3 || MODE == 4) { ss += __shfl_xor(ss, 16); ss += __shfl_xor(ss, 32); if (fq == 0) atomicAdd(rowsq + row, ss); }
            }
            if (HAS_MUL) asm volatile("" ::: "memory");
        }
    }
};
__device__ __forceinline__ void ph_merged(const Params& P, LAS unsigned char* lds, int G, int c) {
    unsigned char* ws = P.ws; pg8::StaticOrder So; So.init(T, D, G, c);
    { pg8::Gemm g{(const f16*)(ws + WS_U), (const f16*)(ws + WS_WBA), 1024, 512, 512}; EpiGen<1> E{(f16*)(ws + WS_MERGED), (const f16*)(ws + WS_MG), 2048, 0, nullptr, nullptr}; pg8::gemm_phase(lds, g, So, E); }
    So.rev = (GEMM_LIFO & 1) != 0;
    { pg8::Gemm g{(const f16*)(ws + WS_U) + 512, (const f16*)(ws + WS_WBB), 1024, 512, 512}; EpiGen<2> E{(f16*)(ws + WS_MERGED), (const f16*)(ws + WS_MG), 2048, 1024, (const f16*)(ws + WS_MERGED), nullptr}; pg8::gemm_phase(lds, g, So, E); }
}
__device__ __forceinline__ void ph_out(const Params& P, LAS unsigned char* lds, int G, int c, int rsq_off = 0) {
    unsigned char* ws = P.ws; pg8::StaticOrder So; So.init(T, D, G, c);
    pg8::Gemm g{(const f16*)(ws + WS_MERGED), (const f16*)(ws + WS_WO), 1024, 1024, 1024}; EpiGen<3> E{(f16*)(ws + WS_OUT16), nullptr, 0, 0, nullptr, (float*)(ws + WS_ROWSQ) + rsq_off}; pg8::gemm_phase(lds, g, So, E);
}
__device__ __forceinline__ void ph_gate(const Params& P, LAS unsigned char* lds, int G, int c, int rsq_off = T) {
    unsigned char* ws = P.ws; pg8::StaticOrder So; So.init(T, D, G, c);
    So.rev = (GEMM_LIFO & 2) != 0;
    { pg8::Gemm g{(const f16*)(ws + WS_P16), (const f16*)(ws + WS_WPLE), DPLE, DPLE, DPLE}; EpiGen<0> E{(f16*)(ws + WS_E16), nullptr, 0, 0, nullptr, nullptr}; pg8::gemm_phase(lds, g, So, E); }
    So.rev = false;
    { pg8::Gemm g{(const f16*)(ws + WS_X116), (const f16*)(ws + WS_WPG), 1024, 1024, 1024}; EpiGen<4> E{(f16*)(ws + WS_V16), (const f16*)(ws + WS_E16), 1024, 0, nullptr, (float*)(ws + WS_ROWSQ) + rsq_off}; pg8::gemm_phase(lds, g, So, E); }
}
__global__ void __launch_bounds__(512, 2) k_merged(Params P) { extern __shared__ __attribute__((aligned(16))) unsigned char lds[]; ph_merged(P, (LAS unsigned char*)lds, gridDim.x, blockIdx.x); }
__global__ void __launch_bounds__(512, 2) k_out(Params P) { extern __shared__ __attribute__((aligned(16))) unsigned char lds[]; ph_out(P, (LAS unsigned char*)lds, gridDim.x, blockIdx.x); }
__global__ void __launch_bounds__(512, 2) k_gate(Params P) { extern __shared__ __attribute__((aligned(16))) unsigned char lds[]; ph_gate(P, (LAS unsigned char*)lds, gridDim.x, blockIdx.x); }


namespace att {
typedef short s16x4 __attribute__((ext_vector_type(4)));
typedef short s16x8 __attribute__((ext_vector_type(8)));
constexpr int NW = 8, QBLK = 32, KVBLK = 64, NSLOT = 3, SLOTB = 8192;
constexpr int LDS_K = 0, LDS_V = NSLOT * SLOTB, LDS_WS = 2 * NSLOT * SLOTB, LDS_OST = LDS_WS + NW * 64 * 4, LDS_AUX = LDS_OST + NW * 4096, LDS_PK = LDS_AUX + 8192, LDS_BYTES = LDS_PK + 8192;
__device__ __forceinline__ int crow(int r, int hi) { return (r & 3) + 8 * (r >> 2) + 4 * hi; }
#define SBAR() __builtin_amdgcn_sched_barrier(0)
__device__ __forceinline__ void glds16(const void* gsrc, unsigned lds_dst) { unsigned keep;
    asm volatile("s_mov_b32 %0, m0\n\ts_mov_b32 m0, %2\n\ts_nop 0\n\tglobal_load_lds_dwordx4 %1, off\n\ts_mov_b32 m0, %0" : "=&s"(keep) : "v"(gsrc), "s"(lds_dst) : "memory"); }
__device__ __forceinline__ float max3f(float a, float b, float c) { float r; asm("v_max3_f32 %0, %1, %2, %3" : "=v"(r) : "v"(a), "v"(b), "v"(c)); return r; }
__device__ __forceinline__ float max2f(float a, float b) { float r; asm("v_max_f32_e32 %0, %1, %2" : "=v"(r) : "v"(a), "v"(b)); return r; }
__device__ __forceinline__ float fadd_s(float a, float b) { float r; asm("v_add_f32_e32 %0, %1, %2" : "=v"(r) : "v"(a), "v"(b)); return r; }
__device__ __forceinline__ float fsub_s(float a, float b) { float r; asm("v_sub_f32_e32 %0, %1, %2" : "=v"(r) : "v"(a), "v"(b)); return r; }
__device__ __forceinline__ unsigned cvtpk_s(float lo, float hi) { return __builtin_bit_cast(unsigned, __builtin_amdgcn_cvt_pkrtz(lo, hi)); }
#define WAIT_BAR(N) asm volatile("s_waitcnt vmcnt(" #N ") lgkmcnt(0)\n\ts_barrier" ::: "memory")
typedef LAS const char* lds_cptr;
typedef short v4i16_t __attribute__((ext_vector_type(4)));
__device__ __forceinline__ void kload8(f16x8* kf, lds_cptr kp) {
    kf[0] = *(const LAS f16x8*)(kp);        kf[1] = *(const LAS f16x8*)(kp + 512);
    kf[2] = *(const LAS f16x8*)(kp + 2048); kf[3] = *(const LAS f16x8*)(kp + 2560);
    kf[4] = *(const LAS f16x8*)(kp + 4096); kf[5] = *(const LAS f16x8*)(kp + 4608);
    kf[6] = *(const LAS f16x8*)(kp + 6144); kf[7] = *(const LAS f16x8*)(kp + 6656);
}
__device__ __forceinline__ void kload2(f16x8* kf, lds_cptr kp, int j) { kf[2 * j] = *(const LAS f16x8*)(kp + j * 2048); kf[2 * j + 1] = *(const LAS f16x8*)(kp + j * 2048 + 512); }
__device__ __forceinline__ s16x4 vtr(lds_cptr p) { return __builtin_bit_cast(s16x4, __builtin_amdgcn_ds_read_tr16_b64_v4i16((LAS v4i16_t*)p)); }
__device__ __forceinline__ float rowmax(const f32x16& p0, const f32x16& p1) {
    float a = max3f(p0[0], p0[1], p1[0]), b = max3f(p0[2], p0[3], p1[1]); a = max3f(a, p1[2], p1[3]);
#pragma unroll
    for (int r = 4; r < 16; r += 4) { a = max3f(a, p0[r], p0[r + 1]); b = max3f(b, p0[r + 2], p0[r + 3]); a = max3f(a, p1[r], p1[r + 1]); b = max3f(b, p1[r + 2], p1[r + 3]); }
    const float m = max2f(a, b);
    auto rr = __builtin_amdgcn_permlane32_swap(__float_as_uint(m), __float_as_uint(m), false, false);
    return max2f(__uint_as_float(rr[0]), __uint_as_float(rr[1]));
}
#define MFMA32(a, b, c) __builtin_amdgcn_mfma_f32_32x32x16_f16((a), (b), (c), 0, 0, 0)
__device__ __forceinline__ void cmask(f32x16& p0, f32x16& p1, int jb, int qrel, int hi) {
    const float NEG = -INFINITY; const int kb = 64 * jb + 4 * hi;
#pragma unroll
    for (int r = 0; r < 16; ++r) { const int kv = kb + (r & 3) + 8 * (r >> 2); if (kv > qrel) p0[r] = NEG; if (kv + 32 > qrel) p1[r] = NEG; }
}
__device__ __forceinline__ void pv(f32x16* o, int vb, f16x8 pa0, f16x8 pa1, f16x8 pa2, f16x8 pa3) {
#pragma unroll
    for (int d0 = 0; d0 < 2; ++d0) { s16x4 lo[4], hi[4];
#pragma unroll
        for (int ks = 0; ks < 4; ++ks) {
            asm volatile("ds_read_b64_tr_b16 %0,%1 offset:%c2" : "=&v"(lo[ks]) : "v"(vb), "i"(d0 * 4096 + ks * 1024) : "memory");
            asm volatile("ds_read_b64_tr_b16 %0,%1 offset:%c2" : "=&v"(hi[ks]) : "v"(vb), "i"(d0 * 4096 + ks * 1024 + 512) : "memory"); }
        asm volatile("s_waitcnt lgkmcnt(0)" ::: "memory"); SBAR();
#define PK(k) __builtin_bit_cast(f16x8, (s16x8){lo[k][0], lo[k][1], lo[k][2], lo[k][3], hi[k][0], hi[k][1], hi[k][2], hi[k][3]})
        o[d0] = MFMA32(pa0, PK(0), o[d0]); o[d0] = MFMA32(pa1, PK(1), o[d0]); o[d0] = MFMA32(pa2, PK(2), o[d0]); o[d0] = MFMA32(pa3, PK(3), o[d0]);
#undef PK
    }
}
__device__ __forceinline__ void prefetch_kv(const f16* Kh, const f16* Vh, const int KP, char* shm) {
    int tid = threadIdx.x; asm volatile("" : "+v"(tid));
    const int lane = tid & 63; const int wid = __builtin_amdgcn_readfirstlane(tid >> 6);
    const unsigned lds0 = (unsigned)(uintptr_t)shm;
    const f16* ksrc = Kh + (long)lane * KP + wid * 8;
    const f16* vsrc = Vh + (long)(16 * (wid & 3) + (lane >> 2)) * KP + (wid >> 2) * 32 + (lane & 3) * 8;
    const unsigned kdst = lds0 + LDS_K + wid * 1024, vdst = lds0 + LDS_V + wid * 1024;
    glds16(ksrc, (unsigned)__builtin_amdgcn_readfirstlane(kdst)); glds16(vsrc, (unsigned)__builtin_amdgcn_readfirstlane(vdst));
    glds16(ksrc + (long)KVBLK * KP, (unsigned)__builtin_amdgcn_readfirstlane(kdst + SLOTB)); glds16(ksrc + 2l * KVBLK * KP, (unsigned)__builtin_amdgcn_readfirstlane(kdst + 2 * SLOTB));
}
template <int MODE, int THRL, bool PRE = false> __device__ __forceinline__ void attn_unit(const f16* Qw, const f16* __restrict__ Kh, const f16* __restrict__ Vh, const int KP, const int NT, const int qrel0, const float ct2,
                                                                          f16* Uw, const f16* SGw, char* shm) {
    int tid = threadIdx.x; asm volatile("" : "+v"(tid));
    const int lane = tid & 63, r32 = lane & 31, hi = lane >> 5; const int wid = __builtin_amdgcn_readfirstlane(tid >> 6);
    const unsigned lds0 = (unsigned)(uintptr_t)shm;
    float* wsf = (float*)(shm + LDS_WS) + wid * 64;
    const f16* ksrc = Kh + (long)lane * KP + wid * 8;
    const f16* vsrc = Vh + (long)(16 * (wid & 3) + (lane >> 2)) * KP + (wid >> 2) * 32 + (lane & 3) * 8;
    const unsigned kdst = lds0 + LDS_K + wid * 1024, vdst = lds0 + LDS_V + wid * 1024;
#define DMA_K(t, slot) glds16(ksrc + (long)(t) * KVBLK * KP, (unsigned)__builtin_amdgcn_readfirstlane(kdst + (slot)))
#define DMA_V(t, slot) glds16(vsrc + (long)(t) * KVBLK * KP, (unsigned)__builtin_amdgcn_readfirstlane(vdst + (slot)))
    const int vb0 = (int)(lds0 + LDS_V) + ((lane >> 4) & 1) * 32 + (lane & 3) * 8 + (4 * hi + ((lane & 15) >> 2)) * 64;
    f16x8 kf[8];
    const lds_cptr shm3 = (lds_cptr)shm; const lds_cptr kp0 = shm3 + LDS_K + hi * 1024 + r32 * 16; const lds_cptr vp0 = shm3 + LDS_V + ((lane >> 4) & 1) * 32 + (lane & 3) * 8 + (4 * hi + ((lane & 15) >> 2)) * 64;
    const LAS float* cs2 = (const LAS float*)(shm3 + LDS_AUX) + 4 * hi;
    const LAS u64* mwp = (const LAS u64*)(shm3 + LDS_AUX) + r32;
    const LAS unsigned* pkp = (const LAS unsigned*)(shm3 + LDS_PK) + r32;
    const unsigned one_w = hi ? 0u : 0x3C003C00u, himask = hi ? 0u : 0xFFFFFFFFu;
    u32x4 qxw = (u32x4){0u, one_w, 0u, 0u};
#define QX_BUILD() do { if (MODE == 0) { const f16 bh_ = (f16)base; const f16 bl_ = (f16)(base - (float)bh_); \
        qxw[0] = ((unsigned)__builtin_bit_cast(unsigned short, bh_) | ((unsigned)__builtin_bit_cast(unsigned short, bl_) << 16)) & himask; } } while (0)
    if (!PRE) { DMA_K(0, 0); DMA_V(0, 0); DMA_K(1, SLOTB); }
    f16x8 qr[4];
#pragma unroll
    for (int d0 = 0; d0 < 4; ++d0) qr[d0] = *reinterpret_cast<const f16x8*>(&Qw[(long)r32 * 512 + d0 * 16 + hi * 8]);
    float mhat = 0.f, l_reg = 0.f; f32x16 o[2]; o[0] = f32x16{}; o[1] = f32x16{};
    float base = (MODE == 0) ? ct2 : 0.f;
    const int qrel = qrel0 + r32;
#define INITH(C, t, HOFF, WSH) do { if (MODE == 0) { const unsigned p_ = pkp[64 * (t) + (HOFF)] & himask; const u32x4 kx_ = (u32x4){one_w, p_, 0u, 0u}; \
        C = MFMA32(__builtin_bit_cast(f16x8, kx_), __builtin_bit_cast(f16x8, qxw), f32x16{}); } \
      else { const u64 w_ = mwp[32 * (t)]; const unsigned w0_ = (unsigned)(w_ >> ((WSH) + 4 * hi)); const unsigned nb_ = __float_as_uint(base), ng_ = __float_as_uint(-1e30f); \
        _Pragma("unroll") for (int r_ = 0; r_ < 16; ++r_) { const int cb_ = (r_ & 3) + 8 * (r_ >> 2); const unsigned t0_ = (unsigned)__builtin_amdgcn_sbfe((int)w0_, cb_, 1); \
            C[r_] = __uint_as_float((t0_ & nb_) | (~t0_ & ng_)); } } } while (0)
#define INIT(C0, C1, t) do { INITH(C0, t, 0, 0); INITH(C1, t, 32, 32); } while (0)
#define CMASK(P0, P1, t) do { if (MODE == 0) { int jb_ = (t) - (NT - 4); if (jb_ >= 0) cmask(P0, P1, jb_, qrel, hi); } } while (0)
    QX_BUILD();
    bool resc = false;
#define START(P0, P1) do { const float rm = rowmax(P0, P1); resc = false; \
    { const float dl = (MODE == 0) ? rm : __builtin_fmaxf(rm, -1000.f); mhat = fadd_s(mhat, dl); base = fsub_s(base, dl); QX_BUILD(); \
      _Pragma("unroll") for (int r = 0; r < 16; ++r) { P0[r] = fsub_s(P0[r], dl); P1[r] = fsub_s(P1[r], dl); } } \
    _Pragma("unroll") for (int r = 0; r < 16; ++r) P0[r] = __builtin_amdgcn_exp2f(P0[r]); } while (0)
#define RESC() do { if (resc) { asm volatile("s_waitcnt lgkmcnt(0)" ::: "memory"); \
      _Pragma("unroll") for (int d_ = 0; d_ < 2; ++d_) _Pragma("unroll") for (int r = 0; r < 16; ++r) o[d_][r] *= wsf[crow(r, hi)]; } } while (0)
    f32x16 pA0, pA1, pB0, pB1;
    int sl_prev = 0, sl_cur = 0, sl_next = SLOTB;
#define ROT() do { sl_prev = sl_cur; sl_cur = sl_next; sl_next = (sl_next == (NSLOT - 1) * SLOTB) ? 0 : sl_next + SLOTB; } while (0)
    if (!PRE) DMA_K(2, 2 * SLOTB);
    WAIT_BAR(3);
    INIT(pA0, pA1, 0);
    { const char* kb = shm + LDS_K + hi * 1024 + r32 * 16;
#pragma unroll
      for (int d0 = 0; d0 < 4; ++d0) { const f16x8 b0 = *reinterpret_cast<const f16x8*>(kb + d0 * 2048); const f16x8 b1 = *reinterpret_cast<const f16x8*>(kb + d0 * 2048 + 512);
          pA0 = MFMA32(b0, qr[d0], pA0); pA1 = MFMA32(b1, qr[d0], pA1); } }
    asm volatile("s_nop 15\n\ts_nop 7" : "+v"(pA0), "+v"(pA1)); CMASK(pA0, pA1, 0);
    START(pA0, pA1);
#pragma unroll
    for (int r = 0; r < 16; ++r) pA1[r] = __builtin_amdgcn_exp2f(pA1[r]);
    WAIT_BAR(0);
    DMA_K(3, 0); DMA_V(1, SLOTB);
    ROT();
    kload8(kf, kp0 + sl_cur);
    WAIT_BAR(2);
    s16x4 vlo[8], vhi[8]; u32x4 pw0, pw1, pw2, pw3;
#define PKW(P, B) cvtpk_s(P[B], P[B + 1])
#define PAF(k) __builtin_bit_cast(f16x8, pw##k)
#define VFR(i) __builtin_bit_cast(f16x8, (s16x8){vlo[i][0], vlo[i][1], vlo[i][2], vlo[i][3], vhi[i][0], vhi[i][1], vhi[i][2], vhi[i][3]})
#define PIN(x) asm volatile("" : "+v"(x))
#define MX3(a, b, c) __builtin_fmaxf(__builtin_fmaxf((a), (b)), (c))
#define GAPA(MF, A0, A1, A2, A3, W0, W1, PW) do { MF; sacc += A0; sacc += A1; sacc += A2; sacc += A3; PIN(sacc); W0; W1; PIN(PW); SBAR(); } while (0)
#define EX(v) __builtin_amdgcn_exp2f(v)
#define GAPB(MF, X, B) do { MF; X[B] = EX(X[B]); X[B + 1] = EX(X[B + 1]); X[B + 2] = EX(X[B + 2]); X[B + 3] = EX(X[B + 3]); PIN(X); SBAR(); } while (0)
#define VRD(i) do { vlo[i] = vtr(vp_ + (((i) >> 2) * 4096 + ((i) & 3) * 1024)); vhi[i] = vtr(vp_ + (((i) >> 2) * 4096 + ((i) & 3) * 1024 + 512)); } while (0)
#define KRD(G, j) do { if (G) { kload2(kf, kp0 + sl_next, j); SBAR(); } } while (0)
#define STEP(C0, C1, P0, P1, t, GK, GV, GL) do { SBAR(); \
    const lds_cptr vp_ = vp0 + sl_prev; \
    INITH(C0, t, 0, 0); \
    VRD(0); SBAR(); float sacc = (P0[0] + P0[1]); \
    GAPA(C0 = MFMA32(kf[0], qr[0], C0), P0[2], P0[3], P0[4], P0[5],     pw0[0] = PKW(P0, 0), pw0[1] = PKW(P0, 2), pw0); \
    INITH(C1, t, 32, 32); \
    VRD(4); SBAR(); GAPA(C1 = MFMA32(kf[1], qr[0], C1), P0[6], P0[7], P0[8], P0[9],     pw0[2] = PKW(P0, 4), pw0[3] = PKW(P0, 6), pw0); \
    VRD(1); SBAR(); GAPA(C0 = MFMA32(kf[2], qr[1], C0),   P0[10], P0[11], P0[12], P0[13], pw1[0] = PKW(P0, 8), pw1[1] = PKW(P0, 10), pw1); \
    VRD(5); SBAR(); GAPA(C1 = MFMA32(kf[3], qr[1], C1),   P0[14], P0[15], P1[0], P1[1],   pw1[2] = PKW(P0, 12), pw1[3] = PKW(P0, 14), pw1); \
    VRD(2); SBAR(); GAPA(C0 = MFMA32(kf[4], qr[2], C0),   P1[2], P1[3], P1[4], P1[5],     pw2[0] = PKW(P1, 0), pw2[1] = PKW(P1, 2), pw2); \
    VRD(6); SBAR(); GAPA(C1 = MFMA32(kf[5], qr[2], C1),   P1[6], P1[7], P1[8], P1[9],     pw2[2] = PKW(P1, 4), pw2[3] = PKW(P1, 6), pw2); \
    VRD(3); SBAR(); GAPA(C0 = MFMA32(kf[6], qr[3], C0),   P1[10], P1[11], P1[12], P1[13], pw3[0] = PKW(P1, 8), pw3[1] = PKW(P1, 10), pw3); \
    VRD(7); SBAR(); GAPA(C1 = MFMA32(kf[7], qr[3], C1),   P1[14], P1[15], 0.f, 0.f,       pw3[2] = PKW(P1, 12), pw3[3] = PKW(P1, 14), pw3); \
    l_reg += sacc; \
    if (GK) { DMA_K((t) + 3, sl_cur); } if (GV) { DMA_V((t) + 1, sl_next); } \
    CMASK(C0, C1, t); \
    { float a = MX3(C0[0], C0[1], C1[0]), b = MX3(C0[2], C0[3], C1[1]); a = MX3(a, C1[2], C1[3]); \
      _Pragma("unroll") for (int r = 4; r < 16; r += 4) { a = MX3(a, C0[r], C0[r + 1]); b = MX3(b, C0[r + 2], C0[r + 3]); a = MX3(a, C1[r], C1[r + 1]); b = MX3(b, C1[r + 2], C1[r + 3]); } \
      float rm = __builtin_fmaxf(a, b); { auto rr = __builtin_amdgcn_permlane32_swap(__float_as_uint(rm), __float_as_uint(rm), false, false); rm = __builtin_fmaxf(__uint_as_float(rr[0]), __uint_as_float(rr[1])); } \
      resc = false; \
      if (__builtin_expect(__any(rm > (float)THRL), 0)) { const float dl = __builtin_fmaxf(rm, 0.f); mhat += dl; base -= dl; QX_BUILD(); \
        _Pragma("unroll") for (int r = 0; r < 16; ++r) { C0[r] -= dl; C1[r] -= dl; } \
        const float f = __builtin_amdgcn_exp2f(-dl); l_reg *= f; if (hi == 0) wsf[r32] = f; resc = true; } } \
    SBAR(); \
    GAPB(o[0] = MFMA32(PAF(0), VFR(0), o[0]), C0, 0); \
    GAPB(o[1] = MFMA32(PAF(0), VFR(4), o[1]), C0, 4); \
    KRD(GL, 0); GAPB(o[0] = MFMA32(PAF(1), VFR(1), o[0]), C0, 8); \
    KRD(GL, 1); GAPB(o[1] = MFMA32(PAF(1), VFR(5), o[1]), C0, 12); \
    KRD(GL, 2); GAPB(o[0] = MFMA32(PAF(2), VFR(2), o[0]), C1, 0); \
    KRD(GL, 3); GAPB(o[1] = MFMA32(PAF(2), VFR(6), o[1]), C1, 4); \
    GAPB(o[0] = MFMA32(PAF(3), VFR(3), o[0]), C1, 8); \
    GAPB(o[1] = MFMA32(PAF(3), VFR(7), o[1]), C1, 12); \
    } while (0)
    int t = 1;
#define ENDW(tt) do { if ((tt) + 3 < NT) { WAIT_BAR(2); } else if ((tt) + 2 < NT) { WAIT_BAR(1); } else { WAIT_BAR(0); } } while (0)
#undef CMASK
#define CMASK(P0, P1, t) do { } while (0)
    for (; t + 5 < NT; t += 2) {
        STEP(pB0, pB1, pA0, pA1, t, true, true, true);     WAIT_BAR(2); RESC(); ROT();
        STEP(pA0, pA1, pB0, pB1, t + 1, true, true, true); WAIT_BAR(2); RESC(); ROT();
    }
#undef CMASK
#define CMASK(P0, P1, t) do { if (MODE == 0) { int jb_ = (t) - (NT - 4); if (jb_ >= 0) cmask(P0, P1, jb_, qrel, hi); } } while (0)
    for (; t + 1 < NT; t += 2) {
        STEP(pB0, pB1, pA0, pA1, t, (t + 3 < NT), (t + 1 < NT), (t + 1 < NT));         ENDW(t);     RESC(); ROT();
        STEP(pA0, pA1, pB0, pB1, t + 1, (t + 4 < NT), (t + 2 < NT), (t + 2 < NT));     ENDW(t + 1); RESC(); ROT();
    }
    STEP(pB0, pB1, pA0, pA1, NT - 1, false, false, false); RESC();
#if GATE_PF
    f16x8 gpf[4];
#pragma unroll
    for (int i = 0; i < 4; ++i) gpf[i] = *(const f16x8*)(SGw + (long)(i * 8 + (lane >> 3)) * 512 + (lane & 7) * 8);
#endif
    { float sacc = pB0[0] + pB0[1];
#pragma unroll
      for (int r = 2; r < 16; ++r) sacc += pB0[r];
#pragma unroll
      for (int r = 0; r < 16; ++r) sacc += pB1[r];
      l_reg += sacc;
      pw0 = (u32x4){PKW(pB0, 0), PKW(pB0, 2), PKW(pB0, 4), PKW(pB0, 6)}; pw1 = (u32x4){PKW(pB0, 8), PKW(pB0, 10), PKW(pB0, 12), PKW(pB0, 14)};
      pw2 = (u32x4){PKW(pB1, 0), PKW(pB1, 2), PKW(pB1, 4), PKW(pB1, 6)}; pw3 = (u32x4){PKW(pB1, 8), PKW(pB1, 10), PKW(pB1, 12), PKW(pB1, 14)};
      SBAR(); pv(o, vb0 + sl_cur, PAF(0), PAF(1), PAF(2), PAF(3)); }
#undef PKW
#undef PAF
#undef VFR
#undef PIN
#undef MX3
#undef GAPA
#undef GAPB
#undef EX
#undef VRD
#undef KRD
#undef STEP
#undef ENDW
    { auto rr = __builtin_amdgcn_permlane32_swap(__float_as_uint(l_reg), __float_as_uint(l_reg), false, false); l_reg = __uint_as_float(rr[0]) + __uint_as_float(rr[1]); }
    if (hi == 0) wsf[32 + r32] = l_reg; asm volatile("s_waitcnt lgkmcnt(0)" ::: "memory");
    float rli[16];
#pragma unroll
    for (int r = 0; r < 16; ++r) rli[r] = __builtin_amdgcn_rcpf(wsf[32 + crow(r, hi)]);
    { f16* stg = (f16*)(shm + LDS_OST) + wid * 2048;
#pragma unroll
      for (int r = 0; r < 16; ++r) { const int orow = crow(r, hi);
#pragma unroll
          for (int d0 = 0; d0 < 2; ++d0) stg[orow * 64 + d0 * 32 + r32] = (f16)(o[d0][r] * rli[r]); }
      asm volatile("s_waitcnt lgkmcnt(0)" ::: "memory");
#pragma unroll
      for (int i = 0; i < 4; ++i) { const int row = i * 8 + (lane >> 3), ch = lane & 7; const f16x8 v = *(const f16x8*)(stg + row * 64 + ch * 8);
#if GATE_PF
          const f16x8 g = gpf[i];
#else
          const f16x8 g = *(const f16x8*)(SGw + (long)row * 512 + ch * 8);
#endif

          *(f16x8*)(Uw + (long)row * 1024 + ch * 8) = v * g; } }
    asm volatile("s_waitcnt lgkmcnt(0)\n\ts_barrier" ::: "memory");
#undef DMA_K
#undef DMA_V
#undef CMASK
#undef INIT
#undef INITH
#undef QX_BUILD
#undef START
#undef RESC
#undef ROT
}
#undef SBAR
#undef WAIT_BAR
#undef MFMA32
}

__device__ __forceinline__ void ph_fox(const Params& P, char* shm, int vcu, int G) {
    unsigned char* ws = P.ws; const int tid = threadIdx.x, lane = tid & 63, wid = tid >> 6;
    for (int bh = vcu; bh < NB * 8; bh += G) {
        const int b = bh >> 3, h = bh & 7;
        float* cs = (float*)(shm + att::LDS_AUX); float* wtot = (float*)(shm + att::LDS_WS);
        { int t2 = threadIdx.x; asm volatile("" : "+v"(t2));
          const int lane2 = t2 & 63, wid2 = t2 >> 6;
          const float* lf = (const float*)(ws + WS_LOGF) + ((size_t)b * S + t2 * 4) * 8 + h;
          float v0 = lf[0], v1 = v0 + lf[8], v2 = v1 + lf[16], v3 = v2 + lf[24]; float inc = v3;
#pragma unroll
          for (int o = 1; o < 64; o <<= 1) { const float n = __shfl_up(inc, o); if (lane2 >= o) inc += n; }
          if (lane2 == 63) wtot[wid2] = inc;
          __syncthreads();
          float off = inc - v3; for (int w = 0; w < wid2; ++w) off += wtot[w];
          const f32x4 c4 = (f32x4){(v0 + off) * LOG2E, (v1 + off) * LOG2E, (v2 + off) * LOG2E, (v3 + off) * LOG2E};
          *(f32x4*)(cs + t2 * 4) = c4;
          { u32x4 pw;
#pragma unroll
            for (int e = 0; e < 4; ++e) { const float a = -c4[e]; const f16 ah = (f16)a; const f16 al = (f16)(a - (float)ah);
                pw[e] = (unsigned)__builtin_bit_cast(unsigned short, ah) | ((unsigned)__builtin_bit_cast(unsigned short, al) << 16); }
            *(u32x4*)((unsigned*)(shm + att::LDS_PK) + t2 * 4) = pw; }
          __syncthreads(); }
        const size_t rowbase = (size_t)b * S;
        for (int qi = 0; qi < 8; ++qi) { const int qb = 7 - qi; const int q0 = qb * 256;
            const size_t tok = rowbase + q0 + wid * 32;
            const float ct2 = cs[q0 + wid * 32 + (lane & 31)];
            att::attn_unit<0, 8>((const f16*)(ws + WS_QB) + tok * 512 + h * 64, (const f16*)(ws + WS_KB) + rowbase * 512 + h * 64, (const f16*)(ws + WS_VB) + rowbase * 512 + h * 64, 512, 4 * qb + 4, wid * 32, ct2,
                                 (f16*)(ws + WS_U) + tok * 1024 + 512 + h * 64, (const f16*)(ws + WS_SGB) + tok * 512 + h * 64, shm); }
        __syncthreads();
    }
}
__device__ __forceinline__ void ph_dsa_attn(const Params& P, char* shm, int vcu, int G) {
    unsigned char* ws = P.ws; const int tid = threadIdx.x, wid = tid >> 6;
    for (int it = vcu; it < NB * 8; it += G) {
        const int b = it >> 3, j = it & 7; const size_t rowbase = (size_t)b * S;
        for (int k = 0; k < 8; ++k) { const int qt = (k & 1) ? (16 * (k >> 1) + 15 - j) : (16 * (k >> 1) + j);
            const int nt = qt / 2 + 1, NT = nt < 4 ? 4 : nt + (nt & 1);
            { const u32x4* src = (const u32x4*)((const u64*)(ws + WS_MASK) + ((size_t)b * 64 + qt) * 32 * 32); u32x4* dst = (u32x4*)(shm + att::LDS_AUX);
              if (tid < NT * 16) dst[tid] = src[tid]; }
            __syncthreads();
            const size_t tok = rowbase + qt * 32;
            att::attn_unit<1, 8>((const f16*)(ws + WS_QA) + tok * 512 + wid * 64, (const f16*)(ws + WS_KA) + rowbase * 64, (const f16*)(ws + WS_VA) + rowbase * 64, 64, NT, 0, 0.f,
                                 (f16*)(ws + WS_U) + tok * 1024 + wid * 64, (const f16*)(ws + WS_SGA) + tok * 512 + wid * 64, shm); }
    }
}

namespace idx {
constexpr int BUFB = 32768;
__device__ __forceinline__ int half_sum(int v) {
    v += __builtin_amdgcn_update_dpp(0, v, 0xB1, 0xF, 0xF, false);
    v += __builtin_amdgcn_update_dpp(0, v, 0x4E, 0xF, 0xF, false);
    v += __builtin_amdgcn_update_dpp(0, v, 0x141, 0xF, 0xF, false);
    v += __builtin_amdgcn_update_dpp(0, v, 0x140, 0xF, 0xF, false);
    v += __shfl_xor(v, 16);
    return v;
}
__device__ __forceinline__ float fmax_(float a, float b) { float r; asm("v_max_f32_e32 %0, %1, %2" : "=v"(r) : "v"(a), "v"(b)); return r; }
__device__ __forceinline__ float amax_(float a, float b) { float r; asm("v_max_f32_e64 %0, %1, |%2|" : "=v"(r) : "v"(a), "v"(b)); return r; }
__device__ __forceinline__ float fmin_(float a, float b) { float r; asm("v_min_f32_e32 %0, %1, %2" : "=v"(r) : "v"(a), "v"(b)); return r; }
__device__ __forceinline__ float dppf(float v, const int ctrl_sel) {
    const int x = __float_as_int(v);
    const int y = ctrl_sel == 0 ? __builtin_amdgcn_update_dpp(0, x, 0xB1, 0xF, 0xF, false) : ctrl_sel == 1 ? __builtin_amdgcn_update_dpp(0, x, 0x4E, 0xF, 0xF, false)
                : ctrl_sel == 2 ? __builtin_amdgcn_update_dpp(0, x, 0x141, 0xF, 0xF, false) : __builtin_amdgcn_update_dpp(0, x, 0x140, 0xF, 0xF, false);
    return __int_as_float(y);
}
__device__ __forceinline__ float half_max(float v) { v = fmax_(v, dppf(v, 0)); v = fmax_(v, dppf(v, 1)); v = fmax_(v, dppf(v, 2)); v = fmax_(v, dppf(v, 3)); return fmax_(v, __shfl_xor(v, 16)); }
__device__ __forceinline__ float half_min(float v) { v = fmin_(v, dppf(v, 0)); v = fmin_(v, dppf(v, 1)); v = fmin_(v, dppf(v, 2)); v = fmin_(v, dppf(v, 3)); return fmin_(v, __shfl_xor(v, 16)); }
constexpr float CNT_BIG = 18446744073709551616.0f;
__device__ __forceinline__ void cntp4(f32x2& acc, f32x2 big2, f32x2 nb2, f32x2 a0, f32x2 a1, f32x2 a2, f32x2 a3) {
    f32x2 t0, t1, t2, t3;
    asm volatile(
        "v_pk_fma_f32 %1, %5, %9, %10 clamp\n\tv_pk_fma_f32 %2, %6, %9, %10 clamp\n\tv_pk_fma_f32 %3, %7, %9, %10 clamp\n\tv_pk_fma_f32 %4, %8, %9, %10 clamp\n\t"
        "v_pk_add_f32 %1, %1, %2\n\tv_pk_add_f32 %3, %3, %4\n\tv_pk_add_f32 %1, %1, %3\n\tv_pk_add_f32 %0, %0, %1"
        : "+v"(acc), "=&v"(t0), "=&v"(t1), "=&v"(t2), "=&v"(t3)
        : "v"(a0), "v"(a1), "v"(a2), "v"(a3), "v"(big2), "v"(nb2));
}
__device__ __forceinline__ float clampmul(float a, float b) { float r; asm("v_mul_f32_e64 %0, %1, %2 clamp" : "=v"(r) : "v"(a), "v"(b)); return r; }
__device__ __forceinline__ float half_sumf(float v) { v += dppf(v, 0); v += dppf(v, 1); v += dppf(v, 2); v += dppf(v, 3); return v + __shfl_xor(v, 16); }
#define CNTP4(acc, nb2, kp, B) cntp4(acc, big2, nb2, kp[B], kp[B + 1], kp[B + 2], kp[B + 3])
__device__ __forceinline__ void indexer_tile(const Params& P, char* shm, const int b, const int qt, const int NTA) {
    unsigned char* ws = P.ws;
    int tid = threadIdx.x; asm volatile("" : "+v"(tid));
    const int lane = tid & 63, c = lane & 31, g = lane >> 5; const int wid = __builtin_amdgcn_readfirstlane(tid >> 6);
    const size_t rowbase = (size_t)b * S; const int q0 = qt * 32; const int ntiles = qt + 1, nchunks = (ntiles + 7) >> 3;
    const unsigned lds0 = (unsigned)(uintptr_t)shm;
    const float NINF = -__builtin_inff(), PINF = __builtin_inff();
    const f16* kig = (const f16*)(ws + WS_KI) + rowbase * 64;
#define IDX_DMA(ch) do { _Pragma("unroll") for (int pp_ = 0; pp_ < 4; ++pp_) { const int p_ = wid + 8 * pp_; const int key_ = 8 * p_ + (lane >> 3); \
        att::glds16(kig + (size_t)((ch) * 256 + key_) * 64 + (((lane & 7) ^ ((key_ >> 1) & 7)) * 8), (unsigned)__builtin_amdgcn_readfirstlane(lds0 + ((ch) & 1) * BUFB + p_ * 1024)); } } while (0)
    IDX_DMA(0);
    f16x8 aq[4];
    { const int rho = c; const int qq = 2 * ((rho >> 2) & 1) + (rho >> 4), hd = 4 * ((rho >> 3) & 1) + (rho & 3);
      const f16* qp = (const f16*)(ws + WS_QI) + (rowbase + q0 + 4 * wid + qq) * 512 + hd * 64 + 8 * g;
#pragma unroll
      for (int kk = 0; kk < 4; ++kk) aq[kk] = *(const f16x8*)(qp + 16 * kk); }
    float wq[16];
    { const f32x4* wp = (const f32x4*)((const float*)(ws + WS_WI) + (rowbase + q0 + 4 * wid + 2 * g) * 8);
      const f32x4 a0 = wp[0], a1 = wp[1], a2 = wp[2], a3 = wp[3];
      wq[0] = a0[0]; wq[1] = a0[1]; wq[2] = a0[2]; wq[3] = a0[3]; wq[4] = a1[0]; wq[5] = a1[1]; wq[6] = a1[2]; wq[7] = a1[3];
      wq[8] = a2[0]; wq[9] = a2[1]; wq[10] = a2[2]; wq[11] = a2[3]; wq[12] = a3[0]; wq[13] = a3[1]; wq[14] = a3[2]; wq[15] = a3[3]; }
    const int ql0 = 4 * wid + 2 * g, ql1 = ql0 + 1;
    f32x2 kp0[32], kp1[32];
#pragma unroll
    for (int i = 0; i < 32; ++i) { kp0[i] = (f32x2){NINF, NINF}; kp1[i] = (f32x2){NINF, NINF}; }
    float mn0 = PINF, mx0 = IDX_AMAX ? 0.f : NINF, mn1 = PINF, mx1 = IDX_AMAX ? 0.f : NINF, cp0 = 0.f, cn0 = 0.f, cp1 = 0.f, cn1 = 0.f;
    const LAS char* bbase = (const LAS char*)shm + c * 128;
    const int sw = (c >> 1) & 7;
#pragma unroll
    for (int ch = 0; ch < 8; ++ch) if (ch < nchunks) {
        asm volatile("s_waitcnt vmcnt(0)\n\ts_barrier" ::: "memory");
        if (ch + 1 < nchunks) IDX_DMA(ch + 1);
#if IDX_PAIR
#pragma unroll
        for (int j = 0; j < 8; j += 2) { const int jt = ch * 8 + j;
            if (jt < ntiles) {
                const LAS char* bp = bbase + (ch & 1) * BUFB + j * 4096;
                f32x16 acc = f32x16{}, acd = f32x16{};
#pragma unroll
                for (int kk = 0; kk < 4; ++kk) { const f16x8 bk = *(const LAS f16x8*)(bp + (((2 * kk + g) ^ sw) * 16)), bl = *(const LAS f16x8*)(bp + 4096 + (((2 * kk + g) ^ sw) * 16));
                    acc = __builtin_amdgcn_mfma_f32_32x32x16_f16(aq[kk], bk, acc, 0, 0, 0); acd = __builtin_amdgcn_mfma_f32_32x32x16_f16(aq[kk], bl, acd, 0, 0, 0); }
#define IDX_RELU16(A) asm volatile("v_max_f32_e32 %0, 0, %0\n\tv_max_f32_e32 %1, 0, %1\n\tv_max_f32_e32 %2, 0, %2\n\tv_max_f32_e32 %3, 0, %3\n\tv_max_f32_e32 %4, 0, %4\n\tv_max_f32_e32 %5, 0, %5\n\tv_max_f32_e32 %6, 0, %6\n\tv_max_f32_e32 %7, 0, %7\n\t" \
                             "v_max_f32_e32 %8, 0, %8\n\tv_max_f32_e32 %9, 0, %9\n\tv_max_f32_e32 %10, 0, %10\n\tv_max_f32_e32 %11, 0, %11\n\tv_max_f32_e32 %12, 0, %12\n\tv_max_f32_e32 %13, 0, %13\n\tv_max_f32_e32 %14, 0, %14\n\tv_max_f32_e32 %15, 0, %15" \
                             : "+v"(A[0]), "+v"(A[1]), "+v"(A[2]), "+v"(A[3]), "+v"(A[4]), "+v"(A[5]), "+v"(A[6]), "+v"(A[7]), "+v"(A[8]), "+v"(A[9]), "+v"(A[10]), "+v"(A[11]), "+v"(A[12]), "+v"(A[13]), "+v"(A[14]), "+v"(A[15]))
                asm volatile("s_nop 15\n\ts_nop 3" : "+v"(acc), "+v"(acd));
                IDX_RELU16(acc); IDX_RELU16(acd);
#undef IDX_RELU16
#pragma unroll
                for (int h2 = 0; h2 < 2; ++h2) { const int jj = jt + h2; const f32x16& A = h2 ? acd : acc;
                    float s0 = 0.f, s1 = 0.f;
#pragma unroll
                    for (int r = 0; r < 8; ++r) { s0 = __builtin_fmaf(wq[r], A[r], s0); s1 = __builtin_fmaf(wq[8 + r], A[8 + r], s1); }
                    const bool inv0 = (jj > qt) || ((jj == qt) && (c > ql0)), inv1 = (jj > qt) || ((jj == qt) && (c > ql1));
                    kp0[jj >> 1][jj & 1] = inv0 ? NINF : s0; kp1[jj >> 1][jj & 1] = inv1 ? NINF : s1;
                    const float z0 = inv0 ? 0.f : s0, z1 = inv1 ? 0.f : s1;
#if IDX_AMAX
                    mx0 = amax_(mx0, z0); mx1 = amax_(mx1, z1);
#else
                    mx0 = fmax_(mx0, inv0 ? NINF : s0); mx1 = fmax_(mx1, inv1 ? NINF : s1); mn0 = fmin_(mn0, inv0 ? PINF : s0); mn1 = fmin_(mn1, inv1 ? PINF : s1);
#endif
                    cp0 += clampmul(z0, CNT_BIG); cn0 += clampmul(z0, -CNT_BIG); cp1 += clampmul(z1, CNT_BIG); cn1 += clampmul(z1, -CNT_BIG); }
            }
        }
    }
#else
#pragma unroll
        for (int j = 0; j < 8; ++j) { const int jt = ch * 8 + j;
            if (jt < ntiles) {
                const LAS char* bp = bbase + (ch & 1) * BUFB + j * 4096;
                f32x16 acc = f32x16{};
#pragma unroll
                for (int kk = 0; kk < 4; ++kk) { const f16x8 bk = *(const LAS f16x8*)(bp + (((2 * kk + g) ^ sw) * 16)); acc = __builtin_amdgcn_mfma_f32_32x32x16_f16(aq[kk], bk, acc, 0, 0, 0); }
                asm volatile("s_nop 15\n\ts_nop 3\n\tv_max_f32_e32 %0, 0, %0\n\tv_max_f32_e32 %1, 0, %1\n\tv_max_f32_e32 %2, 0, %2\n\tv_max_f32_e32 %3, 0, %3\n\tv_max_f32_e32 %4, 0, %4\n\tv_max_f32_e32 %5, 0, %5\n\tv_max_f32_e32 %6, 0, %6\n\tv_max_f32_e32 %7, 0, %7\n\t"
                             "v_max_f32_e32 %8, 0, %8\n\tv_max_f32_e32 %9, 0, %9\n\tv_max_f32_e32 %10, 0, %10\n\tv_max_f32_e32 %11, 0, %11\n\tv_max_f32_e32 %12, 0, %12\n\tv_max_f32_e32 %13, 0, %13\n\tv_max_f32_e32 %14, 0, %14\n\tv_max_f32_e32 %15, 0, %15"
                             : "+v"(acc[0]), "+v"(acc[1]), "+v"(acc[2]), "+v"(acc[3]), "+v"(acc[4]), "+v"(acc[5]), "+v"(acc[6]), "+v"(acc[7]),
                               "+v"(acc[8]), "+v"(acc[9]), "+v"(acc[10]), "+v"(acc[11]), "+v"(acc[12]), "+v"(acc[13]), "+v"(acc[14]), "+v"(acc[15]));
                float s0 = 0.f, s1 = 0.f;
#pragma unroll
                for (int r = 0; r < 8; ++r) { s0 = __builtin_fmaf(wq[r], acc[r], s0); s1 = __builtin_fmaf(wq[8 + r], acc[8 + r], s1); }
                const bool inv0 = (jt == qt) && (c > ql0), inv1 = (jt == qt) && (c > ql1);
                kp0[jt >> 1][jt & 1] = inv0 ? NINF : s0; kp1[jt >> 1][jt & 1] = inv1 ? NINF : s1;
                mx0 = fmax_(mx0, inv0 ? NINF : s0); mx1 = fmax_(mx1, inv1 ? NINF : s1); mn0 = fmin_(mn0, inv0 ? PINF : s0); mn1 = fmin_(mn1, inv1 ? PINF : s1);
                const float z0 = inv0 ? 0.f : s0, z1 = inv1 ? 0.f : s1;
                cp0 += clampmul(z0, CNT_BIG); cn0 += clampmul(z0, -CNT_BIG); cp1 += clampmul(z1, CNT_BIG); cn1 += clampmul(z1, -CNT_BIG);
            }
        }
    }
#endif
#undef IDX_DMA
    asm volatile("s_waitcnt lgkmcnt(0)\n\ts_barrier" ::: "memory");
#if DSA_PRE
    att::prefetch_kv((const f16*)(ws + WS_KA) + rowbase * 64, (const f16*)(ws + WS_VA) + rowbase * 64, 64, shm);
#if DSA_QWARM
    unsigned qwarm_;
    { const f16* qa_ = (const f16*)(ws + WS_QA) + (rowbase + q0 + c) * 512 + wid * 64 + g * 32;
      asm volatile("global_load_dword %0, %1, off" : "=v"(qwarm_) : "v"(qa_) : "memory"); }
#endif
#endif
    LAS unsigned* mk = (LAS unsigned*)((LAS char*)shm + att::LDS_AUX);
    LAS unsigned* mk0 = mk + ql0 * 2; LAS unsigned* mk1 = mk + ql1 * 2;
    if (qt < 8) {
#pragma unroll
        for (int jt = 0; jt < 64; ++jt) if (jt < 2 * NTA) {
            const unsigned m0 = jt < qt ? 0xFFFFFFFFu : (jt == qt ? (unsigned)((2ull << ql0) - 1ull) : 0u), m1 = jt < qt ? 0xFFFFFFFFu : (jt == qt ? (unsigned)((2ull << ql1) - 1ull) : 0u);
            mk0[(jt >> 1) * 64 + (jt & 1)] = m0; mk1[(jt >> 1) * 64 + (jt & 1)] = m1; }
    } else {
        const float KF = (float)TOPK, nv0 = (float)(q0 + ql0 + 1), nv1 = (float)(q0 + ql1 + 1);
        const float P0 = half_sumf(cp0), N0 = half_sumf(cn0), P1 = half_sumf(cp1), N1 = half_sumf(cn1);
#if IDX_AMAX
        const float X0 = half_max(mx0), M0 = -X0, X1 = half_max(mx1), M1 = -X1;
#else
        const float X0 = half_max(mx0), M0 = half_min(mn0), X1 = half_max(mx1), M1 = half_min(mn1);
#endif
        float lo0, hi0, lo1, hi1, th0 = 0.f, th1 = 0.f; int st0, st1;
        if (P0 == KF) { st0 = 1; lo0 = 0.f; hi0 = 0.f; } else if (P0 > KF) { st0 = 0; lo0 = 0.f; hi0 = X0; } else if (nv0 - N0 >= KF) { st0 = 2; lo0 = 0.f; hi0 = 0.f; } else { st0 = 0; lo0 = 2.f * M0; hi0 = 0.f; }
        if (P1 == KF) { st1 = 1; lo1 = 0.f; hi1 = 0.f; } else if (P1 > KF) { st1 = 0; lo1 = 0.f; hi1 = X1; } else if (nv1 - N1 >= KF) { st1 = 2; lo1 = 0.f; hi1 = 0.f; } else { st1 = 0; lo1 = 2.f * M1; hi1 = 0.f; }
        float mid0 = lo0 + 0.5f * (hi0 - lo0), mid1 = lo1 + 0.5f * (hi1 - lo1);
        f32x2 big2 = (f32x2){CNT_BIG, CNT_BIG}; asm volatile("" : "+v"(big2));
#if PROBE_DUP & 16384
#pragma unroll 1
        for (int rep3_ = 0; rep3_ < 2; ++rep3_) { if (rep3_) { asm volatile("" : "+v"(mid0), "+v"(mid1)); }
#endif
        for (int it = 0; it < 200; ++it) {
            if (!__any(st0 == 0 || st1 == 0)) break;
            f32x2 a0 = (f32x2){0.f, 0.f}, a1 = (f32x2){0.f, 0.f}; const float nb0 = -mid0 * CNT_BIG, nb1 = -mid1 * CNT_BIG; const f32x2 nb20 = (f32x2){nb0, nb0}, nb21 = (f32x2){nb1, nb1};
#pragma unroll
            for (int blk = 0; blk < 8; ++blk) if (blk * 8 < ntiles) { CNTP4(a0, nb20, kp0, blk * 4); CNTP4(a1, nb21, kp1, blk * 4); }
            const float c0 = half_sumf(a0[0] + a0[1]), c1 = half_sumf(a1[0] + a1[1]);
            { const bool act = st0 == 0, fnd = c0 == KF, gt = c0 > KF; const float nlo = gt ? mid0 : lo0, nhi = (gt || fnd) ? hi0 : mid0, nm = nlo + 0.5f * (nhi - nlo); const bool adj = !(nm > nlo && nm < nhi);
              if (act) { lo0 = nlo; hi0 = nhi; th0 = fnd ? mid0 : nhi; st0 = fnd ? 1 : (adj ? 2 : 0); mid0 = nm; } }
            { const bool act = st1 == 0, fnd = c1 == KF, gt = c1 > KF; const float nlo = gt ? mid1 : lo1, nhi = (gt || fnd) ? hi1 : mid1, nm = nlo + 0.5f * (nhi - nlo); const bool adj = !(nm > nlo && nm < nhi);
              if (act) { lo1 = nlo; hi1 = nhi; th1 = fnd ? mid1 : nhi; st1 = fnd ? 1 : (adj ? 2 : 0); mid1 = nm; } }
        }
#if PROBE_DUP & 16384
        }
#endif
        if (__any(st0 != 1 || st1 != 1)) {
            f32x2 n0 = (f32x2){0.f, 0.f}, n1 = (f32x2){0.f, 0.f}; const float nt0 = -th0 * CNT_BIG, nt1 = -th1 * CNT_BIG; const f32x2 nt20 = (f32x2){nt0, nt0}, nt21 = (f32x2){nt1, nt1};
#pragma unroll
            for (int blk = 0; blk < 8; ++blk) if (blk * 8 < ntiles) { CNTP4(n0, nt20, kp0, blk * 4); CNTP4(n1, nt21, kp1, blk * 4); }
            int need0 = TOPK - (int)half_sumf(n0[0] + n0[1]), need1 = TOPK - (int)half_sumf(n1[0] + n1[1]);
#pragma unroll
            for (int jt = 0; jt < 64; ++jt) if (jt < 2 * NTA) {
                unsigned m0 = 0u, m1 = 0u;
                if (jt < ntiles) {
                    const float x0 = kp0[jt >> 1][jt & 1], x1 = kp1[jt >> 1][jt & 1]; const u64 g0 = __ballot(x0 > th0), g1 = __ballot(x1 > th1), e0 = __ballot(x0 == th0 && st0 != 1), e1 = __ballot(x1 == th1 && st1 != 1);
                    unsigned gg0 = g ? (unsigned)(g0 >> 32) : (unsigned)g0, gg1 = g ? (unsigned)(g1 >> 32) : (unsigned)g1, ee0 = g ? (unsigned)(e0 >> 32) : (unsigned)e0, ee1 = g ? (unsigned)(e1 >> 32) : (unsigned)e1;
                    { const int ne = __popc(ee0), tk = need0 < ne ? (need0 > 0 ? need0 : 0) : ne; unsigned r = ee0; while (__popc(r) > tk) r &= ~(0x80000000u >> __clz(r)); need0 -= tk; m0 = gg0 | r; }
                    { const int ne = __popc(ee1), tk = need1 < ne ? (need1 > 0 ? need1 : 0) : ne; unsigned r = ee1; while (__popc(r) > tk) r &= ~(0x80000000u >> __clz(r)); need1 -= tk; m1 = gg1 | r; }
                }
                mk0[(jt >> 1) * 64 + (jt & 1)] = m0; mk1[(jt >> 1) * 64 + (jt & 1)] = m1;
            }
        } else {
#pragma unroll
            for (int jt = 0; jt < 64; ++jt) if (jt < 2 * NTA) {
                unsigned m0 = 0u, m1 = 0u;
                if (jt < ntiles) { const u64 g0 = __ballot(kp0[jt >> 1][jt & 1] > th0), g1 = __ballot(kp1[jt >> 1][jt & 1] > th1); m0 = g ? (unsigned)(g0 >> 32) : (unsigned)g0; m1 = g ? (unsigned)(g1 >> 32) : (unsigned)g1; }
                mk0[(jt >> 1) * 64 + (jt & 1)] = m0; mk1[(jt >> 1) * 64 + (jt & 1)] = m1;
            }
        }
    }
#if DSA_PRE
    asm volatile("s_waitcnt vmcnt(0) lgkmcnt(0)\n\ts_barrier" ::: "memory");
#if DSA_QWARM
    asm volatile("" : "+v"(qwarm_));
#endif
#else
    asm volatile("s_waitcnt lgkmcnt(0)\n\ts_barrier" ::: "memory");
#endif
}
#undef CNTP4
}
__device__ __forceinline__ void ph_dsa(const Params& P, char* shm, int vcu, int G) {
    unsigned char* ws = P.ws; const int wid = threadIdx.x >> 6;
    for (int it = vcu; it < NB * 8; it += G) {
        const int b = it >> 3, j = it & 7; const size_t rowbase = (size_t)b * S;
#pragma unroll 1
        for (int k = 0; k < 8; ++k) { const int qt = (k & 1) ? (16 * (k >> 1) + 15 - j) : (16 * (k >> 1) + j);
            const int nt = qt / 2 + 1, NT = nt < 4 ? 4 : nt + (nt & 1);
            idx::indexer_tile(P, shm, b, qt, NT);
#if PROBE_DUP & 256
#pragma unroll 1
            for (int rep_ = 0; rep_ < PROBE_REP; ++rep_) idx::indexer_tile(P, shm, b, qt, NT);
#endif
            const size_t tok = rowbase + qt * 32;
            att::attn_unit<1, 8, DSA_PRE != 0>((const f16*)(ws + WS_QA) + tok * 512 + wid * 64, (const f16*)(ws + WS_KA) + rowbase * 64, (const f16*)(ws + WS_VA) + rowbase * 64, 64, NT, 0, 0.f,
                                 (f16*)(ws + WS_U) + tok * 1024 + wid * 64, (const f16*)(ws + WS_SGA) + tok * 512 + wid * 64, shm);
#if PROBE_DUP & 512
            att::attn_unit<1, 8>((const f16*)(ws + WS_QA) + tok * 512 + wid * 64, (const f16*)(ws + WS_KA) + rowbase * 64, (const f16*)(ws + WS_VA) + rowbase * 64, 64, NT, 0, 0.f,
                                 (f16*)(ws + WS_U) + tok * 1024 + wid * 64, (const f16*)(ws + WS_SGA) + tok * 512 + wid * 64, shm);
#endif
        }
    }
}
__global__ void __launch_bounds__(512, 2) k_dsa(Params P) { extern __shared__ __attribute__((aligned(16))) unsigned char lds[];
    const int G = gridDim.x, bx = blockIdx.x; ph_dsa(P, (char*)lds, (G % 8 == 0) ? (bx % 8) * (G / 8) + bx / 8 : bx, G); }

constexpr int ATT_LDS = att::LDS_BYTES;
__global__ void __launch_bounds__(512, 2) k_fox(Params P) { extern __shared__ __attribute__((aligned(16))) unsigned char lds[]; ph_fox(P, (char*)lds, blockIdx.x, gridDim.x); }
__global__ void __launch_bounds__(512, 2) k_dsa_attn(Params P) { extern __shared__ __attribute__((aligned(16))) unsigned char lds[];
    const int G = gridDim.x, bx = blockIdx.x; ph_dsa_attn(P, (char*)lds, (G % 8 == 0) ? (bx % 8) * (G / 8) + bx / 8 : bx, G); }

__device__ __forceinline__ float dot_h(const f16* a, const f16* b, int K) {
    float acc = 0.f;
    for (int k = 0; k < K; k += 8) { const f16x8 va = *(const f16x8*)(a + k), vb = *(const f16x8*)(b + k);
#pragma unroll
        for (int j = 0; j < 8; ++j) acc += (float)va[j] * (float)vb[j]; }
    return acc;
}
__global__ void __launch_bounds__(256) nv_gemm1(Params P) {
    unsigned char* ws = P.ws;
    const size_t idx = (size_t)blockIdx.x * 256 + threadIdx.x; if (idx >= (size_t)T * N1) return;
    const int t = (int)(idx / N1), n = (int)(idx % N1);
    const f16* h = (const f16*)(ws + WS_H16) + (size_t)t * D; const f16* W = (const f16*)(ws + WS_W1T);
    float v = dot_h(h, W + (size_t)n * D, D);
    const int pos = t & (S - 1);
    auto rope = [&](int d) -> float {
        const float v2 = dot_h(h, W + (size_t)(d < 8 ? n + 8 : n - 8) * D, D);
        const f32x2 cs = ((const f32x2*)(ws + WS_ROPE))[pos * 8 + (d & 7)];
        return d < 8 ? v * cs.x - v2 * cs.y : v * cs.x + v2 * cs.y; };
    if (n < P_QI) { const int d = n & 63; if (d < 16) v = rope(d); ((f16*)(ws + WS_QA))[(size_t)t * 512 + n] = (f16)(v * C2); return; }
    if (n < P_QB) { const int c = n - P_QI, d = c & 63; if (d < 16) v = rope(d); ((f16*)(ws + WS_QI))[(size_t)t * 512 + c] = (f16)v; return; }
    if (n < P_KB) { ((f16*)(ws + WS_QB))[(size_t)t * 512 + (n - P_QB)] = (f16)(v * C2); return; }
    if (n < P_VB) { ((f16*)(ws + WS_KB))[(size_t)t * 512 + (n - P_KB)] = (f16)v; return; }
    if (n < P_GA) { ((f16*)(ws + WS_VB))[(size_t)t * 512 + (n - P_VB)] = (f16)v; return; }
    if (n < P_GB) { ((f16*)(ws + WS_SGA))[(size_t)t * 512 + (n - P_GA)] = (f16)siluf_(v); return; }
    if (n < P_SM) { ((f16*)(ws + WS_SGB))[(size_t)t * 512 + (n - P_GB)] = (f16)siluf_(v); return; }
    if (n < P_MG) { const int c = n - P_SM;
        if (c < 64) { if (c < 16) v = rope(c); ((f16*)(ws + WS_KA))[(size_t)t * 64 + c] = (f16)v; }
        else if (c < 128) ((f16*)(ws + WS_VA))[(size_t)t * 64 + (c - 64)] = (f16)v;
        else if (c < 192) { const int d = c - 128; if (d < 16) v = rope(d); ((f16*)(ws + WS_KI))[(size_t)t * 64 + d] = (f16)v; }
        else if (c < 200) ((float*)(ws + WS_WI))[(size_t)t * 8 + (c - 192)] = v * IDX_SCALE;
        else if (c < 208) ((float*)(ws + WS_LOGF))[(size_t)t * 8 + (c - 200)] = logsigmoidf_(v + P.b_forget[c - 200]);
        return; }
    ((f16*)(ws + WS_MG))[(size_t)t * 2048 + (n - P_MG)] = (f16)sigmoidf_(v);
}
__global__ void nv_cumsum(Params P) {
    const int i = blockIdx.x * blockDim.x + threadIdx.x; if (i >= NB * 8) return;
    const int b = i >> 3, h = i & 7; const float* lf = (const float*)(P.ws + WS_LOGF); float* cs = (float*)(P.ws + WS_CSUM) + (size_t)i * S;
    float c = 0.f; for (int s = 0; s < S; ++s) { c += lf[((size_t)b * S + s) * 8 + h]; cs[s] = c * LOG2E; }
}
__global__ void __launch_bounds__(256) nv_fox(Params P) {
    unsigned char* ws = P.ws;
    const int idx = blockIdx.x * 256 + threadIdx.x; const int h = idx & 7, tok = idx >> 3, b = tok / S, t = tok % S;
    float q[64], o[64];
    { const f16* qp = (const f16*)(ws + WS_QB) + (size_t)tok * 512 + h * 64;
#pragma unroll
      for (int d = 0; d < 64; ++d) { q[d] = (float)qp[d]; o[d] = 0.f; } }
    const float* cs = (const float*)(ws + WS_CSUM) + (size_t)(b * 8 + h) * S; const float ct = cs[t];
    float m = -1e30f, l = 0.f;
    for (int s = 0; s <= t; ++s) {
        const f16* kp = (const f16*)(ws + WS_KB) + ((size_t)b * S + s) * 512 + h * 64; const f16* vp = (const f16*)(ws + WS_VB) + ((size_t)b * S + s) * 512 + h * 64;
        float d0 = 0.f;
#pragma unroll
        for (int d = 0; d < 64; ++d) d0 += q[d] * (float)kp[d];
        const float lg = d0 + (ct - cs[s]); const float mn = fmaxf(m, lg), f = exp2f(m - mn), pe = exp2f(lg - mn);
        l = l * f + pe; m = mn;
#pragma unroll
        for (int d = 0; d < 64; ++d) o[d] = o[d] * f + pe * (float)vp[d];
    }
    const float il = 1.f / l; const f16* sg = (const f16*)(ws + WS_SGB) + (size_t)tok * 512 + h * 64; f16* u = (f16*)(ws + WS_U) + (size_t)tok * 1024 + 512 + h * 64;
#pragma unroll
    for (int d = 0; d < 64; ++d) u[d] = (f16)(o[d] * il * (float)sg[d]);
}
__device__ __forceinline__ size_t mask_word(int b, int t, int s, int& bit) {
    bit = s & 63; return ((((size_t)b * 64 + (t >> 5)) * 32 + (s >> 6)) * 32 + (t & 31));
}
__global__ void __launch_bounds__(256) nv_indexer(Params P) {
    unsigned char* ws = P.ws;
    __shared__ f16 sq[512]; __shared__ float sw[8]; __shared__ unsigned skey[S]; __shared__ unsigned char sflag[S]; __shared__ unsigned scnt;
    const int tok = blockIdx.x, b = tok / S, t = tok % S, tid = threadIdx.x;
    if (tid < 64) ((f16x8*)sq)[tid] = ((const f16x8*)((const f16*)(ws + WS_QI) + (size_t)tok * 512))[tid];
    if (tid < 8) sw[tid] = ((const float*)(ws + WS_WI))[(size_t)tok * 8 + tid];
    __syncthreads();
    unsigned key[8];
#pragma unroll
    for (int i = 0; i < 8; ++i) { const int s = tid + 256 * i; key[i] = 0u; sflag[s] = 0;
        if (s <= t) { const f16* kp = (const f16*)(ws + WS_KI) + ((size_t)b * S + s) * 64; float sc = 0.f;
            for (int h = 0; h < 8; ++h) { float d0 = 0.f;
#pragma unroll
                for (int d = 0; d < 64; ++d) d0 += (float)sq[h * 64 + d] * (float)kp[d];
                sc += sw[h] * fmaxf(d0, 0.f); }
            key[i] = sortkey(sc); }
        skey[s] = key[i]; }
    auto count_gt = [&](unsigned x) -> unsigned { int c = 0;
#pragma unroll
        for (int i = 0; i < 8; ++i) c += (key[i] > x) ? 1 : 0;
        __syncthreads(); if (tid == 0) scnt = 0u; __syncthreads(); atomicAdd(&scnt, (unsigned)c); __syncthreads(); return scnt; };
    bool sel[8];
    if (t + 1 <= TOPK) {
#pragma unroll
        for (int i = 0; i < 8; ++i) sel[i] = (tid + 256 * i) <= t;
    } else {
        unsigned lo = 0u, hi = 0xFFFFFFFFu, thr = 0u; bool found = false;
        while (hi - lo > 1u) { const unsigned mid = lo + (hi - lo) / 2u; const unsigned c = count_gt(mid);
            if (c == (unsigned)TOPK) { thr = mid; found = true; break; } else if (c > (unsigned)TOPK) lo = mid; else hi = mid; }
        if (found) {
#pragma unroll
            for (int i = 0; i < 8; ++i) sel[i] = key[i] > thr;
        } else {
            const unsigned cg = count_gt(hi); int need = TOPK - (int)cg;
            if (tid == 0) { for (int s = 0; s <= t && need > 0; ++s) if (skey[s] == hi) { sflag[s] = 1; --need; } }
            __syncthreads();
#pragma unroll
            for (int i = 0; i < 8; ++i) sel[i] = key[i] > hi || (key[i] == hi && sflag[tid + 256 * i]);
        }
    }
#pragma unroll
    for (int i = 0; i < 8; ++i) if (sel[i]) { int bit; const size_t w = mask_word(b, t, tid + 256 * i, bit); atomicOr((u64*)(ws + WS_MASK) + w, 1ull << bit); }
}
__global__ void __launch_bounds__(256) nv_dsa(Params P) {
    unsigned char* ws = P.ws;
    const int idx = blockIdx.x * 256 + threadIdx.x; const int h = idx & 7, tok = idx >> 3, b = tok / S, t = tok % S;
    float q[64], o[64];
    { const f16* qp = (const f16*)(ws + WS_QA) + (size_t)tok * 512 + h * 64;
#pragma unroll
      for (int d = 0; d < 64; ++d) { q[d] = (float)qp[d]; o[d] = 0.f; } }
    float m = -1e30f, l = 0.f;
    for (int s = 0; s <= t; ++s) {
        int bit; const size_t w = mask_word(b, t, s, bit); if (!((((const u64*)(ws + WS_MASK))[w] >> bit) & 1ull)) continue;
        const f16* kp = (const f16*)(ws + WS_KA) + ((size_t)b * S + s) * 64; const f16* vp = (const f16*)(ws + WS_VA) + ((size_t)b * S + s) * 64;
        float d0 = 0.f;
#pragma unroll
        for (int d = 0; d < 64; ++d) d0 += q[d] * (float)kp[d];
        const float mn = fmaxf(m, d0), f = exp2f(m - mn), pe = exp2f(d0 - mn);
        l = l * f + pe; m = mn;
#pragma unroll
        for (int d = 0; d < 64; ++d) o[d] = o[d] * f + pe * (float)vp[d];
    }
    const float il = 1.f / l; const f16* sg = (const f16*)(ws + WS_SGA) + (size_t)tok * 512 + h * 64; f16* u = (f16*)(ws + WS_U) + (size_t)tok * 1024 + h * 64;
#pragma unroll
    for (int d = 0; d < 64; ++d) u[d] = (f16)(o[d] * il * (float)sg[d]);
}
__global__ void __launch_bounds__(256) nv_merged(Params P) {
    unsigned char* ws = P.ws; const size_t idx = (size_t)blockIdx.x * 256 + threadIdx.x; const int t = (int)(idx >> 10), n = (int)(idx & 1023);
    const f16* u = (const f16*)(ws + WS_U) + (size_t)t * 1024;
    const float ya = dot_h(u, (const f16*)(ws + WS_WBA) + (size_t)n * 512, 512), yb = dot_h(u + 512, (const f16*)(ws + WS_WBB) + (size_t)n * 512, 512);
    const f16* mg = (const f16*)(ws + WS_MG) + (size_t)t * 2048;
    ((f16*)(ws + WS_MERGED))[idx] = (f16)((float)mg[n] * ya + (float)mg[1024 + n] * yb);
}
__global__ void __launch_bounds__(256) nv_out(Params P) {
    unsigned char* ws = P.ws; const size_t idx = (size_t)blockIdx.x * 256 + threadIdx.x; const int t = (int)(idx >> 10), n = (int)(idx & 1023);
    const float v = dot_h((const f16*)(ws + WS_MERGED) + (size_t)t * 1024, (const f16*)(ws + WS_WO) + (size_t)n * 1024, 1024);
    ((f16*)(ws + WS_OUT16))[idx] = (f16)v; atomicAdd((float*)(ws + WS_ROWSQ) + t, v * v);
}
#if EW_LIFO
#define EW_LOOP(i, gt, GT, n8) const bool xc_ = ((GT) == (size_t)131072); const size_t gb_ = ((gt) >> 9), ib_ = ((gb_ & 7) * 8192 + (gb_ >> 3) * 4) * 128 + ((gt) & 511); \
    for (size_t k_ = xc_ ? 64 : ((n8) - (gt) + (GT) - 1) / (GT), i = 0; k_-- > 0 && ((i = xc_ ? ib_ + k_ * 16384 : (gt) + k_ * (GT)), true); )
#else
#define EW_LOOP(i, gt, GT, n8) for (size_t i = (gt); i < (n8); i += (GT))
#endif
__device__ __forceinline__ void ew_x1(const Params& P, size_t gt, size_t GT) {
    unsigned char* ws = P.ws; const size_t n8 = (size_t)T * D / 8;
    EW_LOOP(i, gt, GT, n8) { const int t = (int)(i >> 7), c8 = (int)(i & 127);
        const float rstd = rsqrtf(((const float*)(ws + WS_ROWSQ))[t] * (1.f / D) + EPS);
        const f16x8 o = ((const f16x8*)(ws + WS_OUT16))[i]; const f32x4 xa = __builtin_nontemporal_load((const f32x4*)P.x + 2 * i), xb = __builtin_nontemporal_load((const f32x4*)P.x + 2 * i + 1);
        const f32x4 ga = ((const f32x4*)P.g_post)[2 * c8], gb = ((const f32x4*)P.g_post)[2 * c8 + 1];
        f16x8 r; r[0] = (f16)(xa.x + (float)o[0] * rstd * ga.x); r[1] = (f16)(xa.y + (float)o[1] * rstd * ga.y); r[2] = (f16)(xa.z + (float)o[2] * rstd * ga.z); r[3] = (f16)(xa.w + (float)o[3] * rstd * ga.w);
        r[4] = (f16)(xb.x + (float)o[4] * rstd * gb.x); r[5] = (f16)(xb.y + (float)o[5] * rstd * gb.y); r[6] = (f16)(xb.z + (float)o[6] * rstd * gb.z); r[7] = (f16)(xb.w + (float)o[7] * rstd * gb.w);
        ((f16x8*)(ws + WS_X116))[i] = r; }
}
__global__ void __launch_bounds__(256) k_x1(Params P) { ew_x1(P, (size_t)blockIdx.x * 256 + threadIdx.x, (size_t)gridDim.x * 256); }
__global__ void __launch_bounds__(256) nv_gate(Params P) {
    unsigned char* ws = P.ws; const size_t idx = (size_t)blockIdx.x * 256 + threadIdx.x; const int t = (int)(idx >> 10), n = (int)(idx & 1023);
    const float gz = dot_h((const f16*)(ws + WS_X116) + (size_t)t * 1024, (const f16*)(ws + WS_WPG) + (size_t)n * 1024, 1024);
    const float e = dot_h((const f16*)(ws + WS_P16) + (size_t)t * DPLE, (const f16*)(ws + WS_WPLE) + (size_t)n * DPLE, DPLE);
    const float v = sigmoidf_(gz) * e; ((f16*)(ws + WS_V16))[idx] = (f16)v; atomicAdd((float*)(ws + WS_ROWSQ) + T + t, v * v);
}
__device__ __forceinline__ void ew_final(const Params& P, size_t gt, size_t GT) {
    unsigned char* ws = P.ws; const size_t n8 = (size_t)T * D / 8;
    EW_LOOP(i, gt, GT, n8) { const int t = (int)(i >> 7), c8 = (int)(i & 127);
        const float r2 = rsqrtf(((const float*)(ws + WS_ROWSQ))[T + t] * (1.f / D) + EPS);
        const f16x8 x1 = ((const f16x8*)(ws + WS_X116))[i], v = ((const f16x8*)(ws + WS_V16))[i];
        const f32x4 ha = ((const f32x4*)P.g_ple)[2 * c8], hb = ((const f32x4*)P.g_ple)[2 * c8 + 1];
        f32x4 ya, yb;
        ya.x = (float)x1[0] + (float)v[0] * r2 * ha.x; ya.y = (float)x1[1] + (float)v[1] * r2 * ha.y; ya.z = (float)x1[2] + (float)v[2] * r2 * ha.z; ya.w = (float)x1[3] + (float)v[3] * r2 * ha.w;
        yb.x = (float)x1[4] + (float)v[4] * r2 * hb.x; yb.y = (float)x1[5] + (float)v[5] * r2 * hb.y; yb.z = (float)x1[6] + (float)v[6] * r2 * hb.z; yb.w = (float)x1[7] + (float)v[7] * r2 * hb.w;
        __builtin_nontemporal_store(ya, (f32x4*)P.out + 2 * i); __builtin_nontemporal_store(yb, (f32x4*)P.out + 2 * i + 1); }
}
__global__ void __launch_bounds__(256) k_final(Params P) { ew_final(P, (size_t)blockIdx.x * 256 + threadIdx.x, (size_t)gridDim.x * 256); }


#define XB_TMO      128
#define XB_XCNT(j)  (256  + 64 * (j))
#define XB_XSUB(j)  (1280 + 64 * (j))
#define XB_XGEN(j)  (2304 + 64 * (j))
#define XB_TOP      3328
#define XB_TOPGEN   3392
#define XCD_BAR_WORDS 3456
#define XB_SPIN_CAP (1u << 22)
__device__ __forceinline__ unsigned xb_ld(unsigned* p)              { return __hip_atomic_load(p, __ATOMIC_RELAXED, __HIP_MEMORY_SCOPE_AGENT); }
__device__ __forceinline__ unsigned xb_add(unsigned* p, unsigned v) { return __hip_atomic_fetch_add(p, v, __ATOMIC_RELAXED, __HIP_MEMORY_SCOPE_AGENT); }
__device__ __forceinline__ unsigned xb_xcc_id() { return (unsigned)__builtin_amdgcn_s_getreg((3 << 11) | 20) & 0xFu; }
#define XB_SPIN(cond, bar) do { unsigned _sp = 0; while (cond) { __builtin_amdgcn_s_sleep(1); \
    if ((++_sp & 255u) == 0u) { if (xb_ld(&(bar)[XB_TMO])) break; if (_sp > XB_SPIN_CAP) { atomicAdd(&(bar)[XB_TMO], 1u); break; } } } } while (0)
struct XcdBarrier { unsigned* bar; unsigned x; volatile LAS unsigned* st; };
__device__ __forceinline__ XcdBarrier xcd_barrier_post(unsigned* bar, volatile LAS unsigned* st) {
    XcdBarrier b; b.bar = bar; b.x = xb_xcc_id(); b.st = st;
    if (threadIdx.x == 0) (void)xb_add(&bar[XB_XCNT(b.x)], 1u);
    return b;
}
__device__ __forceinline__ void xcd_barrier_complete(unsigned* bar, unsigned x, unsigned& nloc, unsigned& nx) {
    const unsigned G = gridDim.x * gridDim.y * gridDim.z;
    unsigned sum, cnt, mine, sp = 0u;
    for (;;) {
        sum = 0u; cnt = 0u; mine = 0u;
#pragma unroll
        for (unsigned j = 0; j < 16; ++j) { const unsigned c = xb_ld(&bar[XB_XCNT(j)]); sum += c; cnt += (c > 0u) ? 1u : 0u; mine = (j == x) ? c : mine; }
        if (sum == G) break;
        __builtin_amdgcn_s_sleep(1);
        if ((++sp & 255u) == 0u) { if (xb_ld(&bar[XB_TMO])) break; if (sp > XB_SPIN_CAP) { atomicAdd(&bar[XB_TMO], 1u); break; } }
    }
    nloc = mine > 0u ? mine : 1u; nx = cnt > 0u ? cnt : 1u;
}
__device__ __forceinline__ void xcd_barrier(const XcdBarrier& b) {
    asm volatile("s_waitcnt vmcnt(0)" ::: "memory");
    __syncthreads();
    if (threadIdx.x == 0) {
        unsigned* bar = b.bar;
        __builtin_amdgcn_s_waitcnt(0);
        unsigned nloc = b.st[0], nx = b.st[1];
        if (nloc == 0u) { xcd_barrier_complete(bar, b.x, nloc, nx); b.st[0] = nloc; b.st[1] = nx; }
        const unsigned old = xb_add(&bar[XB_XSUB(b.x)], 1u);
        const unsigned gen = old / nloc;
        if (old + 1u == (gen + 1u) * nloc) {
            __builtin_amdgcn_fence(__ATOMIC_RELEASE, "agent");
            asm volatile("s_waitcnt vmcnt(0)" ::: "memory");
            const unsigned og = xb_add(&bar[XB_TOP], 1u);
            const unsigned tg = og / nx;
            if (og + 1u == (tg + 1u) * nx) xb_add(&bar[XB_TOPGEN], 1u);
            else XB_SPIN(xb_ld(&bar[XB_TOPGEN]) == tg, bar);
            __builtin_amdgcn_fence(__ATOMIC_ACQUIRE, "agent");
            xb_add(&bar[XB_XGEN(b.x)], 1u);
            asm volatile("s_waitcnt vmcnt(0)" ::: "memory");
        } else {
            XB_SPIN(xb_ld(&bar[XB_XGEN(b.x)]) == gen, bar);
            __builtin_amdgcn_fence(__ATOMIC_ACQUIRE, "agent");
            asm volatile("s_waitcnt vmcnt(0)" ::: "memory");
        }
    }
    __syncthreads();
}
constexpr int MISC_OFF = 131072 + 320;
constexpr size_t CTL_ZERO_BYTES = 65536;

namespace cg = cooperative_groups;
#ifndef STAGGER_TICKS
#define STAGGER_TICKS 350
#endif
__device__ __forceinline__ void stagger_xcd(int bx, int ticks) {
    const unsigned long long t0 = __builtin_amdgcn_s_memrealtime(), want = (unsigned long long)(((bx >> 6) & 3) * ticks);
    while (__builtin_amdgcn_s_memrealtime() - t0 < want) __builtin_amdgcn_s_sleep(8);
    __syncthreads();
}
__global__ void __launch_bounds__(512, 2) k_mega(Params P) {
    extern __shared__ __attribute__((aligned(16))) unsigned char lds[];
    cg::grid_group grid = cg::this_grid();
    const int G = gridDim.x, bx = blockIdx.x; const int vcu = (G % 8 == 0) ? (bx % 8) * (G / 8) + bx / 8 : bx;
    volatile LAS unsigned* MISC = (volatile LAS unsigned*)((LAS unsigned char*)lds + MISC_OFF);
    if (threadIdx.x < 32) MISC[threadIdx.x] = 0u;
    __syncthreads();
    const XcdBarrier xbar = xcd_barrier_post((unsigned*)(P.ws + WS_CTL) + 4096, MISC + 8);
#define SEAM() xcd_barrier(xbar)
    p0_prologue(P, (LAS unsigned char*)lds, bx, G);
#if PROBE_DUP & 1
#pragma unroll 1
    for (int rep_ = 0; rep_ < PROBE_REP; ++rep_) { __syncthreads(); p0_prologue(P, (LAS unsigned char*)lds, bx, G); }
#endif
    grid.sync();
    { pg8::Gemm g{(const f16*)(P.ws + WS_H16), (const f16*)(P.ws + WS_W1T), D, D, D}; pg8::StaticOrder So; So.init(T, N1, G, bx, G1_WGM); EpiG1 E{P.ws, P.b_forget};
      pg8::gemm_phase<EpiG1>((LAS unsigned char*)lds, g, So, E);
#if PROBE_DUP & 2
#pragma unroll 1
      for (int rep_ = 0; rep_ < PROBE_REP; ++rep_) pg8::gemm_phase<EpiG1>((LAS unsigned char*)lds, g, So, E);
#endif
#if PROBE_DUP & 4096
      { EpiNull En{(float*)(P.ws + WS_ROWSQ) + 2 * T}; pg8::gemm_phase<EpiNull>((LAS unsigned char*)lds, g, So, En); }
#endif
#if PROBE_DUP & 8192
      { EpiNull En{(float*)(P.ws + WS_ROWSQ) + 2 * T}; pg8::StaticOrder Sh = So; Sh.hot = true; pg8::gemm_phase<EpiNull>((LAS unsigned char*)lds, g, Sh, En); }
#endif
    }
    SEAM();
    ph_fox(P, (char*)lds, vcu, G);
#if PROBE_DUP & 4
#pragma unroll 1
    for (int rep_ = 0; rep_ < PROBE_REP; ++rep_) ph_fox(P, (char*)lds, vcu, G);
#endif
    ph_dsa(P, (char*)lds, vcu, G);
#if PROBE_DUP & 8
#pragma unroll 1
    for (int rep_ = 0; rep_ < PROBE_REP; ++rep_) ph_dsa(P, (char*)lds, vcu, G);
#endif
    SEAM();
    ph_merged(P, (LAS unsigned char*)lds, G, bx);
#if PROBE_DUP & 16
    ph_merged(P, (LAS unsigned char*)lds, G, bx);
#endif
    SEAM();
    ph_out(P, (LAS unsigned char*)lds, G, bx);
#if PROBE_DUP & 32
    ph_out(P, (LAS unsigned char*)lds, G, bx, 2 * T);
#endif
    SEAM();
    ew_x1(P, (size_t)bx * 512 + threadIdx.x, (size_t)G * 512);
#if PROBE_DUP & 128
#pragma unroll 1
    for (int rep_ = 0; rep_ < PROBE_REP; ++rep_) ew_x1(P, (size_t)bx * 512 + threadIdx.x, (size_t)G * 512);
#endif
    SEAM();
    ph_gate(P, (LAS unsigned char*)lds, G, bx);
#if PROBE_DUP & 64
    ph_gate(P, (LAS unsigned char*)lds, G, bx, 3 * T);
#endif
    SEAM();
    ew_final(P, (size_t)bx * 512 + threadIdx.x, (size_t)G * 512);
#if PROBE_DUP & 64
#pragma unroll 1
    for (int rep_ = 0; rep_ < PROBE_REP; ++rep_) ew_final(P, (size_t)bx * 512 + threadIdx.x, (size_t)G * 512);
#endif
}

extern "C" void kernel_launch(void* const* d_in, const int* in_sizes, int n_in, void* d_out, int out_size, void* d_ws, size_t ws_size, hipStream_t stream) {
    if (n_in != 13 || in_sizes[0] != T * D || out_size != T * D || ws_size < WS_END) { fprintf(stderr, "kernel_launch: unexpected shapes / workspace (n_in %d, ws %zu < %zu)\n", n_in, ws_size, (size_t)WS_END); return; }
    Params P{};
    P.x = (const float*)d_in[0]; P.p = (const float*)d_in[1]; P.w_in = (const float*)d_in[2]; P.b_forget = (const float*)d_in[3]; P.w_ba = (const float*)d_in[4]; P.w_bb = (const float*)d_in[5];
    P.w_merge = (const float*)d_in[6]; P.w_out = (const float*)d_in[7]; P.g_pre = (const float*)d_in[8]; P.g_post = (const float*)d_in[9]; P.w_ple = (const float*)d_in[10]; P.w_pg = (const float*)d_in[11]; P.g_ple = (const float*)d_in[12];
    P.out = (float*)d_out; P.ws = (unsigned char*)d_ws;
#if USE_MEGA
    static int grid_blocks = 0;
    if (!grid_blocks) {
        int dev = 0, cus = 0, per_cu = 0;
        (void)hipGetDevice(&dev); (void)hipDeviceGetAttribute(&cus, hipDeviceAttributeMultiprocessorCount, dev);
        if (hipFuncSetAttribute((const void*)k_mega, hipFuncAttributeMaxDynamicSharedMemorySize, GEMM_LDS) != hipSuccess) { fprintf(stderr, "kernel_launch: hipFuncSetAttribute failed\n"); grid_blocks = -1; return; }
        if (hipOccupancyMaxActiveBlocksPerMultiprocessor(&per_cu, (const void*)k_mega, 512, GEMM_LDS) != hipSuccess || per_cu < 1) { fprintf(stderr, "kernel_launch: occupancy query failed (%d)\n", per_cu); grid_blocks = -1; return; }
        grid_blocks = cus * per_cu;
    }
    if (grid_blocks < 0) return;
    (void)hipMemsetAsync((char*)d_ws + WS_CTL, 0, CTL_ZERO_BYTES, stream);
    void* args[] = {&P};
    const hipError_t e = hipLaunchCooperativeKernel((const void*)k_mega, dim3(grid_blocks), dim3(512), args, GEMM_LDS, stream);
    if (e != hipSuccess) fprintf(stderr, "cooperative launch failed: %s (grid %d)\n", hipGetErrorString(e), grid_blocks);
#else
    static bool attr = false;
    if (!attr) { (void)hipFuncSetAttribute((const void*)k_p0, hipFuncAttributeMaxDynamicSharedMemorySize, 8 * 8704); (void)hipFuncSetAttribute((const void*)k_gemm1, hipFuncAttributeMaxDynamicSharedMemorySize, GEMM_LDS);
        (void)hipFuncSetAttribute((const void*)k_merged, hipFuncAttributeMaxDynamicSharedMemorySize, GEMM_LDS); (void)hipFuncSetAttribute((const void*)k_out, hipFuncAttributeMaxDynamicSharedMemorySize, GEMM_LDS); (void)hipFuncSetAttribute((const void*)k_gate, hipFuncAttributeMaxDynamicSharedMemorySize, GEMM_LDS);
        (void)hipFuncSetAttribute((const void*)k_fox, hipFuncAttributeMaxDynamicSharedMemorySize, ATT_LDS); (void)hipFuncSetAttribute((const void*)k_dsa_attn, hipFuncAttributeMaxDynamicSharedMemorySize, ATT_LDS); (void)hipFuncSetAttribute((const void*)k_dsa, hipFuncAttributeMaxDynamicSharedMemorySize, ATT_LDS); attr = true; }
    hipLaunchKernelGGL(k_p0, dim3(256), dim3(512), 8 * 8704, stream, P);
#if USE_NV_GEMM1
    hipLaunchKernelGGL(nv_gemm1, dim3((unsigned)(((size_t)T * N1 + 255) / 256)), dim3(256), 0, stream, P);
#else
    hipLaunchKernelGGL(k_gemm1, dim3(256), dim3(512), GEMM_LDS, stream, P);
#endif
#if USE_NV_FOX
    hipLaunchKernelGGL(nv_cumsum, dim3(1), dim3(256), 0, stream, P);
    hipLaunchKernelGGL(nv_fox, dim3(T * 8 / 256), dim3(256), 0, stream, P);
#else
    hipLaunchKernelGGL(k_fox, dim3(256), dim3(512), ATT_LDS, stream, P);
#endif
#if USE_NV_IDX
    hipLaunchKernelGGL(nv_indexer, dim3(T), dim3(256), 0, stream, P);
#if USE_NV_DSA
    hipLaunchKernelGGL(nv_dsa, dim3(T * 8 / 256), dim3(256), 0, stream, P);
#else
    hipLaunchKernelGGL(k_dsa_attn, dim3(256), dim3(512), ATT_LDS, stream, P);
#endif
#else
    hipLaunchKernelGGL(k_dsa, dim3(256), dim3(512), ATT_LDS, stream, P);
#endif
#if USE_NV_POST
    hipLaunchKernelGGL(nv_merged, dim3(T * 1024 / 256), dim3(256), 0, stream, P);
    hipLaunchKernelGGL(nv_out, dim3(T * 1024 / 256), dim3(256), 0, stream, P);
#else
    hipLaunchKernelGGL(k_merged, dim3(256), dim3(512), GEMM_LDS, stream, P);
    hipLaunchKernelGGL(k_out, dim3(256), dim3(512), GEMM_LDS, stream, P);
#endif
    hipLaunchKernelGGL(k_x1, dim3(2048), dim3(256), 0, stream, P);
#if USE_NV_POST
    hipLaunchKernelGGL(nv_gate, dim3(T * 1024 / 256), dim3(256), 0, stream, P);
#else
    hipLaunchKernelGGL(k_gate, dim3(256), dim3(512), GEMM_LDS, stream, P);
#endif
    hipLaunchKernelGGL(k_final, dim3(2048), dim3(256), 0, stream, P);
#endif
}
```

```cpp
#include <hip/hip_runtime.h>
#include <hip/hip_cooperative_groups.h>
#include <cstdio>
#include <cstdint>
#ifndef IDX_AMAX
#define IDX_AMAX 1
#endif
#ifndef IDX_PAIR
#define IDX_PAIR 1
#endif
#ifndef GATE_PF
#define GATE_PF 1
#endif
#ifndef DSA_PRE
#define DSA_PRE 1
#endif
#ifndef DSA_QWARM
#define DSA_QWARM 1
#endif
#ifndef EW_LIFO
#define EW_LIFO 1
#endif
#ifndef INPLACE
#define INPLACE 1
#endif
#ifndef INPLACE_U
#define INPLACE_U 1
#endif
#define U_LD (INPLACE_U ? 512 : 1024)
#define U_A(ws) ((f16*)((ws) + (INPLACE_U ? WS_QA : WS_U)))
#define U_B(ws) ((f16*)((ws) + (INPLACE_U ? WS_QB : WS_U)) + (INPLACE_U ? 0 : 512))
#ifndef XREC
#define XREC (INPLACE_U)
#endif
#ifndef FUSE_AB
#define FUSE_AB 1
#endif
#ifndef GATE_RATIO
#define GATE_RATIO 1
#endif
#ifndef EPI5_ONE
#define EPI5_ONE 1
#endif
#ifndef GATE_FRAG
#define GATE_FRAG 1
#endif
#ifndef WARM_SKIP
#define WARM_SKIP 0
#endif
#ifndef PROBE_REP
#define PROBE_REP 1
#endif
#ifndef G1_WGM
#define G1_WGM 4
#endif
#ifndef PROBE_DUP
#define PROBE_DUP 0
#endif
#ifndef USE_MEGA
#define USE_MEGA 1
#endif
#ifndef USE_NV_IDX
#define USE_NV_IDX 0
#endif
#ifndef USE_NV_FOX
#define USE_NV_FOX 0
#endif
#ifndef USE_NV_DSA
#define USE_NV_DSA 0
#endif
#ifndef USE_NV_POST
#define USE_NV_POST 0
#endif
#ifndef USE_NV_GEMM1
#define USE_NV_GEMM1 0
#endif

typedef _Float16 f16;
typedef _Float16 f16x2 __attribute__((ext_vector_type(2)));
typedef _Float16 f16x4 __attribute__((ext_vector_type(4)));
typedef _Float16 f16x8 __attribute__((ext_vector_type(8)));
typedef float f32x2 __attribute__((ext_vector_type(2)));
typedef float f32x4 __attribute__((ext_vector_type(4)));
typedef float f32x16 __attribute__((ext_vector_type(16)));
typedef unsigned u32x2 __attribute__((ext_vector_type(2)));
typedef unsigned u32x4 __attribute__((ext_vector_type(4)));
typedef unsigned long long u64;
#define LAS __attribute__((address_space(3)))

constexpr int NB = 32, S = 2048, T = NB * S, D = 1024, DPLE = 256, DIN = 3792;
constexpr int N1 = 5888;
constexpr int TOPK = 256;
constexpr float EPS = 1e-6f;
constexpr float LOG2E = 1.4426950408889634f;
constexpr float C2 = 0.125f * 1.4426950408889634f;
constexpr float IDX_SCALE = 0.044194173824159216f;
constexpr int O_QA = 0, O_KA = 512, O_VA = 576, O_GA = 640, O_QI = 1152, O_KI = 1664, O_WI = 1728, O_QB = 1736, O_KB = 2248, O_VB = 2760, O_FB = 3272, O_GB = 3280;
constexpr int P_QA = 0, P_QI = 512, P_QB = 1024, P_KB = 1536, P_VB = 2048, P_GA = 2560, P_GB = 3072, P_SM = 3584, P_MG = 3840;

constexpr size_t MiB = 1u << 20;
constexpr size_t WS_CTL = 0, WS_ROPE = 1 * MiB, WS_W1T = 2 * MiB, WS_WBA = 14 * MiB, WS_WBB = 15 * MiB, WS_WO = 16 * MiB, WS_WPG = 18 * MiB, WS_WPLE = 20 * MiB,
                 WS_ROWSQ = 21 * MiB, WS_WI = 22 * MiB, WS_LOGF = 24 * MiB, WS_CSUM = 26 * MiB, WS_KA = 28 * MiB, WS_VA = 36 * MiB, WS_KI = 44 * MiB, WS_MASK = 52 * MiB,
                 WS_P16 = 68 * MiB, WS_H16 = 100 * MiB, WS_U = 100 * MiB  , WS_MG = 228 * MiB,
                 WS_QA = 484 * MiB, WS_QI = 548 * MiB, WS_QB = 612 * MiB, WS_KB = 676 * MiB, WS_VB = 740 * MiB, WS_SGA = 804 * MiB, WS_SGB = 868 * MiB, WS_END = 932 * MiB,
                 WS_MERGED = INPLACE_U ? 740 * MiB   : 484 * MiB  , WS_OUT16 = 612 * MiB  , WS_E16 = 356 * MiB  ,
                 WS_X116 = INPLACE ? WS_OUT16 : 740 * MiB  , WS_V16 = INPLACE ? WS_E16 : 228 * MiB  ;

struct Params {
    const float *x, *p, *w_in, *b_forget, *w_ba, *w_bb, *w_merge, *w_out, *g_pre, *g_post, *w_ple, *w_pg, *g_ple;
    float* out; unsigned char* ws;
};

__device__ __forceinline__ float wave_sum(float v) {
#pragma unroll
    for (int o = 1; o < 64; o <<= 1) v += __shfl_xor(v, o);
    return v;
}
#if USE_NV_GEMM1 || USE_NV_POST
constexpr float W_PRESCALE = 1.f;
#else
constexpr float W_PRESCALE = -1.4426950408889634f;
#endif
constexpr float NEG_LN2 = -0.6931471805599453f;
__device__ __forceinline__ float gate_t(float a) { return __builtin_amdgcn_rcpf(1.0f + __builtin_amdgcn_exp2f(a)); }
__device__ __forceinline__ float gate1(float a, float al, float be) { return __builtin_fmaf(a, al, be) * gate_t(a); }
__device__ __forceinline__ float sigmoidf_(float z) { return __builtin_amdgcn_rcpf(1.0f + __builtin_amdgcn_exp2f(z * -LOG2E)); }
__device__ __forceinline__ float siluf_(float z) { return z * __builtin_amdgcn_rcpf(1.0f + __builtin_amdgcn_exp2f(z * -LOG2E)); }
__device__ __forceinline__ float logsigmoidf_(float z) { return fminf(z, 0.f) - 0.6931471805599453f * __builtin_amdgcn_logf(1.0f + __builtin_amdgcn_exp2f(fabsf(z) * -LOG2E)); }
__device__ __forceinline__ unsigned sortkey(float f) { const unsigned u = __float_as_uint(f); return (u & 0x80000000u) ? ~u : (u | 0x80000000u); }

__device__ __forceinline__ int w1_src(int n, int& which) {
    which = 0;
    if (n < P_QI) return O_QA + n;
    if (n < P_QB) return O_QI + (n - P_QI);
    if (n < P_KB) return O_QB + (n - P_QB);
    if (n < P_VB) return O_KB + (n - P_KB);
    if (n < P_GA) return O_VB + (n - P_VB);
    if (n < P_GB) return O_GA + (n - P_GA);
    if (n < P_SM) return O_GB + (n - P_GB);
    if (n < P_MG) { const int c = n - P_SM;
        if (c < 64) return O_KA + c; if (c < 128) return O_VA + (c - 64); if (c < 192) return O_KI + (c - 128);
        if (c < 200) return O_WI + (c - 192); if (c < 208) return O_FB + (c - 200); which = -1; return 0; }
    which = 1;
    if (GATE_RATIO) { const int c = n - P_MG, j = c >> 8, w = c & 255; return w < 128 ? 128 * j + w : 1024 + 128 * j + (w - 128); }
    return n - P_MG;
}

__device__ __forceinline__ void tr_item(const float* src, int ldw, f16* WT, int K, int n0, int k0, LAS float* scr, int lane, float scale = 1.f) {
    float tv[32];
#pragma unroll
    for (int i = 0; i < 32; ++i) { const int kk = 2 * i + (lane >> 5); tv[i] = src ? src[(size_t)(k0 + kk) * ldw] : 0.f; }
#pragma unroll
    for (int i = 0; i < 32; ++i) { const int kk = 2 * i + (lane >> 5); scr[kk * 33 + (lane & 31)] = tv[i]; }
    asm volatile("s_waitcnt lgkmcnt(0)" ::: "memory");
    const int c = lane & 7;
#pragma unroll
    for (int j = 0; j < 4; ++j) { const int n = (lane >> 3) + 8 * j; const LAS float* s = scr + (8 * c) * 33 + n;
        f16x8 o;
#pragma unroll
        for (int e = 0; e < 8; ++e) o[e] = (f16)(s[e * 33] * scale);
        *(f16x8*)(WT + (size_t)(n0 + n) * K + k0 + 8 * c) = o; }
    asm volatile("s_waitcnt lgkmcnt(0)" ::: "memory");
}
__device__ __forceinline__ void sincos_d(double a, float& sn, float& cs) {
    const double TWO_PI = 6.283185307179586476925, INV = 0.15915494309189533576888;
    double r = a - rint(a * INV) * TWO_PI;
    const double HALF_PI = 1.57079632679489661923;
    const double qd = rint(r / HALF_PI); const int q = ((int)qd) & 3; const double y = r - qd * HALF_PI, y2 = y * y;
    const double s = y * (1.0 + y2 * (-1.0 / 6 + y2 * (1.0 / 120 + y2 * (-1.0 / 5040 + y2 * (1.0 / 362880 + y2 * (-1.0 / 39916800 + y2 * (1.0 / 6227020800.0)))))));
    const double c = 1.0 + y2 * (-0.5 + y2 * (1.0 / 24 + y2 * (-1.0 / 720 + y2 * (1.0 / 40320 + y2 * (-1.0 / 3628800 + y2 * (1.0 / 479001600.0 + y2 * (-1.0 / 87178291200.0)))))));
    double so, co;
    if (q == 0) { so = s; co = c; } else if (q == 1) { so = c; co = -s; } else if (q == 2) { so = -s; co = -c; } else { so = -c; co = s; }
    sn = (float)so; cs = (float)co;
}
__device__ __forceinline__ void p0_prologue(const Params& P, LAS unsigned char* lds, int vcu, int G) {
    const int tid = threadIdx.x, lane = tid & 63, wave = tid >> 6, NW = blockDim.x >> 6;
    LAS float* scr = (LAS float*)(lds + wave * 8704);
    const int gw = vcu * NW + wave, NGW = G * NW;
    unsigned char* ws = P.ws;
    constexpr int I_W1 = (N1 / 32) * (D / 64), I_BA = (D / 32) * (512 / 64), I_WO = (D / 32) * (D / 64), I_PLE = (D / 32) * (DPLE / 64);
    constexpr int NITEMS = I_W1 + 2 * I_BA + 2 * I_WO + I_PLE;
    for (int it = gw; it < NITEMS; it += NGW) {
        int r = it;
        if (r < I_W1) { const int nb = r % (N1 / 32), kb = r / (N1 / 32); int which; const int sc = w1_src(nb * 32 + (lane & 31), which);
            const float* src = which == 0 ? P.w_in + sc : (which == 1 ? P.w_merge + sc : nullptr);
            tr_item(src, which == 1 ? 2048 : DIN, (f16*)(ws + WS_W1T), D, nb * 32, kb * 64, scr, lane, (nb * 32 >= P_MG || (nb * 32 >= P_GA && nb * 32 < P_SM)) ? W_PRESCALE : 1.f); continue; }
        r -= I_W1;
        if (r < I_BA) { const int nb = r % 32, kb = r / 32; tr_item(P.w_ba + nb * 32 + (lane & 31), D, (f16*)(ws + WS_WBA), 512, nb * 32, kb * 64, scr, lane); continue; }
        r -= I_BA;
        if (r < I_BA) { const int nb = r % 32, kb = r / 32; tr_item(P.w_bb + nb * 32 + (lane & 31), D, (f16*)(ws + WS_WBB), 512, nb * 32, kb * 64, scr, lane); continue; }
        r -= I_BA;
        if (r < I_WO) { const int nb = r % 32, kb = r / 32; tr_item(P.w_out + nb * 32 + (lane & 31), D, (f16*)(ws + WS_WO), D, nb * 32, kb * 64, scr, lane); continue; }
        r -= I_WO;
        if (r < I_WO) { const int nb = r % 32, kb = r / 32; tr_item(P.w_pg + nb * 32 + (lane & 31), D, (f16*)(ws + WS_WPG), D, nb * 32, kb * 64, scr, lane, W_PRESCALE); continue; }
        r -= I_WO;
        { const int nb = r % 32, kb = r / 32; tr_item(P.w_ple + nb * 32 + (lane & 31), D, (f16*)(ws + WS_WPLE), DPLE, nb * 32, kb * 64, scr, lane); }
    }
    {
        f32x4 g[4];
#pragma unroll
        for (int j = 0; j < 4; ++j) g[j] = ((const f32x4*)P.g_pre)[64 * j + lane];
        for (int m = gw; m < T; m += 2 * NGW) {
            const int m2 = m + NGW; const bool has2 = m2 < T;
            const f32x4* xr = (const f32x4*)(P.x + (size_t)m * D) + lane; const f32x4* xs = (const f32x4*)(P.x + (size_t)(has2 ? m2 : m) * D) + lane;
            f32x4 v[4], u[4]; float s2 = 0.f, t2 = 0.f;
#pragma unroll
            for (int j = 0; j < 4; ++j) { v[j] = __builtin_nontemporal_load(xr + 64 * j); u[j] = __builtin_nontemporal_load(xs + 64 * j); }
#pragma unroll
            for (int j = 0; j < 4; ++j) { s2 += (v[j].x * v[j].x + v[j].y * v[j].y) + (v[j].z * v[j].z + v[j].w * v[j].w); t2 += (u[j].x * u[j].x + u[j].y * u[j].y) + (u[j].z * u[j].z + u[j].w * u[j].w); }
            const float rstd = rsqrtf(wave_sum(s2) * (1.f / D) + EPS), rstu = rsqrtf(wave_sum(t2) * (1.f / D) + EPS);
            if (XREC && lane == 0) { float* xsc = (float*)(ws + WS_ROWSQ) + 3 * T; xsc[m] = 1.f / rstd; if (has2) xsc[m2] = 1.f / rstu; }
            f16x4* o = (f16x4*)((f16*)(ws + WS_H16) + (size_t)m * D) + lane; f16x4* o2 = (f16x4*)((f16*)(ws + WS_H16) + (size_t)m2 * D) + lane;
#pragma unroll
            for (int j = 0; j < 4; ++j) { f16x4 h; h[0] = (f16)(v[j].x * rstd * g[j].x); h[1] = (f16)(v[j].y * rstd * g[j].y); h[2] = (f16)(v[j].z * rstd * g[j].z); h[3] = (f16)(v[j].w * rstd * g[j].w); o[64 * j] = h; }
            if (has2) {
#pragma unroll
                for (int j = 0; j < 4; ++j) { f16x4 h; h[0] = (f16)(u[j].x * rstu * g[j].x); h[1] = (f16)(u[j].y * rstu * g[j].y); h[2] = (f16)(u[j].z * rstu * g[j].z); h[3] = (f16)(u[j].w * rstu * g[j].w); o2[64 * j] = h; } }
        }
    }
    {
        const size_t n8 = (size_t)T * DPLE / 8; const size_t gt = (size_t)vcu * blockDim.x + tid, GT = (size_t)G * blockDim.x;
        for (size_t i0 = gt; i0 < n8; i0 += 4 * GT) { f32x4 a[4], b[4];
#pragma unroll
            for (int q = 0; q < 4; ++q) { size_t i = i0 + q * GT; if (i >= n8) i = i0; a[q] = __builtin_nontemporal_load((const f32x4*)P.p + 2 * i); b[q] = __builtin_nontemporal_load((const f32x4*)P.p + 2 * i + 1); }
#pragma unroll
            for (int q = 0; q < 4; ++q) { const size_t i = i0 + q * GT; f16x8 o; o[0] = (f16)a[q].x; o[1] = (f16)a[q].y; o[2] = (f16)a[q].z; o[3] = (f16)a[q].w; o[4] = (f16)b[q].x; o[5] = (f16)b[q].y; o[6] = (f16)b[q].z; o[7] = (f16)b[q].w;
                if (i < n8) ((f16x8*)(ws + WS_P16))[i] = o; } }
        for (size_t i = gt; i < (size_t)S * 8; i += GT) { const int pos = (int)(i >> 3), fi = (int)(i & 7);
            const float frf = fi == 0 ? 1.0f : fi == 1 ? 0.19392274474868576f : fi == 2 ? 0.03760603093086393f : fi == 3 ? 0.007292664737217109f : fi == 4 ? 0.001414213562373095f
                            : fi == 5 ? 0.0002742481756762073f : fi == 6 ? 5.318295896944988e-05f : 1.031338537721246e-05f;
            const float ang = (float)pos * frf;
            float sn, cs; sincos_d((double)ang, sn, cs); ((f32x2*)(ws + WS_ROPE))[i] = (f32x2){cs, sn}; }
        for (size_t i = gt; i < (size_t)2 * T; i += GT) ((float*)(ws + WS_ROWSQ))[i] = 0.f;
#if USE_NV_IDX
        for (size_t i = gt; i < (size_t)16 * MiB / 16; i += GT) ((u32x4*)(ws + WS_MASK))[i] = (u32x4){0u, 0u, 0u, 0u};
#endif
    }
}
__global__ void __launch_bounds__(512) k_p0(Params P) {
    extern __shared__ __attribute__((aligned(16))) unsigned char lds[];
    p0_prologue(P, (LAS unsigned char*)lds, blockIdx.x, gridDim.x);
}


namespace pg8 {
constexpr int BM = 256, BK = 64, HALF = 128, HTB = HALF * BK * 2, STAGE_BYTES = 8 * HTB, NXCD = 8, WGM = 8;
__host__ __device__ __forceinline__ int lds_byte(int r, int c) { const int st = (r >> 4) * 2 + (c >> 5), rr = r & 15, cc = c & 31, ob = rr * 64 + cc * 2; return st * 1024 + (ob ^ (((ob >> 9) & 1) << 5)); }
__host__ __device__ __forceinline__ void stage_rc(int b, int& R, int& C) { const int st = b / 1024, sb = b % 1024, swz = sb ^ (((sb >> 9) & 1) << 5); R = (st >> 1) * 16 + swz / 64; C = (st & 1) * 32 + (swz % 64) / 2; }
__host__ __device__ __forceinline__ int perm32(int rho) { const int n = rho >> 4, i = rho & 15; return 8 * (i >> 2) + 4 * n + (i & 3); }
struct Unit { int pm, pn; };
struct Gemm { const f16* A; const f16* Bt; int lda, ldb, K; const f16* A2 = nullptr; const f16* Bt2 = nullptr; };
struct StaticOrder {
    int nM, nN, nwg, G, c, wgm; bool hot;
    __host__ __device__ void init(int M, int N, int G_, int c_, int wgm_ = WGM) { nM = M / BM; nN = N / BM; nwg = nM * nN; G = G_; c = c_; hot = false; wgm = wgm_; }
    __host__ __device__ bool next(int i, Unit& u) const {
        const long L = (long)i * G + c; if (L >= nwg) return false;
        int wgid = (int)L; { const int q = nwg / NXCD, r = nwg % NXCD, xcd = wgid % NXCD, off = wgid / NXCD; wgid = (xcd < r ? xcd * (q + 1) : r * (q + 1) + (xcd - r) * q) + off; }
        const int nig = wgm * nN, gid = wgid / nig, fm = gid * wgm, gsz = (nM - fm) < wgm ? (nM - fm) : wgm;
        u.pm = fm + ((wgid % nig) % gsz); u.pn = (wgid % nig) / gsz; if (hot) { u.pm &= 1; u.pn &= 1; } return true;
    }
};
template <class Epi, bool SEG2 = false>
__device__ __forceinline__ void gemm_phase(LAS unsigned char* lds, const Gemm g, const StaticOrder& S, const Epi& E) {
    int tid = threadIdx.x; asm volatile("" : "+v"(tid));
    const int wid = __builtin_amdgcn_readfirstlane(tid >> 6), lane = tid & 63, wr = wid >> 2, wc = wid & 3, fr = lane & 15, fq = lane >> 4;
    const int nt = g.K / BK;
    unsigned voffA[2], voffB[2];
#pragma unroll
    for (int i = 0; i < 2; ++i) { int R, C; stage_rc(tid * 16 + i * 8192, R, C); const int Rb = (R & ~31) + perm32(R & 31);
        voffA[i] = (unsigned)(R * g.lda + C) * 2u; voffB[i] = (unsigned)(Rb * g.ldb + C) * 2u; }
    const size_t kstep = (size_t)(BK * 2);
    const size_t hstepA = (size_t)HALF * g.lda * 2, hstepB = (size_t)HALF * g.ldb * 2, tstepA = 2 * hstepA, tstepB = 2 * hstepB;
    const unsigned ldsw = (unsigned)wid * 1024u;
    const int aoff = lds_byte(wr * 64 + fr, fq * 8), boff = lds_byte(wc * 32 + fr, fq * 8);
#define PG8_SA(b, h) (((b) * 2 + (h)) * HTB)
#define PG8_SB(b, h) ((4 + (b) * 2 + (h)) * HTB)
#define PG8_STAGE(bufoff, gbase, voff) do { _Pragma("unroll") for (int _i = 0; _i < 2; ++_i) \
        __builtin_amdgcn_global_load_lds((const unsigned*)((const char*)(gbase) + (voff)[_i]), (LAS unsigned*)(lds + (bufoff) + ldsw + _i * 8192), 16, 0, 0); } while (0)
#define PG8_LDA(dst, b, h) do { _Pragma("unroll") for (int m = 0; m < 4; ++m) _Pragma("unroll") for (int k = 0; k < 2; ++k) dst[m][k] = *(const LAS f16x8*)(lds + PG8_SA(b, h) + aoff + m * 2048 + k * 1024); } while (0)
#define PG8_LDB(dst, b, h) do { _Pragma("unroll") for (int n = 0; n < 2; ++n) _Pragma("unroll") for (int k = 0; k < 2; ++k) dst[n][k] = *(const LAS f16x8*)(lds + PG8_SB(b, h) + boff + n * 2048 + k * 1024); } while (0)
#define PG8_MMA(ai, bj, At, Bt) do { __builtin_amdgcn_s_setprio(1); _Pragma("unroll") for (int m = 0; m < 4; ++m) _Pragma("unroll") for (int n = 0; n < 2; ++n) _Pragma("unroll") for (int k = 0; k < 2; ++k) \
        acc[ai][bj][m][n] = __builtin_amdgcn_mfma_f32_16x16x32_f16(Bt[n][k], At[m][k], acc[ai][bj][m][n], 0, 0, 0); __builtin_amdgcn_s_setprio(0); } while (0)
#define PG8_WAIT_V(n) asm volatile("s_waitcnt vmcnt(" #n ")" ::: "memory")
#define PG8_WAIT_L(n) asm volatile("s_waitcnt lgkmcnt(" #n ")" ::: "memory")
#define PG8_BAR __builtin_amdgcn_s_barrier()
#define PG8_SCHED __builtin_amdgcn_sched_barrier(0)
    Unit cur, nxt; int ui = 0; bool warm = false;
    if (!S.next(0, cur)) return;
    f32x4 acc[2][2][4][2];
#pragma unroll
    for (int a = 0; a < 2; ++a)
#pragma unroll
        for (int b = 0; b < 2; ++b)
#pragma unroll
            for (int m = 0; m < 4; ++m)
#pragma unroll
                for (int n = 0; n < 2; ++n) acc[a][b][m][n] = (f32x4){0.f, 0.f, 0.f, 0.f};
    f16x8 At[4][2], B0[2][2], B1[2][2];
    const char* cA = (const char*)g.A + (size_t)cur.pm * tstepA; const char* cB = (const char*)g.Bt + (size_t)cur.pn * tstepB;
    const int hs = nt >> 1; const size_t segb = (size_t)hs * kstep;
    const char* cA2 = SEG2 ? (const char*)g.A2 + (size_t)cur.pm * tstepA - segb : cA; const char* cB2 = SEG2 ? (const char*)g.Bt2 + (size_t)cur.pn * tstepB - segb : cB;
    PG8_STAGE(PG8_SB(0, 0), cB, voffB); PG8_STAGE(PG8_SB(0, 1), cB + hstepB, voffB); PG8_STAGE(PG8_SA(0, 0), cA, voffA); PG8_STAGE(PG8_SA(0, 1), cA + hstepA, voffA);
    if (wr == 1) PG8_BAR;
    PG8_WAIT_V(2); PG8_BAR;
    PG8_STAGE(PG8_SB(1, 0), cB + kstep, voffB); PG8_STAGE(PG8_SA(1, 0), cA + kstep, voffA); PG8_STAGE(PG8_SB(1, 1), cB + hstepB + kstep, voffB);
    PG8_WAIT_V(6); PG8_BAR;
    for (;;) {
        const bool has_next = S.next(ui + 1, nxt);
        const char* nA = has_next ? (const char*)g.A + (size_t)nxt.pm * tstepA : cA; const char* nB = has_next ? (const char*)g.Bt + (size_t)nxt.pn * tstepB : cB;
        const char* nA2 = (SEG2 && has_next) ? (const char*)g.A2 + (size_t)nxt.pm * tstepA - segb : cA2; const char* nB2 = (SEG2 && has_next) ? (const char*)g.Bt2 + (size_t)nxt.pn * tstepB - segb : cB2;
#pragma unroll 1
        for (int t = 0; t < nt; t += 2) {
            const bool last = (t == nt - 2);
            if constexpr (SEG2) if (t == hs) E.mid(acc, cur, wr, wc, fr, fq);
            const char* a1 = ((SEG2 && t >= hs) ? cA2 : cA) + (size_t)(t + 1) * kstep;
            const char* a2 = last ? nA : ((SEG2 && t + 2 >= hs) ? cA2 : cA) + (size_t)(t + 2) * kstep; const char* b2 = last ? nB : ((SEG2 && t + 2 >= hs) ? cB2 : cB) + (size_t)(t + 2) * kstep;
            const char* a3 = a2 + kstep; const char* b3 = b2 + kstep;
            const bool skipw = WARM_SKIP && warm && t == 0;
            PG8_LDB(B0, 0, 0); PG8_LDB(B1, 0, 1); PG8_SCHED; PG8_LDA(At, 0, 0); PG8_STAGE(PG8_SA(1, 1), a1 + hstepA, voffA);
            if (!skipw) PG8_WAIT_V(8); PG8_WAIT_L(0); PG8_BAR; PG8_MMA(0, 0, At, B0); PG8_MMA(0, 1, At, B1); PG8_BAR; PG8_SCHED;
            PG8_LDA(At, 0, 1); PG8_STAGE(PG8_SB(0, 0), b2, voffB); PG8_STAGE(PG8_SB(0, 1), b2 + hstepB, voffB); PG8_STAGE(PG8_SA(0, 0), a2, voffA);
            if (!skipw) PG8_WAIT_V(8); PG8_WAIT_L(0); PG8_BAR; PG8_MMA(1, 0, At, B0); PG8_MMA(1, 1, At, B1); PG8_BAR; PG8_SCHED;
            PG8_LDB(B0, 1, 0); PG8_LDB(B1, 1, 1); PG8_SCHED; PG8_LDA(At, 1, 0); PG8_STAGE(PG8_SA(0, 1), a2 + hstepA, voffA);
            PG8_WAIT_V(8); PG8_WAIT_L(0); PG8_BAR; PG8_MMA(0, 0, At, B0); PG8_MMA(0, 1, At, B1); PG8_BAR; PG8_SCHED;
            PG8_LDA(At, 1, 1); PG8_STAGE(PG8_SB(1, 0), b3, voffB); PG8_STAGE(PG8_SB(1, 1), b3 + hstepB, voffB); PG8_STAGE(PG8_SA(1, 0), a3, voffA);
            PG8_WAIT_V(8); PG8_WAIT_L(0); PG8_BAR; PG8_MMA(1, 0, At, B0); PG8_MMA(1, 1, At, B1); PG8_BAR; PG8_SCHED;
        }
        if (wr == 0) PG8_BAR;
        if (WARM_SKIP && has_next) { PG8_WAIT_V(0); PG8_BAR; warm = true; }
        E(acc, cur, wr, wc, fr, fq);
        if (!has_next) break;
#pragma unroll
        for (int a = 0; a < 2; ++a)
#pragma unroll
            for (int b = 0; b < 2; ++b)
#pragma unroll
                for (int m = 0; m < 4; ++m)
#pragma unroll
                    for (int n = 0; n < 2; ++n) acc[a][b][m][n] = (f32x4){0.f, 0.f, 0.f, 0.f};
        cur = nxt; cA = nA; cB = nB; cA2 = nA2; cB2 = nB2; ++ui;
        if (wr == 1) PG8_BAR;
    }
    PG8_WAIT_V(0);
    PG8_BAR;
#undef PG8_SA
#undef PG8_SB
#undef PG8_STAGE
#undef PG8_LDA
#undef PG8_LDB
#undef PG8_MMA
#undef PG8_WAIT_V
#undef PG8_WAIT_L
#undef PG8_BAR
#undef PG8_SCHED
}
}

#ifndef EPI_NT
#define EPI_NT 0
#endif
#define EPI_ST_STREAM(p, v) __builtin_nontemporal_store((v), (p))
#if EPI_NT == 1
#define EPI_ST(p, v) __builtin_nontemporal_store((v), (p))
#else
#define EPI_ST(p, v) (*(p) = (v))
#endif
#ifndef EPI_TR
#define EPI_TR 1
#endif
__device__ __forceinline__ f16x8 epi_tr(f16x8 v, int src4) { if (!EPI_TR) return v; u32x4 w = __builtin_bit_cast(u32x4, v), r;
    r[0] = (unsigned)__builtin_amdgcn_ds_bpermute(src4, (int)w[0]); r[1] = (unsigned)__builtin_amdgcn_ds_bpermute(src4, (int)w[1]);
    r[2] = (unsigned)__builtin_amdgcn_ds_bpermute(src4, (int)w[2]); r[3] = (unsigned)__builtin_amdgcn_ds_bpermute(src4, (int)w[3]); return __builtin_bit_cast(f16x8, r); }
__device__ __forceinline__ f16x8 pack8(const f32x4 a, const f32x4 b) { f16x8 o; o[0] = (f16)a[0]; o[1] = (f16)a[1]; o[2] = (f16)a[2]; o[3] = (f16)a[3]; o[4] = (f16)b[0]; o[5] = (f16)b[1]; o[6] = (f16)b[2]; o[7] = (f16)b[3]; return o; }

constexpr float MB_MIN14 = 6.103515625e-05f;
struct EpiG1 {
    unsigned char* ws; const float* b_forget;
    __device__ __forceinline__ void smalls(const f32x4 (&acc)[2][2][4][2], const pg8::Unit& u, int wr, int wc, int fr, int fq) const {
        const int row0 = u.pm * 256 + wr * 64 + fr; const bool rope = (wc == 0);
#pragma unroll
        for (int ai = 0; ai < 2; ++ai)
#pragma unroll
            for (int m = 0; m < 4; ++m) {
                const int row = row0 + ai * 128 + m * 16; const int pos = row & (S - 1);
#pragma unroll
                for (int bj = 0; bj < 2; ++bj) {
                    f32x4 v0 = acc[ai][bj][m][0], v1 = acc[ai][bj][m][1];
                    if (rope) {
                        f32x4 p0, p1;
#pragma unroll
                        for (int e = 0; e < 4; ++e) { p0[e] = __shfl_xor(v0[e], 16); p1[e] = __shfl_xor(v1[e], 16); }
                        if (fq < 2) { const f32x4* rp = (const f32x4*)(ws + WS_ROPE) + pos * 4; const f32x4 c01 = rp[0], c23 = rp[1], c45 = rp[2], c67 = rp[3];
                            const float sg = fq == 0 ? -1.f : 1.f;
                            v0[0] = v0[0] * c01[0] + sg * p0[0] * c01[1]; v0[1] = v0[1] * c01[2] + sg * p0[1] * c01[3]; v0[2] = v0[2] * c23[0] + sg * p0[2] * c23[1]; v0[3] = v0[3] * c23[2] + sg * p0[3] * c23[3];
                            v1[0] = v1[0] * c45[0] + sg * p1[0] * c45[1]; v1[1] = v1[1] * c45[2] + sg * p1[1] * c45[3]; v1[2] = v1[2] * c67[0] + sg * p1[2] * c67[1]; v1[3] = v1[3] * c67[2] + sg * p1[3] * c67[3]; }
                    }
                    const int c = bj * 128 + wc * 32 + fq * 8;
                    if (c < 64) *(f16x8*)((f16*)(ws + WS_KA) + (size_t)row * 64 + c) = pack8(v0, v1);
                    else if (c < 128) *(f16x8*)((f16*)(ws + WS_VA) + (size_t)row * 64 + (c - 64)) = pack8(v0, v1);
                    else if (c < 192) *(f16x8*)((f16*)(ws + WS_KI) + (size_t)row * 64 + (c - 128)) = pack8(v0, v1);
                    else if (c == 192) { f32x4* o = (f32x4*)((float*)(ws + WS_WI) + (size_t)row * 8); o[0] = v0 * IDX_SCALE; o[1] = v1 * IDX_SCALE; }
                    else if (c == 200) { const f32x4 b0 = ((const f32x4*)b_forget)[0], b1 = ((const f32x4*)b_forget)[1]; f32x4 l0, l1;
#pragma unroll
                        for (int e = 0; e < 4; ++e) { l0[e] = logsigmoidf_(v0[e] + b0[e]); l1[e] = logsigmoidf_(v1[e] + b1[e]); }
                        f32x4* o = (f32x4*)((float*)(ws + WS_LOGF) + (size_t)row * 8); o[0] = l0; o[1] = l1; }
                }
            }
    }
    __device__ __forceinline__ void operator()(const f32x4 (&acc)[2][2][4][2], const pg8::Unit& u, int wr, int wc, int fr, int fq) const {
        const int pn = u.pn;
        if (pn == 14) { smalls(acc, u, wr, wc, fr, fq); return; }
        const int row0 = u.pm * 256 + wr * 64 + fr;
        f16* dst; int ld, colb; float alpha = 1.f, beta = 0.f; int gated = 0, rope = 0;
        if (pn < 2) { dst = (f16*)(ws + WS_QA); ld = 512; colb = 256 * pn; alpha = C2; rope = !(wc & 1); }
        else if (pn < 4) { dst = (f16*)(ws + WS_QI); ld = 512; colb = 256 * (pn - 2); rope = !(wc & 1); }
        else if (pn < 6) { dst = (f16*)(ws + WS_QB); ld = 512; colb = 256 * (pn - 4); alpha = C2; }
        else if (pn < 8) { dst = (f16*)(ws + WS_KB); ld = 512; colb = 256 * (pn - 6); }
        else if (pn < 10) { dst = (f16*)(ws + WS_VB); ld = 512; colb = 256 * (pn - 8); }
        else if (pn < 12) { dst = (f16*)(ws + WS_SGA); ld = 512; colb = 256 * (pn - 10); gated = 1; alpha = NEG_LN2; }
        else if (pn < 14) { dst = (f16*)(ws + WS_SGB); ld = 512; colb = 256 * (pn - 12); gated = 1; alpha = NEG_LN2; }
        else { dst = (f16*)(ws + WS_MG); ld = 2048; colb = 256 * (pn - 15); gated = 1; alpha = 0.f; beta = 1.f; }
        const int ln = fr + 16 * fq, tfr = EPI_TR ? ln >> 2 : fr, tfq = EPI_TR ? ln & 3 : fq, src4 = 4 * (tfr + 16 * tfq);
        if (GATE_RATIO && pn >= 15) {
#if GATE_FRAG
            f16* dr = (f16*)(ws + WS_MG) + ((size_t)(((u.pm * 8 + (pn - 15)) * 8 + wr * 4 + wc) * 8) * 64 + fr + 16 * fq) * 8;
#pragma unroll
            for (int ai = 0; ai < 2; ++ai)
#pragma unroll
                for (int m = 0; m < 4; ++m) { f32x4 r0, r1, b0, b1;
#pragma unroll
                    for (int e = 0; e < 4; ++e) {
                        b0[e] = fmaxf(gate1(acc[ai][1][m][0][e], 0.f, 1.f), MB_MIN14); b1[e] = fmaxf(gate1(acc[ai][1][m][1][e], 0.f, 1.f), MB_MIN14);
                        r0[e] = gate1(acc[ai][0][m][0][e], 0.f, 1.f) * __builtin_amdgcn_rcpf(b0[e]); r1[e] = gate1(acc[ai][0][m][1][e], 0.f, 1.f) * __builtin_amdgcn_rcpf(b1[e]); }
                    EPI_ST_STREAM((f16x8*)(dr + (ai * 4 + m) * 512), pack8(r0, r1));
                    EPI_ST_STREAM((f16x8*)(dr + (ai * 4 + m) * 512 + (size_t)T * 1024), pack8(b0, b1)); }
#else
            f16* dr = (f16*)(ws + WS_MG) + 128 * (pn - 15) + wc * 32 + tfq * 8 + (ptrdiff_t)(tfr - fr) * 2048;
#pragma unroll
            for (int ai = 0; ai < 2; ++ai)
#pragma unroll
                for (int m = 0; m < 4; ++m) { const int row = row0 + ai * 128 + m * 16; f32x4 r0, r1, b0, b1;
#pragma unroll
                    for (int e = 0; e < 4; ++e) {
                        b0[e] = fmaxf(gate1(acc[ai][1][m][0][e], 0.f, 1.f), MB_MIN14); b1[e] = fmaxf(gate1(acc[ai][1][m][1][e], 0.f, 1.f), MB_MIN14);
                        r0[e] = gate1(acc[ai][0][m][0][e], 0.f, 1.f) * __builtin_amdgcn_rcpf(b0[e]); r1[e] = gate1(acc[ai][0][m][1][e], 0.f, 1.f) * __builtin_amdgcn_rcpf(b1[e]); }
                    EPI_ST_STREAM((f16x8*)(dr + (size_t)row * 2048), epi_tr(pack8(r0, r1), src4));
                    EPI_ST_STREAM((f16x8*)(dr + (size_t)row * 2048 + 1024), epi_tr(pack8(b0, b1), src4)); }
#endif
            return; }
        f16* dcol = dst + colb + wc * 32 + tfq * 8 + (ptrdiff_t)(tfr - fr) * ld;
        if (gated) {
#pragma unroll
            for (int ai = 0; ai < 2; ++ai)
#pragma unroll
                for (int m = 0; m < 4; ++m)
#pragma unroll
                    for (int bj = 0; bj < 2; ++bj) { const int row = row0 + ai * 128 + m * 16; f32x4 o0, o1;
#pragma unroll
                        for (int e = 0; e < 4; ++e) { o0[e] = gate1(acc[ai][bj][m][0][e], alpha, beta); o1[e] = gate1(acc[ai][bj][m][1][e], alpha, beta); }
                        EPI_ST_STREAM((f16x8*)(dcol + (size_t)row * ld + bj * 128), epi_tr(pack8(o0, o1), src4)); }
        } else if (rope) {
#pragma unroll
            for (int ai = 0; ai < 2; ++ai)
#pragma unroll
                for (int m = 0; m < 4; ++m)
#pragma unroll
                    for (int bj = 0; bj < 2; ++bj) { const int row = row0 + ai * 128 + m * 16;
                        f32x4 v0 = acc[ai][bj][m][0], v1 = acc[ai][bj][m][1], p0, p1;
#pragma unroll
                        for (int e = 0; e < 4; ++e) { p0[e] = __shfl_xor(v0[e], 16); p1[e] = __shfl_xor(v1[e], 16); }
                        if (fq < 2) { const f32x4* rp = (const f32x4*)(ws + WS_ROPE) + (row & (S - 1)) * 4; const f32x4 c01 = rp[0], c23 = rp[1], c45 = rp[2], c67 = rp[3];
                            const float sg = fq == 0 ? -1.f : 1.f;
                            v0[0] = v0[0] * c01[0] + sg * p0[0] * c01[1]; v0[1] = v0[1] * c01[2] + sg * p0[1] * c01[3]; v0[2] = v0[2] * c23[0] + sg * p0[2] * c23[1]; v0[3] = v0[3] * c23[2] + sg * p0[3] * c23[3];
                            v1[0] = v1[0] * c45[0] + sg * p1[0] * c45[1]; v1[1] = v1[1] * c45[2] + sg * p1[1] * c45[3]; v1[2] = v1[2] * c67[0] + sg * p1[2] * c67[1]; v1[3] = v1[3] * c67[2] + sg * p1[3] * c67[3]; }
                        EPI_ST_STREAM((f16x8*)(dcol + (size_t)row * ld + bj * 128), epi_tr(pack8(v0 * alpha, v1 * alpha), src4)); }
        } else {
#pragma unroll
            for (int ai = 0; ai < 2; ++ai)
#pragma unroll
                for (int m = 0; m < 4; ++m)
#pragma unroll
                    for (int bj = 0; bj < 2; ++bj) { const int row = row0 + ai * 128 + m * 16;
                        EPI_ST_STREAM((f16x8*)(dcol + (size_t)row * ld + bj * 128), epi_tr(pack8(acc[ai][bj][m][0] * alpha, acc[ai][bj][m][1] * alpha), src4)); }
        }
    }
};
struct EpiNull { float* sink;
    __device__ __forceinline__ void operator()(const f32x4 (&acc)[2][2][4][2], const pg8::Unit& u, int wr, int wc, int fr, int fq) const {
        f32x4 s = (f32x4){0.f, 0.f, 0.f, 0.f};
#pragma unroll
        for (int ai = 0; ai < 2; ++ai)
#pragma unroll
            for (int bj = 0; bj < 2; ++bj)
#pragma unroll
                for (int m = 0; m < 4; ++m)
#pragma unroll
                    for (int n = 0; n < 2; ++n) s += acc[ai][bj][m][n];
        if (s[0] + s[1] + s[2] + s[3] == 1.2345e30f) sink[u.pm] = s[0]; } };
constexpr int GEMM_LDS = 147456;
__global__ void __launch_bounds__(512, 2) k_gemm1(Params P) {
    extern __shared__ __attribute__((aligned(16))) unsigned char lds[];
    pg8::Gemm g{(const f16*)(P.ws + WS_H16), (const f16*)(P.ws + WS_W1T), D, D, D}; pg8::StaticOrder So; So.init(T, N1, gridDim.x, blockIdx.x);
    EpiG1 E{P.ws, P.b_forget};
    pg8::gemm_phase<EpiG1>((LAS unsigned char*)lds, g, So, E);
}


constexpr float MB_MIN = 5.9604645e-8f;
template <int MODE> struct EpiGen {
    f16* dst; const f16* mul; int ldm, mulcol; const f16* add; float* rowsq;
    __device__ __forceinline__ const f16* fragb(const pg8::Unit& u, int wr, int wc, int fr, int fq) const { return mul + ((size_t)((((u.pm * 8 + 2 * u.pn) * 8 + wr * 4 + wc) * 8) * 64) + fr + 16 * fq) * 8; }
    __device__ __forceinline__ void mid(f32x4 (&acc)[2][2][4][2], const pg8::Unit& u, int wr, int wc, int fr, int fq) const {
        const int row0 = u.pm * 256 + wr * 64 + fr, col0 = u.pn * 256 + wc * 32 + fq * 8;
#if GATE_RATIO
        f16x8 rr[2][4][2];
#pragma unroll
        for (int ai = 0; ai < 2; ++ai)
#pragma unroll
            for (int m = 0; m < 4; ++m)
#pragma unroll
                for (int bj = 0; bj < 2; ++bj) rr[ai][m][bj] = GATE_FRAG ? *(const f16x8*)(fragb(u, wr, wc, fr, fq) + bj * 32768 + (ai * 4 + m) * 512)
                                                                         : *(const f16x8*)(mul + (size_t)(row0 + ai * 128 + m * 16) * ldm + col0 + bj * 128);
#pragma unroll
        for (int ai = 0; ai < 2; ++ai)
#pragma unroll
            for (int m = 0; m < 4; ++m)
#pragma unroll
                for (int bj = 0; bj < 2; ++bj)
#pragma unroll
                    for (int e = 0; e < 4; ++e) { acc[ai][bj][m][0][e] *= (float)rr[ai][m][bj][e]; acc[ai][bj][m][1][e] *= (float)rr[ai][m][bj][4 + e]; }
    }
#else
#pragma unroll
        for (int ai = 0; ai < 2; ++ai) {
            f16x8 ma[4][2], mb[4][2];
#pragma unroll
            for (int m = 0; m < 4; ++m)
#pragma unroll
                for (int bj = 0; bj < 2; ++bj) { const f16* q = mul + (size_t)(row0 + ai * 128 + m * 16) * ldm + col0 + bj * 128; ma[m][bj] = *(const f16x8*)q; mb[m][bj] = *(const f16x8*)(q + mulcol); }
#pragma unroll
            for (int m = 0; m < 4; ++m)
#pragma unroll
                for (int bj = 0; bj < 2; ++bj)
#pragma unroll
                    for (int e = 0; e < 4; ++e) {
                        acc[ai][bj][m][0][e] *= (float)ma[m][bj][e] * __builtin_amdgcn_rcpf(fmaxf((float)mb[m][bj][e], MB_MIN));
                        acc[ai][bj][m][1][e] *= (float)ma[m][bj][4 + e] * __builtin_amdgcn_rcpf(fmaxf((float)mb[m][bj][4 + e], MB_MIN)); }
            asm volatile("" ::: "memory");
        }
    }
#endif
    __device__ __forceinline__ void operator()(const f32x4 (&acc)[2][2][4][2], const pg8::Unit& u, int wr, int wc, int fr, int fq) const {
        const int row0 = u.pm * 256 + wr * 64 + fr, col0 = u.pn * 256 + wc * 32 + fq * 8;
        const int ln = fr + 16 * fq, tfr = EPI_TR ? ln >> 2 : fr, tfq = EPI_TR ? ln & 3 : fq, src4 = 4 * (tfr + 16 * tfq); const int srow = tfr - fr, scol = (tfq - fq) * 8;
        constexpr bool HAS_MUL = (MODE == 1 || MODE == 2 || MODE == 4 || MODE == 5), HAS_ADD = (MODE == 2);
        f16x8 mvb[2][4][2];
        if (MODE == 5 && EPI5_ONE) {
#pragma unroll
            for (int ai = 0; ai < 2; ++ai)
#pragma unroll
                for (int m = 0; m < 4; ++m)
#pragma unroll
                    for (int bj = 0; bj < 2; ++bj) mvb[ai][m][bj] = GATE_FRAG ? *(const f16x8*)(fragb(u, wr, wc, fr, fq) + (size_t)T * 1024 + bj * 32768 + (ai * 4 + m) * 512)
                                                                          : *(const f16x8*)(mul + (size_t)(row0 + ai * 128 + m * 16) * ldm + mulcol + col0 + bj * 128); }
#pragma unroll
        for (int ai = 0; ai < 2; ++ai) {
            f16x8 mv[4][2], av[4][2];
#pragma unroll
            for (int m = 0; m < 4; ++m)
#pragma unroll
                for (int bj = 0; bj < 2; ++bj) { const int row = row0 + ai * 128 + m * 16, col = col0 + bj * 128;
                    if (HAS_MUL) { if (MODE == 5 && EPI5_ONE) mv[m][bj] = mvb[ai][m][bj]; else mv[m][bj] = *(const f16x8*)(mul + (size_t)row * ldm + mulcol + col); }
                    if (HAS_ADD) av[m][bj] = *(const f16x8*)(add + (size_t)row * 1024 + col); }
#pragma unroll
            for (int m = 0; m < 4; ++m) {
                const int row = row0 + ai * 128 + m * 16; float ss = 0.f;
#pragma unroll
                for (int bj = 0; bj < 2; ++bj) {
                    const int col = col0 + bj * 128; f32x4 v0 = acc[ai][bj][m][0], v1 = acc[ai][bj][m][1];
                    if (MODE == 4) {
#pragma unroll
                        for (int e = 0; e < 4; ++e) { v0[e] = W_PRESCALE == 1.f ? sigmoidf_(v0[e]) : gate_t(v0[e]); v1[e] = W_PRESCALE == 1.f ? sigmoidf_(v1[e]) : gate_t(v1[e]); } }
                    if (HAS_MUL) {
#pragma unroll
                        for (int e = 0; e < 4; ++e) { v0[e] *= (MODE == 5 && !GATE_RATIO) ? fmaxf((float)mv[m][bj][e], MB_MIN) : (float)mv[m][bj][e]; v1[e] *= (MODE == 5 && !GATE_RATIO) ? fmaxf((float)mv[m][bj][4 + e], MB_MIN) : (float)mv[m][bj][4 + e];        } }
                    if (HAS_ADD) {
#pragma unroll
                        for (int e = 0; e < 4; ++e) { v0[e] += (float)av[m][bj][e]; v1[e] += (float)av[m][bj][4 + e]; } }
                    if (MODE == 3 || MODE == 4) {
#pragma unroll
                        for (int e = 0; e < 4; ++e) ss += v0[e] * v0[e] + v1[e] * v1[e]; }
                    EPI_ST((f16x8*)(dst + (size_t)(row + srow) * 1024 + col + scol), epi_tr(pack8(v0, v1), src4));
                }
                if (MODE == 3 || MODE == 4) { ss += __shfl_xor(ss, 16); ss += __shfl_xor(ss, 32); if (fq == 0) atomicAdd(rowsq + row, ss); }
            }
            if (HAS_MUL) asm volatile("" ::: "memory");
        }
    }
};
__device__ __forceinline__ void ph_merged(const Params& P, LAS unsigned char* lds, int G, int c) {
    unsigned char* ws = P.ws; pg8::StaticOrder So; So.init(T, D, G, c);
#if FUSE_AB
    { pg8::Gemm g{U_A(ws), (const f16*)(ws + WS_WBA), U_LD, 512, 1024, U_B(ws), (const f16*)(ws + WS_WBB)}; EpiGen<5> E{(f16*)(ws + WS_MERGED), (const f16*)(ws + WS_MG), 2048, 1024, nullptr, nullptr};
      pg8::gemm_phase<EpiGen<5>, true>(lds, g, So, E); }
#else
    { pg8::Gemm g{U_A(ws), (const f16*)(ws + WS_WBA), U_LD, 512, 512}; EpiGen<1> E{(f16*)(ws + WS_MERGED), (const f16*)(ws + WS_MG), 2048, 0, nullptr, nullptr}; pg8::gemm_phase(lds, g, So, E); }
    { pg8::Gemm g{U_B(ws), (const f16*)(ws + WS_WBB), U_LD, 512, 512}; EpiGen<2> E{(f16*)(ws + WS_MERGED), (const f16*)(ws + WS_MG), 2048, 1024, (const f16*)(ws + WS_MERGED), nullptr}; pg8::gemm_phase(lds, g, So, E); }
#endif
}
__device__ __forceinline__ void ph_out(const Params& P, LAS unsigned char* lds, int G, int c, int rsq_off = 0) {
    unsigned char* ws = P.ws; pg8::StaticOrder So; So.init(T, D, G, c);
    pg8::Gemm g{(const f16*)(ws + WS_MERGED), (const f16*)(ws + WS_WO), 1024, 1024, 1024}; EpiGen<3> E{(f16*)(ws + WS_OUT16), nullptr, 0, 0, nullptr, (float*)(ws + WS_ROWSQ) + rsq_off}; pg8::gemm_phase(lds, g, So, E);
}
__device__ __forceinline__ void ph_gate(const Params& P, LAS unsigned char* lds, int G, int c, int rsq_off = T) {
    unsigned char* ws = P.ws; pg8::StaticOrder So; So.init(T, D, G, c);
    { pg8::Gemm g{(const f16*)(ws + WS_P16), (const f16*)(ws + WS_WPLE), DPLE, DPLE, DPLE}; EpiGen<0> E{(f16*)(ws + WS_E16), nullptr, 0, 0, nullptr, nullptr}; pg8::gemm_phase(lds, g, So, E); }
    { pg8::Gemm g{(const f16*)(ws + WS_X116), (const f16*)(ws + WS_WPG), 1024, 1024, 1024}; EpiGen<4> E{(f16*)(ws + WS_V16), (const f16*)(ws + WS_E16), 1024, 0, nullptr, (float*)(ws + WS_ROWSQ) + rsq_off}; pg8::gemm_phase(lds, g, So, E); }
}
__global__ void __launch_bounds__(512, 2) k_merged(Params P) { extern __shared__ __attribute__((aligned(16))) unsigned char lds[]; ph_merged(P, (LAS unsigned char*)lds, gridDim.x, blockIdx.x); }
__global__ void __launch_bounds__(512, 2) k_out(Params P) { extern __shared__ __attribute__((aligned(16))) unsigned char lds[]; ph_out(P, (LAS unsigned char*)lds, gridDim.x, blockIdx.x); }
__global__ void __launch_bounds__(512, 2) k_gate(Params P) { extern __shared__ __attribute__((aligned(16))) unsigned char lds[]; ph_gate(P, (LAS unsigned char*)lds, gridDim.x, blockIdx.x); }


namespace att {
typedef short s16x4 __attribute__((ext_vector_type(4)));
typedef short s16x8 __attribute__((ext_vector_type(8)));
constexpr int NW = 8, QBLK = 32, KVBLK = 64, NSLOT = 3, SLOTB = 8192;
constexpr int LDS_K = 0, LDS_V = NSLOT * SLOTB, LDS_WS = 2 * NSLOT * SLOTB, LDS_OST = LDS_WS + NW * 64 * 4, LDS_AUX = LDS_OST + NW * 4096, LDS_PK = LDS_AUX + 8192, LDS_BYTES = LDS_PK + 8192;
__device__ __forceinline__ int crow(int r, int hi) { return (r & 3) + 8 * (r >> 2) + 4 * hi; }
#define SBAR() __builtin_amdgcn_sched_barrier(0)
__device__ __forceinline__ void glds16(const void* gsrc, unsigned lds_dst) { unsigned keep;
    asm volatile("s_mov_b32 %0, m0\n\ts_mov_b32 m0, %2\n\ts_nop 0\n\tglobal_load_lds_dwordx4 %1, off\n\ts_mov_b32 m0, %0" : "=&s"(keep) : "v"(gsrc), "s"(lds_dst) : "memory"); }
__device__ __forceinline__ float max3f(float a, float b, float c) { float r; asm("v_max3_f32 %0, %1, %2, %3" : "=v"(r) : "v"(a), "v"(b), "v"(c)); return r; }
__device__ __forceinline__ float max2f(float a, float b) { float r; asm("v_max_f32_e32 %0, %1, %2" : "=v"(r) : "v"(a), "v"(b)); return r; }
__device__ __forceinline__ float fadd_s(float a, float b) { float r; asm("v_add_f32_e32 %0, %1, %2" : "=v"(r) : "v"(a), "v"(b)); return r; }
__device__ __forceinline__ float fsub_s(float a, float b) { float r; asm("v_sub_f32_e32 %0, %1, %2" : "=v"(r) : "v"(a), "v"(b)); return r; }
__device__ __forceinline__ unsigned cvtpk_s(float lo, float hi) { return __builtin_bit_cast(unsigned, __builtin_amdgcn_cvt_pkrtz(lo, hi)); }
#define WAIT_BAR(N) asm volatile("s_waitcnt vmcnt(" #N ") lgkmcnt(0)\n\ts_barrier" ::: "memory")
typedef LAS const char* lds_cptr;
typedef short v4i16_t __attribute__((ext_vector_type(4)));
__device__ __forceinline__ void kload8(f16x8* kf, lds_cptr kp) {
    kf[0] = *(const LAS f16x8*)(kp);        kf[1] = *(const LAS f16x8*)(kp + 512);
    kf[2] = *(const LAS f16x8*)(kp + 2048); kf[3] = *(const LAS f16x8*)(kp + 2560);
    kf[4] = *(const LAS f16x8*)(kp + 4096); kf[5] = *(const LAS f16x8*)(kp + 4608);
    kf[6] = *(const LAS f16x8*)(kp + 6144); kf[7] = *(const LAS f16x8*)(kp + 6656);
}
__device__ __forceinline__ void kload2(f16x8* kf, lds_cptr kp, int j) { kf[2 * j] = *(const LAS f16x8*)(kp + j * 2048); kf[2 * j + 1] = *(const LAS f16x8*)(kp + j * 2048 + 512); }
__device__ __forceinline__ s16x4 vtr(lds_cptr p) { return __builtin_bit_cast(s16x4, __builtin_amdgcn_ds_read_tr16_b64_v4i16((LAS v4i16_t*)p)); }
__device__ __forceinline__ float rowmax(const f32x16& p0, const f32x16& p1) {
    float a = max3f(p0[0], p0[1], p1[0]), b = max3f(p0[2], p0[3], p1[1]); a = max3f(a, p1[2], p1[3]);
#pragma unroll
    for (int r = 4; r < 16; r += 4) { a = max3f(a, p0[r], p0[r + 1]); b = max3f(b, p0[r + 2], p0[r + 3]); a = max3f(a, p1[r], p1[r + 1]); b = max3f(b, p1[r + 2], p1[r + 3]); }
    const float m = max2f(a, b);
    auto rr = __builtin_amdgcn_permlane32_swap(__float_as_uint(m), __float_as_uint(m), false, false);
    return max2f(__uint_as_float(rr[0]), __uint_as_float(rr[1]));
}
#define MFMA32(a, b, c) __builtin_amdgcn_mfma_f32_32x32x16_f16((a), (b), (c), 0, 0, 0)
__device__ __forceinline__ void cmask(f32x16& p0, f32x16& p1, int jb, int qrel, int hi) {
    const float NEG = -INFINITY; const int kb = 64 * jb + 4 * hi;
#pragma unroll
    for (int r = 0; r < 16; ++r) { const int kv = kb + (r & 3) + 8 * (r >> 2); if (kv > qrel) p0[r] = NEG; if (kv + 32 > qrel) p1[r] = NEG; }
}
__device__ __forceinline__ void pv(f32x16* o, int vb, f16x8 pa0, f16x8 pa1, f16x8 pa2, f16x8 pa3) {
#pragma unroll
    for (int d0 = 0; d0 < 2; ++d0) { s16x4 lo[4], hi[4];
#pragma unroll
        for (int ks = 0; ks < 4; ++ks) {
            asm volatile("ds_read_b64_tr_b16 %0,%1 offset:%c2" : "=&v"(lo[ks]) : "v"(vb), "i"(d0 * 4096 + ks * 1024) : "memory");
            asm volatile("ds_read_b64_tr_b16 %0,%1 offset:%c2" : "=&v"(hi[ks]) : "v"(vb), "i"(d0 * 4096 + ks * 1024 + 512) : "memory"); }
        asm volatile("s_waitcnt lgkmcnt(0)" ::: "memory"); SBAR();
#define PK(k) __builtin_bit_cast(f16x8, (s16x8){lo[k][0], lo[k][1], lo[k][2], lo[k][3], hi[k][0], hi[k][1], hi[k][2], hi[k][3]})
        o[d0] = MFMA32(pa0, PK(0), o[d0]); o[d0] = MFMA32(pa1, PK(1), o[d0]); o[d0] = MFMA32(pa2, PK(2), o[d0]); o[d0] = MFMA32(pa3, PK(3), o[d0]);
#undef PK
    }
}
__device__ __forceinline__ void prefetch_kv(const f16* Kh, const f16* Vh, const int KP, char* shm) {
    int tid = threadIdx.x; asm volatile("" : "+v"(tid));
    const int lane = tid & 63; const int wid = __builtin_amdgcn_readfirstlane(tid >> 6);
    const unsigned lds0 = (unsigned)(uintptr_t)shm;
    const f16* ksrc = Kh + (long)lane * KP + wid * 8;
    const f16* vsrc = Vh + (long)(16 * (wid & 3) + (lane >> 2)) * KP + (wid >> 2) * 32 + (lane & 3) * 8;
    const unsigned kdst = lds0 + LDS_K + wid * 1024, vdst = lds0 + LDS_V + wid * 1024;
    glds16(ksrc, (unsigned)__builtin_amdgcn_readfirstlane(kdst)); glds16(vsrc, (unsigned)__builtin_amdgcn_readfirstlane(vdst));
    glds16(ksrc + (long)KVBLK * KP, (unsigned)__builtin_amdgcn_readfirstlane(kdst + SLOTB)); glds16(ksrc + 2l * KVBLK * KP, (unsigned)__builtin_amdgcn_readfirstlane(kdst + 2 * SLOTB));
}
template <int MODE, int THRL, bool PRE = false> __device__ __forceinline__ void attn_unit(const f16* Qw, const f16* __restrict__ Kh, const f16* __restrict__ Vh, const int KP, const int NT, const int qrel0, const float ct2,
                                                                          f16* Uw, const f16* SGw, char* shm) {
    int tid = threadIdx.x; asm volatile("" : "+v"(tid));
    const int lane = tid & 63, r32 = lane & 31, hi = lane >> 5; const int wid = __builtin_amdgcn_readfirstlane(tid >> 6);
    const unsigned lds0 = (unsigned)(uintptr_t)shm;
    float* wsf = (float*)(shm + LDS_WS) + wid * 64;
    const f16* ksrc = Kh + (long)lane * KP + wid * 8;
    const f16* vsrc = Vh + (long)(16 * (wid & 3) + (lane >> 2)) * KP + (wid >> 2) * 32 + (lane & 3) * 8;
    const unsigned kdst = lds0 + LDS_K + wid * 1024, vdst = lds0 + LDS_V + wid * 1024;
#define DMA_K(t, slot) glds16(ksrc + (long)(t) * KVBLK * KP, (unsigned)__builtin_amdgcn_readfirstlane(kdst + (slot)))
#define DMA_V(t, slot) glds16(vsrc + (long)(t) * KVBLK * KP, (unsigned)__builtin_amdgcn_readfirstlane(vdst + (slot)))
    const int vb0 = (int)(lds0 + LDS_V) + ((lane >> 4) & 1) * 32 + (lane & 3) * 8 + (4 * hi + ((lane & 15) >> 2)) * 64;
    f16x8 kf[8];
    const lds_cptr shm3 = (lds_cptr)shm; const lds_cptr kp0 = shm3 + LDS_K + hi * 1024 + r32 * 16; const lds_cptr vp0 = shm3 + LDS_V + ((lane >> 4) & 1) * 32 + (lane & 3) * 8 + (4 * hi + ((lane & 15) >> 2)) * 64;
    const LAS float* cs2 = (const LAS float*)(shm3 + LDS_AUX) + 4 * hi;
    const LAS u64* mwp = (const LAS u64*)(shm3 + LDS_AUX) + r32;
    const LAS unsigned* pkp = (const LAS unsigned*)(shm3 + LDS_PK) + r32;
    const unsigned one_w = hi ? 0u : 0x3C003C00u, himask = hi ? 0u : 0xFFFFFFFFu;
    u32x4 qxw = (u32x4){0u, one_w, 0u, 0u};
#define QX_BUILD() do { if (MODE == 0) { const f16 bh_ = (f16)base; const f16 bl_ = (f16)(base - (float)bh_); \
        qxw[0] = ((unsigned)__builtin_bit_cast(unsigned short, bh_) | ((unsigned)__builtin_bit_cast(unsigned short, bl_) << 16)) & himask; } } while (0)
    if (!PRE) { DMA_K(0, 0); DMA_V(0, 0); DMA_K(1, SLOTB); }
    f16x8 qr[4];
#pragma unroll
    for (int d0 = 0; d0 < 4; ++d0) qr[d0] = *reinterpret_cast<const f16x8*>(&Qw[(long)r32 * 512 + d0 * 16 + hi * 8]);
    float mhat = 0.f, l_reg = 0.f; f32x16 o[2]; o[0] = f32x16{}; o[1] = f32x16{};
    float base = (MODE == 0) ? ct2 : 0.f;
    const int qrel = qrel0 + r32;
#define INITH(C, t, HOFF, WSH) do { if (MODE == 0) { const unsigned p_ = pkp[64 * (t) + (HOFF)] & himask; const u32x4 kx_ = (u32x4){one_w, p_, 0u, 0u}; \
        C = MFMA32(__builtin_bit_cast(f16x8, kx_), __builtin_bit_cast(f16x8, qxw), f32x16{}); } \
      else { const u64 w_ = mwp[32 * (t)]; const unsigned w0_ = (unsigned)(w_ >> ((WSH) + 4 * hi)); const unsigned nb_ = __float_as_uint(base), ng_ = __float_as_uint(-1e30f); \
        _Pragma("unroll") for (int r_ = 0; r_ < 16; ++r_) { const int cb_ = (r_ & 3) + 8 * (r_ >> 2); const unsigned t0_ = (unsigned)__builtin_amdgcn_sbfe((int)w0_, cb_, 1); \
            C[r_] = __uint_as_float((t0_ & nb_) | (~t0_ & ng_)); } } } while (0)
#define INIT(C0, C1, t) do { INITH(C0, t, 0, 0); INITH(C1, t, 32, 32); } while (0)
#define CMASK(P0, P1, t) do { if (MODE == 0) { int jb_ = (t) - (NT - 4); if (jb_ >= 0) cmask(P0, P1, jb_, qrel, hi); } } while (0)
    QX_BUILD();
    bool resc = false;
#define START(P0, P1) do { const float rm = rowmax(P0, P1); resc = false; \
    { const float dl = (MODE == 0) ? rm : __builtin_fmaxf(rm, -1000.f); mhat = fadd_s(mhat, dl); base = fsub_s(base, dl); QX_BUILD(); \
      _Pragma("unroll") for (int r = 0; r < 16; ++r) { P0[r] = fsub_s(P0[r], dl); P1[r] = fsub_s(P1[r], dl); } } \
    _Pragma("unroll") for (int r = 0; r < 16; ++r) P0[r] = __builtin_amdgcn_exp2f(P0[r]); } while (0)
#define RESC() do { if (resc) { asm volatile("s_waitcnt lgkmcnt(0)" ::: "memory"); \
      _Pragma("unroll") for (int d_ = 0; d_ < 2; ++d_) _Pragma("unroll") for (int r = 0; r < 16; ++r) o[d_][r] *= wsf[crow(r, hi)]; } } while (0)
    f32x16 pA0, pA1, pB0, pB1;
    int sl_prev = 0, sl_cur = 0, sl_next = SLOTB;
#define ROT() do { sl_prev = sl_cur; sl_cur = sl_next; sl_next = (sl_next == (NSLOT - 1) * SLOTB) ? 0 : sl_next + SLOTB; } while (0)
    if (!PRE) DMA_K(2, 2 * SLOTB);
    WAIT_BAR(3);
    INIT(pA0, pA1, 0);
    { const char* kb = shm + LDS_K + hi * 1024 + r32 * 16;
#pragma unroll
      for (int d0 = 0; d0 < 4; ++d0) { const f16x8 b0 = *reinterpret_cast<const f16x8*>(kb + d0 * 2048); const f16x8 b1 = *reinterpret_cast<const f16x8*>(kb + d0 * 2048 + 512);
          pA0 = MFMA32(b0, qr[d0], pA0); pA1 = MFMA32(b1, qr[d0], pA1); } }
    asm volatile("s_nop 15\n\ts_nop 7" : "+v"(pA0), "+v"(pA1)); CMASK(pA0, pA1, 0);
    START(pA0, pA1);
#pragma unroll
    for (int r = 0; r < 16; ++r) pA1[r] = __builtin_amdgcn_exp2f(pA1[r]);
    WAIT_BAR(0);
    DMA_K(3, 0); DMA_V(1, SLOTB);
    ROT();
    kload8(kf, kp0 + sl_cur);
    WAIT_BAR(2);
    s16x4 vlo[8], vhi[8]; u32x4 pw0, pw1, pw2, pw3;
#define PKW(P, B) cvtpk_s(P[B], P[B + 1])
#define PAF(k) __builtin_bit_cast(f16x8, pw##k)
#define VFR(i) __builtin_bit_cast(f16x8, (s16x8){vlo[i][0], vlo[i][1], vlo[i][2], vlo[i][3], vhi[i][0], vhi[i][1], vhi[i][2], vhi[i][3]})
#define PIN(x) asm volatile("" : "+v"(x))
#define MX3(a, b, c) __builtin_fmaxf(__builtin_fmaxf((a), (b)), (c))
#define GAPA(MF, A0, A1, A2, A3, W0, W1, PW) do { MF; sacc += A0; sacc += A1; sacc += A2; sacc += A3; PIN(sacc); W0; W1; PIN(PW); SBAR(); } while (0)
#define EX(v) __builtin_amdgcn_exp2f(v)
#define GAPB(MF, X, B) do { MF; X[B] = EX(X[B]); X[B + 1] = EX(X[B + 1]); X[B + 2] = EX(X[B + 2]); X[B + 3] = EX(X[B + 3]); PIN(X); SBAR(); } while (0)
#define VRD(i) do { vlo[i] = vtr(vp_ + (((i) >> 2) * 4096 + ((i) & 3) * 1024)); vhi[i] = vtr(vp_ + (((i) >> 2) * 4096 + ((i) & 3) * 1024 + 512)); } while (0)
#define KRD(G, j) do { if (G) { kload2(kf, kp0 + sl_next, j); SBAR(); } } while (0)
#define STEP(C0, C1, P0, P1, t, GK, GV, GL) do { SBAR(); \
    const lds_cptr vp_ = vp0 + sl_prev; \
    INITH(C0, t, 0, 0); \
    VRD(0); SBAR(); float sacc = (P0[0] + P0[1]); \
    GAPA(C0 = MFMA32(kf[0], qr[0], C0), P0[2], P0[3], P0[4], P0[5],     pw0[0] = PKW(P0, 0), pw0[1] = PKW(P0, 2), pw0); \
    INITH(C1, t, 32, 32); \
    VRD(4); SBAR(); GAPA(C1 = MFMA32(kf[1], qr[0], C1), P0[6], P0[7], P0[8], P0[9],     pw0[2] = PKW(P0, 4), pw0[3] = PKW(P0, 6), pw0); \
    VRD(1); SBAR(); GAPA(C0 = MFMA32(kf[2], qr[1], C0),   P0[10], P0[11], P0[12], P0[13], pw1[0] = PKW(P0, 8), pw1[1] = PKW(P0, 10), pw1); \
    VRD(5); SBAR(); GAPA(C1 = MFMA32(kf[3], qr[1], C1),   P0[14], P0[15], P1[0], P1[1],   pw1[2] = PKW(P0, 12), pw1[3] = PKW(P0, 14), pw1); \
    VRD(2); SBAR(); GAPA(C0 = MFMA32(kf[4], qr[2], C0),   P1[2], P1[3], P1[4], P1[5],     pw2[0] = PKW(P1, 0), pw2[1] = PKW(P1, 2), pw2); \
    VRD(6); SBAR(); GAPA(C1 = MFMA32(kf[5], qr[2], C1),   P1[6], P1[7], P1[8], P1[9],     pw2[2] = PKW(P1, 4), pw2[3] = PKW(P1, 6), pw2); \
    VRD(3); SBAR(); GAPA(C0 = MFMA32(kf[6], qr[3], C0),   P1[10], P1[11], P1[12], P1[13], pw3[0] = PKW(P1, 8), pw3[1] = PKW(P1, 10), pw3); \
    VRD(7); SBAR(); GAPA(C1 = MFMA32(kf[7], qr[3], C1),   P1[14], P1[15], 0.f, 0.f,       pw3[2] = PKW(P1, 12), pw3[3] = PKW(P1, 14), pw3); \
    l_reg += sacc; \
    if (GK) { DMA_K((t) + 3, sl_cur); } if (GV) { DMA_V((t) + 1, sl_next); } \
    CMASK(C0, C1, t); \
    { float a = MX3(C0[0], C0[1], C1[0]), b = MX3(C0[2], C0[3], C1[1]); a = MX3(a, C1[2], C1[3]); \
      _Pragma("unroll") for (int r = 4; r < 16; r += 4) { a = MX3(a, C0[r], C0[r + 1]); b = MX3(b, C0[r + 2], C0[r + 3]); a = MX3(a, C1[r], C1[r + 1]); b = MX3(b, C1[r + 2], C1[r + 3]); } \
      float rm = __builtin_fmaxf(a, b); { auto rr = __builtin_amdgcn_permlane32_swap(__float_as_uint(rm), __float_as_uint(rm), false, false); rm = __builtin_fmaxf(__uint_as_float(rr[0]), __uint_as_float(rr[1])); } \
      resc = false; \
      if (__builtin_expect(__any(rm > (float)THRL), 0)) { const float dl = __builtin_fmaxf(rm, 0.f); mhat += dl; base -= dl; QX_BUILD(); \
        _Pragma("unroll") for (int r = 0; r < 16; ++r) { C0[r] -= dl; C1[r] -= dl; } \
        const float f = __builtin_amdgcn_exp2f(-dl); l_reg *= f; if (hi == 0) wsf[r32] = f; resc = true; } } \
    SBAR(); \
    GAPB(o[0] = MFMA32(PAF(0), VFR(0), o[0]), C0, 0); \
    GAPB(o[1] = MFMA32(PAF(0), VFR(4), o[1]), C0, 4); \
    KRD(GL, 0); GAPB(o[0] = MFMA32(PAF(1), VFR(1), o[0]), C0, 8); \
    KRD(GL, 1); GAPB(o[1] = MFMA32(PAF(1), VFR(5), o[1]), C0, 12); \
    KRD(GL, 2); GAPB(o[0] = MFMA32(PAF(2), VFR(2), o[0]), C1, 0); \
    KRD(GL, 3); GAPB(o[1] = MFMA32(PAF(2), VFR(6), o[1]), C1, 4); \
    GAPB(o[0] = MFMA32(PAF(3), VFR(3), o[0]), C1, 8); \
    GAPB(o[1] = MFMA32(PAF(3), VFR(7), o[1]), C1, 12); \
    } while (0)
    int t = 1;
#define ENDW(tt) do { if ((tt) + 3 < NT) { WAIT_BAR(2); } else if ((tt) + 2 < NT) { WAIT_BAR(1); } else { WAIT_BAR(0); } } while (0)
#undef CMASK
#define CMASK(P0, P1, t) do { } while (0)
    for (; t + 5 < NT; t += 2) {
        STEP(pB0, pB1, pA0, pA1, t, true, true, true);     WAIT_BAR(2); RESC(); ROT();
        STEP(pA0, pA1, pB0, pB1, t + 1, true, true, true); WAIT_BAR(2); RESC(); ROT();
    }
#undef CMASK
#define CMASK(P0, P1, t) do { if (MODE == 0) { int jb_ = (t) - (NT - 4); if (jb_ >= 0) cmask(P0, P1, jb_, qrel, hi); } } while (0)
    for (; t + 1 < NT; t += 2) {
        STEP(pB0, pB1, pA0, pA1, t, (t + 3 < NT), (t + 1 < NT), (t + 1 < NT));         ENDW(t);     RESC(); ROT();
        STEP(pA0, pA1, pB0, pB1, t + 1, (t + 4 < NT), (t + 2 < NT), (t + 2 < NT));     ENDW(t + 1); RESC(); ROT();
    }
    STEP(pB0, pB1, pA0, pA1, NT - 1, false, false, false); RESC();
#if GATE_PF
    f16x8 gpf[4];
#pragma unroll
    for (int i = 0; i < 4; ++i) gpf[i] = *(const f16x8*)(SGw + (long)(i * 8 + (lane >> 3)) * 512 + (lane & 7) * 8);
#endif
    { float sacc = pB0[0] + pB0[1];
#pragma unroll
      for (int r = 2; r < 16; ++r) sacc += pB0[r];
#pragma unroll
      for (int r = 0; r < 16; ++r) sacc += pB1[r];
      l_reg += sacc;
      pw0 = (u32x4){PKW(pB0, 0), PKW(pB0, 2), PKW(pB0, 4), PKW(pB0, 6)}; pw1 = (u32x4){PKW(pB0, 8), PKW(pB0, 10), PKW(pB0, 12), PKW(pB0, 14)};
      pw2 = (u32x4){PKW(pB1, 0), PKW(pB1, 2), PKW(pB1, 4), PKW(pB1, 6)}; pw3 = (u32x4){PKW(pB1, 8), PKW(pB1, 10), PKW(pB1, 12), PKW(pB1, 14)};
      SBAR(); pv(o, vb0 + sl_cur, PAF(0), PAF(1), PAF(2), PAF(3)); }
#undef PKW
#undef PAF
#undef VFR
#undef PIN
#undef MX3
#undef GAPA
#undef GAPB
#undef EX
#undef VRD
#undef KRD
#undef STEP
#undef ENDW
    { auto rr = __builtin_amdgcn_permlane32_swap(__float_as_uint(l_reg), __float_as_uint(l_reg), false, false); l_reg = __uint_as_float(rr[0]) + __uint_as_float(rr[1]); }
    if (hi == 0) wsf[32 + r32] = l_reg; asm volatile("s_waitcnt lgkmcnt(0)" ::: "memory");
    float rli[16];
#pragma unroll
    for (int r = 0; r < 16; ++r) rli[r] = __builtin_amdgcn_rcpf(wsf[32 + crow(r, hi)]);
    { f16* stg = (f16*)(shm + LDS_OST) + wid * 2048;
#pragma unroll
      for (int r = 0; r < 16; ++r) { const int orow = crow(r, hi);
#pragma unroll
          for (int d0 = 0; d0 < 2; ++d0) stg[orow * 64 + d0 * 32 + r32] = (f16)(o[d0][r] * rli[r]); }
      asm volatile("s_waitcnt lgkmcnt(0)" ::: "memory");
#pragma unroll
      for (int i = 0; i < 4; ++i) { const int row = i * 8 + (lane >> 3), ch = lane & 7; const f16x8 v = *(const f16x8*)(stg + row * 64 + ch * 8);
#if GATE_PF
          const f16x8 g = gpf[i];
#else
          const f16x8 g = *(const f16x8*)(SGw + (long)row * 512 + ch * 8);
#endif

          *(f16x8*)(Uw + (long)row * U_LD + ch * 8) = v * g; } }
    asm volatile("s_waitcnt lgkmcnt(0)\n\ts_barrier" ::: "memory");
#undef DMA_K
#undef DMA_V
#undef CMASK
#undef INIT
#undef INITH
#undef QX_BUILD
#undef START
#undef RESC
#undef ROT
}
#undef SBAR
#undef WAIT_BAR
#undef MFMA32
}

__device__ __forceinline__ void ph_fox(const Params& P, char* shm, int vcu, int G) {
    unsigned char* ws = P.ws; const int tid = threadIdx.x, lane = tid & 63, wid = tid >> 6;
    for (int bh = vcu; bh < NB * 8; bh += G) {
        const int b = bh >> 3, h = bh & 7;
        float* cs = (float*)(shm + att::LDS_AUX); float* wtot = (float*)(shm + att::LDS_WS);
        { int t2 = threadIdx.x; asm volatile("" : "+v"(t2));
          const int lane2 = t2 & 63, wid2 = t2 >> 6;
          const float* lf = (const float*)(ws + WS_LOGF) + ((size_t)b * S + t2 * 4) * 8 + h;
          float v0 = lf[0], v1 = v0 + lf[8], v2 = v1 + lf[16], v3 = v2 + lf[24]; float inc = v3;
#pragma unroll
          for (int o = 1; o < 64; o <<= 1) { const float n = __shfl_up(inc, o); if (lane2 >= o) inc += n; }
          if (lane2 == 63) wtot[wid2] = inc;
          __syncthreads();
          float off = inc - v3; for (int w = 0; w < wid2; ++w) off += wtot[w];
          const f32x4 c4 = (f32x4){(v0 + off) * LOG2E, (v1 + off) * LOG2E, (v2 + off) * LOG2E, (v3 + off) * LOG2E};
          *(f32x4*)(cs + t2 * 4) = c4;
          { u32x4 pw;
#pragma unroll
            for (int e = 0; e < 4; ++e) { const float a = -c4[e]; const f16 ah = (f16)a; const f16 al = (f16)(a - (float)ah);
                pw[e] = (unsigned)__builtin_bit_cast(unsigned short, ah) | ((unsigned)__builtin_bit_cast(unsigned short, al) << 16); }
            *(u32x4*)((unsigned*)(shm + att::LDS_PK) + t2 * 4) = pw; }
          __syncthreads(); }
        const size_t rowbase = (size_t)b * S;
        for (int qi = 0; qi < 8; ++qi) { const int qb = 7 - qi; const int q0 = qb * 256;
            const size_t tok = rowbase + q0 + wid * 32;
            const float ct2 = cs[q0 + wid * 32 + (lane & 31)];
            att::attn_unit<0, 8>((const f16*)(ws + WS_QB) + tok * 512 + h * 64, (const f16*)(ws + WS_KB) + rowbase * 512 + h * 64, (const f16*)(ws + WS_VB) + rowbase * 512 + h * 64, 512, 4 * qb + 4, wid * 32, ct2,
                                 U_B(ws) + tok * U_LD + h * 64, (const f16*)(ws + WS_SGB) + tok * 512 + h * 64, shm); }
        __syncthreads();
    }
}
__device__ __forceinline__ void ph_dsa_attn(const Params& P, char* shm, int vcu, int G) {
    unsigned char* ws = P.ws; const int tid = threadIdx.x, wid = tid >> 6;
    for (int it = vcu; it < NB * 8; it += G) {
        const int b = it >> 3, j = it & 7; const size_t rowbase = (size_t)b * S;
        for (int k = 0; k < 8; ++k) { const int qt = (k & 1) ? (16 * (k >> 1) + 15 - j) : (16 * (k >> 1) + j);
            const int nt = qt / 2 + 1, NT = nt < 4 ? 4 : nt + (nt & 1);
            { const u32x4* src = (const u32x4*)((const u64*)(ws + WS_MASK) + ((size_t)b * 64 + qt) * 32 * 32); u32x4* dst = (u32x4*)(shm + att::LDS_AUX);
              if (tid < NT * 16) dst[tid] = src[tid]; }
            __syncthreads();
            const size_t tok = rowbase + qt * 32;
            att::attn_unit<1, 8>((const f16*)(ws + WS_QA) + tok * 512 + wid * 64, (const f16*)(ws + WS_KA) + rowbase * 64, (const f16*)(ws + WS_VA) + rowbase * 64, 64, NT, 0, 0.f,
                                 (f16*)(ws + WS_U) + tok * 1024 + wid * 64, (const f16*)(ws + WS_SGA) + tok * 512 + wid * 64, shm); }
    }
}

namespace idx {
constexpr int BUFB = 32768;
__device__ __forceinline__ int half_sum(int v) {
    v += __builtin_amdgcn_update_dpp(0, v, 0xB1, 0xF, 0xF, false);
    v += __builtin_amdgcn_update_dpp(0, v, 0x4E, 0xF, 0xF, false);
    v += __builtin_amdgcn_update_dpp(0, v, 0x141, 0xF, 0xF, false);
    v += __builtin_amdgcn_update_dpp(0, v, 0x140, 0xF, 0xF, false);
    v += __shfl_xor(v, 16);
    return v;
}
__device__ __forceinline__ float fmax_(float a, float b) { float r; asm("v_max_f32_e32 %0, %1, %2" : "=v"(r) : "v"(a), "v"(b)); return r; }
__device__ __forceinline__ float amax_(float a, float b) { float r; asm("v_max_f32_e64 %0, %1, |%2|" : "=v"(r) : "v"(a), "v"(b)); return r; }
__device__ __forceinline__ float fmin_(float a, float b) { float r; asm("v_min_f32_e32 %0, %1, %2" : "=v"(r) : "v"(a), "v"(b)); return r; }
__device__ __forceinline__ float dppf(float v, const int ctrl_sel) {
    const int x = __float_as_int(v);
    const int y = ctrl_sel == 0 ? __builtin_amdgcn_update_dpp(0, x, 0xB1, 0xF, 0xF, false) : ctrl_sel == 1 ? __builtin_amdgcn_update_dpp(0, x, 0x4E, 0xF, 0xF, false)
                : ctrl_sel == 2 ? __builtin_amdgcn_update_dpp(0, x, 0x141, 0xF, 0xF, false) : __builtin_amdgcn_update_dpp(0, x, 0x140, 0xF, 0xF, false);
    return __int_as_float(y);
}
__device__ __forceinline__ float half_max(float v) { v = fmax_(v, dppf(v, 0)); v = fmax_(v, dppf(v, 1)); v = fmax_(v, dppf(v, 2)); v = fmax_(v, dppf(v, 3)); return fmax_(v, __shfl_xor(v, 16)); }
__device__ __forceinline__ float half_min(float v) { v = fmin_(v, dppf(v, 0)); v = fmin_(v, dppf(v, 1)); v = fmin_(v, dppf(v, 2)); v = fmin_(v, dppf(v, 3)); return fmin_(v, __shfl_xor(v, 16)); }
constexpr float CNT_BIG = 18446744073709551616.0f;
__device__ __forceinline__ void cntp4(f32x2& acc, f32x2 big2, f32x2 nb2, f32x2 a0, f32x2 a1, f32x2 a2, f32x2 a3) {
    f32x2 t0, t1, t2, t3;
    asm volatile(
        "v_pk_fma_f32 %1, %5, %9, %10 clamp\n\tv_pk_fma_f32 %2, %6, %9, %10 clamp\n\tv_pk_fma_f32 %3, %7, %9, %10 clamp\n\tv_pk_fma_f32 %4, %8, %9, %10 clamp\n\t"
        "v_pk_add_f32 %1, %1, %2\n\tv_pk_add_f32 %3, %3, %4\n\tv_pk_add_f32 %1, %1, %3\n\tv_pk_add_f32 %0, %0, %1"
        : "+v"(acc), "=&v"(t0), "=&v"(t1), "=&v"(t2), "=&v"(t3)
        : "v"(a0), "v"(a1), "v"(a2), "v"(a3), "v"(big2), "v"(nb2));
}
__device__ __forceinline__ float clampmul(float a, float b) { float r; asm("v_mul_f32_e64 %0, %1, %2 clamp" : "=v"(r) : "v"(a), "v"(b)); return r; }
__device__ __forceinline__ float half_sumf(float v) { v += dppf(v, 0); v += dppf(v, 1); v += dppf(v, 2); v += dppf(v, 3); return v + __shfl_xor(v, 16); }
#define CNTP4(acc, nb2, kp, B) cntp4(acc, big2, nb2, kp[B], kp[B + 1], kp[B + 2], kp[B + 3])
__device__ __forceinline__ void indexer_tile(const Params& P, char* shm, const int b, const int qt, const int NTA) {
    unsigned char* ws = P.ws;
    int tid = threadIdx.x; asm volatile("" : "+v"(tid));
    const int lane = tid & 63, c = lane & 31, g = lane >> 5; const int wid = __builtin_amdgcn_readfirstlane(tid >> 6);
    const size_t rowbase = (size_t)b * S; const int q0 = qt * 32; const int ntiles = qt + 1, nchunks = (ntiles + 7) >> 3;
    const unsigned lds0 = (unsigned)(uintptr_t)shm;
    const float NINF = -__builtin_inff(), PINF = __builtin_inff();
    const f16* kig = (const f16*)(ws + WS_KI) + rowbase * 64;
#define IDX_DMA(ch) do { _Pragma("unroll") for (int pp_ = 0; pp_ < 4; ++pp_) { const int p_ = wid + 8 * pp_; const int key_ = 8 * p_ + (lane >> 3); \
        att::glds16(kig + (size_t)((ch) * 256 + key_) * 64 + (((lane & 7) ^ ((key_ >> 1) & 7)) * 8), (unsigned)__builtin_amdgcn_readfirstlane(lds0 + ((ch) & 1) * BUFB + p_ * 1024)); } } while (0)
    IDX_DMA(0);
    f16x8 aq[4];
    { const int rho = c; const int qq = 2 * ((rho >> 2) & 1) + (rho >> 4), hd = 4 * ((rho >> 3) & 1) + (rho & 3);
      const f16* qp = (const f16*)(ws + WS_QI) + (rowbase + q0 + 4 * wid + qq) * 512 + hd * 64 + 8 * g;
#pragma unroll
      for (int kk = 0; kk < 4; ++kk) aq[kk] = *(const f16x8*)(qp + 16 * kk); }
    float wq[16];
    { const f32x4* wp = (const f32x4*)((const float*)(ws + WS_WI) + (rowbase + q0 + 4 * wid + 2 * g) * 8);
      const f32x4 a0 = wp[0], a1 = wp[1], a2 = wp[2], a3 = wp[3];
      wq[0] = a0[0]; wq[1] = a0[1]; wq[2] = a0[2]; wq[3] = a0[3]; wq[4] = a1[0]; wq[5] = a1[1]; wq[6] = a1[2]; wq[7] = a1[3];
      wq[8] = a2[0]; wq[9] = a2[1]; wq[10] = a2[2]; wq[11] = a2[3]; wq[12] = a3[0]; wq[13] = a3[1]; wq[14] = a3[2]; wq[15] = a3[3]; }
    const int ql0 = 4 * wid + 2 * g, ql1 = ql0 + 1;
    f32x2 kp0[32], kp1[32];
#pragma unroll
    for (int i = 0; i < 32; ++i) { kp0[i] = (f32x2){NINF, NINF}; kp1[i] = (f32x2){NINF, NINF}; }
    float mn0 = PINF, mx0 = IDX_AMAX ? 0.f : NINF, mn1 = PINF, mx1 = IDX_AMAX ? 0.f : NINF, cp0 = 0.f, cn0 = 0.f, cp1 = 0.f, cn1 = 0.f;
    const LAS char* bbase = (const LAS char*)shm + c * 128;
    const int sw = (c >> 1) & 7;
#pragma unroll
    for (int ch = 0; ch < 8; ++ch) if (ch < nchunks) {
        asm volatile("s_waitcnt vmcnt(0)\n\ts_barrier" ::: "memory");
        if (ch + 1 < nchunks) IDX_DMA(ch + 1);
#if IDX_PAIR
#pragma unroll
        for (int j = 0; j < 8; j += 2) { const int jt = ch * 8 + j;
            if (jt < ntiles) {
                const LAS char* bp = bbase + (ch & 1) * BUFB + j * 4096;
                f32x16 acc = f32x16{}, acd = f32x16{};
#pragma unroll
                for (int kk = 0; kk < 4; ++kk) { const f16x8 bk = *(const LAS f16x8*)(bp + (((2 * kk + g) ^ sw) * 16)), bl = *(const LAS f16x8*)(bp + 4096 + (((2 * kk + g) ^ sw) * 16));
                    acc = __builtin_amdgcn_mfma_f32_32x32x16_f16(aq[kk], bk, acc, 0, 0, 0); acd = __builtin_amdgcn_mfma_f32_32x32x16_f16(aq[kk], bl, acd, 0, 0, 0); }
#define IDX_RELU16(A) asm volatile("v_max_f32_e32 %0, 0, %0\n\tv_max_f32_e32 %1, 0, %1\n\tv_max_f32_e32 %2, 0, %2\n\tv_max_f32_e32 %3, 0, %3\n\tv_max_f32_e32 %4, 0, %4\n\tv_max_f32_e32 %5, 0, %5\n\tv_max_f32_e32 %6, 0, %6\n\tv_max_f32_e32 %7, 0, %7\n\t" \
                             "v_max_f32_e32 %8, 0, %8\n\tv_max_f32_e32 %9, 0, %9\n\tv_max_f32_e32 %10, 0, %10\n\tv_max_f32_e32 %11, 0, %11\n\tv_max_f32_e32 %12, 0, %12\n\tv_max_f32_e32 %13, 0, %13\n\tv_max_f32_e32 %14, 0, %14\n\tv_max_f32_e32 %15, 0, %15" \
                             : "+v"(A[0]), "+v"(A[1]), "+v"(A[2]), "+v"(A[3]), "+v"(A[4]), "+v"(A[5]), "+v"(A[6]), "+v"(A[7]), "+v"(A[8]), "+v"(A[9]), "+v"(A[10]), "+v"(A[11]), "+v"(A[12]), "+v"(A[13]), "+v"(A[14]), "+v"(A[15]))
                asm volatile("s_nop 15\n\ts_nop 3" : "+v"(acc), "+v"(acd));
                IDX_RELU16(acc); IDX_RELU16(acd);
#undef IDX_RELU16
#pragma unroll
                for (int h2 = 0; h2 < 2; ++h2) { const int jj = jt + h2; const f32x16& A = h2 ? acd : acc;
                    float s0 = 0.f, s1 = 0.f;
#pragma unroll
                    for (int r = 0; r < 8; ++r) { s0 = __builtin_fmaf(wq[r], A[r], s0); s1 = __builtin_fmaf(wq[8 + r], A[8 + r], s1); }
                    const bool inv0 = (jj > qt) || ((jj == qt) && (c > ql0)), inv1 = (jj > qt) || ((jj == qt) && (c > ql1));
                    kp0[jj >> 1][jj & 1] = inv0 ? NINF : s0; kp1[jj >> 1][jj & 1] = inv1 ? NINF : s1;
                    const float z0 = inv0 ? 0.f : s0, z1 = inv1 ? 0.f : s1;
#if IDX_AMAX
                    mx0 = amax_(mx0, z0); mx1 = amax_(mx1, z1);
#else
                    mx0 = fmax_(mx0, inv0 ? NINF : s0); mx1 = fmax_(mx1, inv1 ? NINF : s1); mn0 = fmin_(mn0, inv0 ? PINF : s0); mn1 = fmin_(mn1, inv1 ? PINF : s1);
#endif
                    cp0 += clampmul(z0, CNT_BIG); cn0 += clampmul(z0, -CNT_BIG); cp1 += clampmul(z1, CNT_BIG); cn1 += clampmul(z1, -CNT_BIG); }
            }
        }
    }
#else
#pragma unroll
        for (int j = 0; j < 8; ++j) { const int jt = ch * 8 + j;
            if (jt < ntiles) {
                const LAS char* bp = bbase + (ch & 1) * BUFB + j * 4096;
                f32x16 acc = f32x16{};
#pragma unroll
                for (int kk = 0; kk < 4; ++kk) { const f16x8 bk = *(const LAS f16x8*)(bp + (((2 * kk + g) ^ sw) * 16)); acc = __builtin_amdgcn_mfma_f32_32x32x16_f16(aq[kk], bk, acc, 0, 0, 0); }
                asm volatile("s_nop 15\n\ts_nop 3\n\tv_max_f32_e32 %0, 0, %0\n\tv_max_f32_e32 %1, 0, %1\n\tv_max_f32_e32 %2, 0, %2\n\tv_max_f32_e32 %3, 0, %3\n\tv_max_f32_e32 %4, 0, %4\n\tv_max_f32_e32 %5, 0, %5\n\tv_max_f32_e32 %6, 0, %6\n\tv_max_f32_e32 %7, 0, %7\n\t"
                             "v_max_f32_e32 %8, 0, %8\n\tv_max_f32_e32 %9, 0, %9\n\tv_max_f32_e32 %10, 0, %10\n\tv_max_f32_e32 %11, 0, %11\n\tv_max_f32_e32 %12, 0, %12\n\tv_max_f32_e32 %13, 0, %13\n\tv_max_f32_e32 %14, 0, %14\n\tv_max_f32_e32 %15, 0, %15"
                             : "+v"(acc[0]), "+v"(acc[1]), "+v"(acc[2]), "+v"(acc[3]), "+v"(acc[4]), "+v"(acc[5]), "+v"(acc[6]), "+v"(acc[7]),
                               "+v"(acc[8]), "+v"(acc[9]), "+v"(acc[10]), "+v"(acc[11]), "+v"(acc[12]), "+v"(acc[13]), "+v"(acc[14]), "+v"(acc[15]));
                float s0 = 0.f, s1 = 0.f;
#pragma unroll
                for (int r = 0; r < 8; ++r) { s0 = __builtin_fmaf(wq[r], acc[r], s0); s1 = __builtin_fmaf(wq[8 + r], acc[8 + r], s1); }
                const bool inv0 = (jt == qt) && (c > ql0), inv1 = (jt == qt) && (c > ql1);
                kp0[jt >> 1][jt & 1] = inv0 ? NINF : s0; kp1[jt >> 1][jt & 1] = inv1 ? NINF : s1;
                mx0 = fmax_(mx0, inv0 ? NINF : s0); mx1 = fmax_(mx1, inv1 ? NINF : s1); mn0 = fmin_(mn0, inv0 ? PINF : s0); mn1 = fmin_(mn1, inv1 ? PINF : s1);
                const float z0 = inv0 ? 0.f : s0, z1 = inv1 ? 0.f : s1;
                cp0 += clampmul(z0, CNT_BIG); cn0 += clampmul(z0, -CNT_BIG); cp1 += clampmul(z1, CNT_BIG); cn1 += clampmul(z1, -CNT_BIG);
            }
        }
    }
#endif
#undef IDX_DMA
    asm volatile("s_waitcnt lgkmcnt(0)\n\ts_barrier" ::: "memory");
#if DSA_PRE
    att::prefetch_kv((const f16*)(ws + WS_KA) + rowbase * 64, (const f16*)(ws + WS_VA) + rowbase * 64, 64, shm);
#if DSA_QWARM
    unsigned qwarm_;
    { const f16* qa_ = (const f16*)(ws + WS_QA) + (rowbase + q0 + c) * 512 + wid * 64 + g * 32;
      asm volatile("global_load_dword %0, %1, off" : "=v"(qwarm_) : "v"(qa_) : "memory"); }
#endif
#endif
    LAS unsigned* mk = (LAS unsigned*)((LAS char*)shm + att::LDS_AUX);
    LAS unsigned* mk0 = mk + ql0 * 2; LAS unsigned* mk1 = mk + ql1 * 2;
    if (qt < 8) {
#pragma unroll
        for (int jt = 0; jt < 64; ++jt) if (jt < 2 * NTA) {
            const unsigned m0 = jt < qt ? 0xFFFFFFFFu : (jt == qt ? (unsigned)((2ull << ql0) - 1ull) : 0u), m1 = jt < qt ? 0xFFFFFFFFu : (jt == qt ? (unsigned)((2ull << ql1) - 1ull) : 0u);
            mk0[(jt >> 1) * 64 + (jt & 1)] = m0; mk1[(jt >> 1) * 64 + (jt & 1)] = m1; }
    } else {
        const float KF = (float)TOPK, nv0 = (float)(q0 + ql0 + 1), nv1 = (float)(q0 + ql1 + 1);
        const float P0 = half_sumf(cp0), N0 = half_sumf(cn0), P1 = half_sumf(cp1), N1 = half_sumf(cn1);
#if IDX_AMAX
        const float X0 = half_max(mx0), M0 = -X0, X1 = half_max(mx1), M1 = -X1;
#else
        const float X0 = half_max(mx0), M0 = half_min(mn0), X1 = half_max(mx1), M1 = half_min(mn1);
#endif
        float lo0, hi0, lo1, hi1, th0 = 0.f, th1 = 0.f; int st0, st1;
        if (P0 == KF) { st0 = 1; lo0 = 0.f; hi0 = 0.f; } else if (P0 > KF) { st0 = 0; lo0 = 0.f; hi0 = X0; } else if (nv0 - N0 >= KF) { st0 = 2; lo0 = 0.f; hi0 = 0.f; } else { st0 = 0; lo0 = 2.f * M0; hi0 = 0.f; }
        if (P1 == KF) { st1 = 1; lo1 = 0.f; hi1 = 0.f; } else if (P1 > KF) { st1 = 0; lo1 = 0.f; hi1 = X1; } else if (nv1 - N1 >= KF) { st1 = 2; lo1 = 0.f; hi1 = 0.f; } else { st1 = 0; lo1 = 2.f * M1; hi1 = 0.f; }
        float mid0 = lo0 + 0.5f * (hi0 - lo0), mid1 = lo1 + 0.5f * (hi1 - lo1);
        f32x2 big2 = (f32x2){CNT_BIG, CNT_BIG}; asm volatile("" : "+v"(big2));
#if PROBE_DUP & 16384
#pragma unroll 1
        for (int rep3_ = 0; rep3_ < 2; ++rep3_) { if (rep3_) { asm volatile("" : "+v"(mid0), "+v"(mid1)); }
#endif
        for (int it = 0; it < 200; ++it) {
            if (!__any(st0 == 0 || st1 == 0)) break;
            f32x2 a0 = (f32x2){0.f, 0.f}, a1 = (f32x2){0.f, 0.f}; const float nb0 = -mid0 * CNT_BIG, nb1 = -mid1 * CNT_BIG; const f32x2 nb20 = (f32x2){nb0, nb0}, nb21 = (f32x2){nb1, nb1};
#pragma unroll
            for (int blk = 0; blk < 8; ++blk) if (blk * 8 < ntiles) { CNTP4(a0, nb20, kp0, blk * 4); CNTP4(a1, nb21, kp1, blk * 4); }
            const float c0 = half_sumf(a0[0] + a0[1]), c1 = half_sumf(a1[0] + a1[1]);
            { const bool act = st0 == 0, fnd = c0 == KF, gt = c0 > KF; const float nlo = gt ? mid0 : lo0, nhi = (gt || fnd) ? hi0 : mid0, nm = nlo + 0.5f * (nhi - nlo); const bool adj = !(nm > nlo && nm < nhi);
              if (act) { lo0 = nlo; hi0 = nhi; th0 = fnd ? mid0 : nhi; st0 = fnd ? 1 : (adj ? 2 : 0); mid0 = nm; } }
            { const bool act = st1 == 0, fnd = c1 == KF, gt = c1 > KF; const float nlo = gt ? mid1 : lo1, nhi = (gt || fnd) ? hi1 : mid1, nm = nlo + 0.5f * (nhi - nlo); const bool adj = !(nm > nlo && nm < nhi);
              if (act) { lo1 = nlo; hi1 = nhi; th1 = fnd ? mid1 : nhi; st1 = fnd ? 1 : (adj ? 2 : 0); mid1 = nm; } }
        }
#if PROBE_DUP & 16384
        }
#endif
        if (__any(st0 != 1 || st1 != 1)) {
            f32x2 n0 = (f32x2){0.f, 0.f}, n1 = (f32x2){0.f, 0.f}; const float nt0 = -th0 * CNT_BIG, nt1 = -th1 * CNT_BIG; const f32x2 nt20 = (f32x2){nt0, nt0}, nt21 = (f32x2){nt1, nt1};
#pragma unroll
            for (int blk = 0; blk < 8; ++blk) if (blk * 8 < ntiles) { CNTP4(n0, nt20, kp0, blk * 4); CNTP4(n1, nt21, kp1, blk * 4); }
            int need0 = TOPK - (int)half_sumf(n0[0] + n0[1]), need1 = TOPK - (int)half_sumf(n1[0] + n1[1]);
#pragma unroll
            for (int jt = 0; jt < 64; ++jt) if (jt < 2 * NTA) {
                unsigned m0 = 0u, m1 = 0u;
                if (jt < ntiles) {
                    const float x0 = kp0[jt >> 1][jt & 1], x1 = kp1[jt >> 1][jt & 1]; const u64 g0 = __ballot(x0 > th0), g1 = __ballot(x1 > th1), e0 = __ballot(x0 == th0 && st0 != 1), e1 = __ballot(x1 == th1 && st1 != 1);
                    unsigned gg0 = g ? (unsigned)(g0 >> 32) : (unsigned)g0, gg1 = g ? (unsigned)(g1 >> 32) : (unsigned)g1, ee0 = g ? (unsigned)(e0 >> 32) : (unsigned)e0, ee1 = g ? (unsigned)(e1 >> 32) : (unsigned)e1;
                    { const int ne = __popc(ee0), tk = need0 < ne ? (need0 > 0 ? need0 : 0) : ne; unsigned r = ee0; while (__popc(r) > tk) r &= ~(0x80000000u >> __clz(r)); need0 -= tk; m0 = gg0 | r; }
                    { const int ne = __popc(ee1), tk = need1 < ne ? (need1 > 0 ? need1 : 0) : ne; unsigned r = ee1; while (__popc(r) > tk) r &= ~(0x80000000u >> __clz(r)); need1 -= tk; m1 = gg1 | r; }
                }
                mk0[(jt >> 1) * 64 + (jt & 1)] = m0; mk1[(jt >> 1) * 64 + (jt & 1)] = m1;
            }
        } else {
#pragma unroll
            for (int jt = 0; jt < 64; ++jt) if (jt < 2 * NTA) {
                unsigned m0 = 0u, m1 = 0u;
                if (jt < ntiles) { const u64 g0 = __ballot(kp0[jt >> 1][jt & 1] > th0), g1 = __ballot(kp1[jt >> 1][jt & 1] > th1); m0 = g ? (unsigned)(g0 >> 32) : (unsigned)g0; m1 = g ? (unsigned)(g1 >> 32) : (unsigned)g1; }
                mk0[(jt >> 1) * 64 + (jt & 1)] = m0; mk1[(jt >> 1) * 64 + (jt & 1)] = m1;
            }
        }
    }
#if DSA_PRE
    asm volatile("s_waitcnt vmcnt(0) lgkmcnt(0)\n\ts_barrier" ::: "memory");
#if DSA_QWARM
    asm volatile("" : "+v"(qwarm_));
#endif
#else
    asm volatile("s_waitcnt lgkmcnt(0)\n\ts_barrier" ::: "memory");
#endif
}
#undef CNTP4
}
__device__ __forceinline__ void ph_dsa(const Params& P, char* shm, int vcu, int G) {
    unsigned char* ws = P.ws; const int wid = threadIdx.x >> 6;
    for (int it = vcu; it < NB * 8; it += G) {
        const int b = it >> 3, j = it & 7; const size_t rowbase = (size_t)b * S;
#pragma unroll 1
        for (int k = 0; k < 8; ++k) { const int qt = (k & 1) ? (16 * (k >> 1) + 15 - j) : (16 * (k >> 1) + j);
            const int nt = qt / 2 + 1, NT = nt < 4 ? 4 : nt + (nt & 1);
            idx::indexer_tile(P, shm, b, qt, NT);
#if PROBE_DUP & 256
#pragma unroll 1
            for (int rep_ = 0; rep_ < PROBE_REP; ++rep_) idx::indexer_tile(P, shm, b, qt, NT);
#endif
            const size_t tok = rowbase + qt * 32;
            att::attn_unit<1, 8, DSA_PRE != 0>((const f16*)(ws + WS_QA) + tok * 512 + wid * 64, (const f16*)(ws + WS_KA) + rowbase * 64, (const f16*)(ws + WS_VA) + rowbase * 64, 64, NT, 0, 0.f,
                                 U_A(ws) + tok * U_LD + wid * 64, (const f16*)(ws + WS_SGA) + tok * 512 + wid * 64, shm);
#if PROBE_DUP & 512
            att::attn_unit<1, 8>((const f16*)(ws + WS_QA) + tok * 512 + wid * 64, (const f16*)(ws + WS_KA) + rowbase * 64, (const f16*)(ws + WS_VA) + rowbase * 64, 64, NT, 0, 0.f,
                                 (f16*)(ws + WS_U) + tok * 1024 + wid * 64, (const f16*)(ws + WS_SGA) + tok * 512 + wid * 64, shm);
#endif
        }
    }
}
__global__ void __launch_bounds__(512, 2) k_dsa(Params P) { extern __shared__ __attribute__((aligned(16))) unsigned char lds[];
    const int G = gridDim.x, bx = blockIdx.x; ph_dsa(P, (char*)lds, (G % 8 == 0) ? (bx % 8) * (G / 8) + bx / 8 : bx, G); }

constexpr int ATT_LDS = att::LDS_BYTES;
__global__ void __launch_bounds__(512, 2) k_fox(Params P) { extern __shared__ __attribute__((aligned(16))) unsigned char lds[]; ph_fox(P, (char*)lds, blockIdx.x, gridDim.x); }
__global__ void __launch_bounds__(512, 2) k_dsa_attn(Params P) { extern __shared__ __attribute__((aligned(16))) unsigned char lds[];
    const int G = gridDim.x, bx = blockIdx.x; ph_dsa_attn(P, (char*)lds, (G % 8 == 0) ? (bx % 8) * (G / 8) + bx / 8 : bx, G); }

__device__ __forceinline__ float dot_h(const f16* a, const f16* b, int K) {
    float acc = 0.f;
    for (int k = 0; k < K; k += 8) { const f16x8 va = *(const f16x8*)(a + k), vb = *(const f16x8*)(b + k);
#pragma unroll
        for (int j = 0; j < 8; ++j) acc += (float)va[j] * (float)vb[j]; }
    return acc;
}
__global__ void __launch_bounds__(256) nv_gemm1(Params P) {
    unsigned char* ws = P.ws;
    const size_t idx = (size_t)blockIdx.x * 256 + threadIdx.x; if (idx >= (size_t)T * N1) return;
    const int t = (int)(idx / N1), n = (int)(idx % N1);
    const f16* h = (const f16*)(ws + WS_H16) + (size_t)t * D; const f16* W = (const f16*)(ws + WS_W1T);
    float v = dot_h(h, W + (size_t)n * D, D);
    const int pos = t & (S - 1);
    auto rope = [&](int d) -> float {
        const float v2 = dot_h(h, W + (size_t)(d < 8 ? n + 8 : n - 8) * D, D);
        const f32x2 cs = ((const f32x2*)(ws + WS_ROPE))[pos * 8 + (d & 7)];
        return d < 8 ? v * cs.x - v2 * cs.y : v * cs.x + v2 * cs.y; };
    if (n < P_QI) { const int d = n & 63; if (d < 16) v = rope(d); ((f16*)(ws + WS_QA))[(size_t)t * 512 + n] = (f16)(v * C2); return; }
    if (n < P_QB) { const int c = n - P_QI, d = c & 63; if (d < 16) v = rope(d); ((f16*)(ws + WS_QI))[(size_t)t * 512 + c] = (f16)v; return; }
    if (n < P_KB) { ((f16*)(ws + WS_QB))[(size_t)t * 512 + (n - P_QB)] = (f16)(v * C2); return; }
    if (n < P_VB) { ((f16*)(ws + WS_KB))[(size_t)t * 512 + (n - P_KB)] = (f16)v; return; }
    if (n < P_GA) { ((f16*)(ws + WS_VB))[(size_t)t * 512 + (n - P_VB)] = (f16)v; return; }
    if (n < P_GB) { ((f16*)(ws + WS_SGA))[(size_t)t * 512 + (n - P_GA)] = (f16)siluf_(v); return; }
    if (n < P_SM) { ((f16*)(ws + WS_SGB))[(size_t)t * 512 + (n - P_GB)] = (f16)siluf_(v); return; }
    if (n < P_MG) { const int c = n - P_SM;
        if (c < 64) { if (c < 16) v = rope(c); ((f16*)(ws + WS_KA))[(size_t)t * 64 + c] = (f16)v; }
        else if (c < 128) ((f16*)(ws + WS_VA))[(size_t)t * 64 + (c - 64)] = (f16)v;
        else if (c < 192) { const int d = c - 128; if (d < 16) v = rope(d); ((f16*)(ws + WS_KI))[(size_t)t * 64 + d] = (f16)v; }
        else if (c < 200) ((float*)(ws + WS_WI))[(size_t)t * 8 + (c - 192)] = v * IDX_SCALE;
        else if (c < 208) ((float*)(ws + WS_LOGF))[(size_t)t * 8 + (c - 200)] = logsigmoidf_(v + P.b_forget[c - 200]);
        return; }
    ((f16*)(ws + WS_MG))[(size_t)t * 2048 + (n - P_MG)] = (f16)sigmoidf_(v);
}
__global__ void nv_cumsum(Params P) {
    const int i = blockIdx.x * blockDim.x + threadIdx.x; if (i >= NB * 8) return;
    const int b = i >> 3, h = i & 7; const float* lf = (const float*)(P.ws + WS_LOGF); float* cs = (float*)(P.ws + WS_CSUM) + (size_t)i * S;
    float c = 0.f; for (int s = 0; s < S; ++s) { c += lf[((size_t)b * S + s) * 8 + h]; cs[s] = c * LOG2E; }
}
__global__ void __launch_bounds__(256) nv_fox(Params P) {
    unsigned char* ws = P.ws;
    const int idx = blockIdx.x * 256 + threadIdx.x; const int h = idx & 7, tok = idx >> 3, b = tok / S, t = tok % S;
    float q[64], o[64];
    { const f16* qp = (const f16*)(ws + WS_QB) + (size_t)tok * 512 + h * 64;
#pragma unroll
      for (int d = 0; d < 64; ++d) { q[d] = (float)qp[d]; o[d] = 0.f; } }
    const float* cs = (const float*)(ws + WS_CSUM) + (size_t)(b * 8 + h) * S; const float ct = cs[t];
    float m = -1e30f, l = 0.f;
    for (int s = 0; s <= t; ++s) {
        const f16* kp = (const f16*)(ws + WS_KB) + ((size_t)b * S + s) * 512 + h * 64; const f16* vp = (const f16*)(ws + WS_VB) + ((size_t)b * S + s) * 512 + h * 64;
        float d0 = 0.f;
#pragma unroll
        for (int d = 0; d < 64; ++d) d0 += q[d] * (float)kp[d];
        const float lg = d0 + (ct - cs[s]); const float mn = fmaxf(m, lg), f = exp2f(m - mn), pe = exp2f(lg - mn);
        l = l * f + pe; m = mn;
#pragma unroll
        for (int d = 0; d < 64; ++d) o[d] = o[d] * f + pe * (float)vp[d];
    }
    const float il = 1.f / l; const f16* sg = (const f16*)(ws + WS_SGB) + (size_t)tok * 512 + h * 64; f16* u = (f16*)(ws + WS_U) + (size_t)tok * 1024 + 512 + h * 64;
#pragma unroll
    for (int d = 0; d < 64; ++d) u[d] = (f16)(o[d] * il * (float)sg[d]);
}
__device__ __forceinline__ size_t mask_word(int b, int t, int s, int& bit) {
    bit = s & 63; return ((((size_t)b * 64 + (t >> 5)) * 32 + (s >> 6)) * 32 + (t & 31));
}
__global__ void __launch_bounds__(256) nv_indexer(Params P) {
    unsigned char* ws = P.ws;
    __shared__ f16 sq[512]; __shared__ float sw[8]; __shared__ unsigned skey[S]; __shared__ unsigned char sflag[S]; __shared__ unsigned scnt;
    const int tok = blockIdx.x, b = tok / S, t = tok % S, tid = threadIdx.x;
    if (tid < 64) ((f16x8*)sq)[tid] = ((const f16x8*)((const f16*)(ws + WS_QI) + (size_t)tok * 512))[tid];
    if (tid < 8) sw[tid] = ((const float*)(ws + WS_WI))[(size_t)tok * 8 + tid];
    __syncthreads();
    unsigned key[8];
#pragma unroll
    for (int i = 0; i < 8; ++i) { const int s = tid + 256 * i; key[i] = 0u; sflag[s] = 0;
        if (s <= t) { const f16* kp = (const f16*)(ws + WS_KI) + ((size_t)b * S + s) * 64; float sc = 0.f;
            for (int h = 0; h < 8; ++h) { float d0 = 0.f;
#pragma unroll
                for (int d = 0; d < 64; ++d) d0 += (float)sq[h * 64 + d] * (float)kp[d];
                sc += sw[h] * fmaxf(d0, 0.f); }
            key[i] = sortkey(sc); }
        skey[s] = key[i]; }
    auto count_gt = [&](unsigned x) -> unsigned { int c = 0;
#pragma unroll
        for (int i = 0; i < 8; ++i) c += (key[i] > x) ? 1 : 0;
        __syncthreads(); if (tid == 0) scnt = 0u; __syncthreads(); atomicAdd(&scnt, (unsigned)c); __syncthreads(); return scnt; };
    bool sel[8];
    if (t + 1 <= TOPK) {
#pragma unroll
        for (int i = 0; i < 8; ++i) sel[i] = (tid + 256 * i) <= t;
    } else {
        unsigned lo = 0u, hi = 0xFFFFFFFFu, thr = 0u; bool found = false;
        while (hi - lo > 1u) { const unsigned mid = lo + (hi - lo) / 2u; const unsigned c = count_gt(mid);
            if (c == (unsigned)TOPK) { thr = mid; found = true; break; } else if (c > (unsigned)TOPK) lo = mid; else hi = mid; }
        if (found) {
#pragma unroll
            for (int i = 0; i < 8; ++i) sel[i] = key[i] > thr;
        } else {
            const unsigned cg = count_gt(hi); int need = TOPK - (int)cg;
            if (tid == 0) { for (int s = 0; s <= t && need > 0; ++s) if (skey[s] == hi) { sflag[s] = 1; --need; } }
            __syncthreads();
#pragma unroll
            for (int i = 0; i < 8; ++i) sel[i] = key[i] > hi || (key[i] == hi && sflag[tid + 256 * i]);
        }
    }
#pragma unroll
    for (int i = 0; i < 8; ++i) if (sel[i]) { int bit; const size_t w = mask_word(b, t, tid + 256 * i, bit); atomicOr((u64*)(ws + WS_MASK) + w, 1ull << bit); }
}
__global__ void __launch_bounds__(256) nv_dsa(Params P) {
    unsigned char* ws = P.ws;
    const int idx = blockIdx.x * 256 + threadIdx.x; const int h = idx & 7, tok = idx >> 3, b = tok / S, t = tok % S;
    float q[64], o[64];
    { const f16* qp = (const f16*)(ws + WS_QA) + (size_t)tok * 512 + h * 64;
#pragma unroll
      for (int d = 0; d < 64; ++d) { q[d] = (float)qp[d]; o[d] = 0.f; } }
    float m = -1e30f, l = 0.f;
    for (int s = 0; s <= t; ++s) {
        int bit; const size_t w = mask_word(b, t, s, bit); if (!((((const u64*)(ws + WS_MASK))[w] >> bit) & 1ull)) continue;
        const f16* kp = (const f16*)(ws + WS_KA) + ((size_t)b * S + s) * 64; const f16* vp = (const f16*)(ws + WS_VA) + ((size_t)b * S + s) * 64;
        float d0 = 0.f;
#pragma unroll
        for (int d = 0; d < 64; ++d) d0 += q[d] * (float)kp[d];
        const float mn = fmaxf(m, d0), f = exp2f(m - mn), pe = exp2f(d0 - mn);
        l = l * f + pe; m = mn;
#pragma unroll
        for (int d = 0; d < 64; ++d) o[d] = o[d] * f + pe * (float)vp[d];
    }
    const float il = 1.f / l; const f16* sg = (const f16*)(ws + WS_SGA) + (size_t)tok * 512 + h * 64; f16* u = (f16*)(ws + WS_U) + (size_t)tok * 1024 + h * 64;
#pragma unroll
    for (int d = 0; d < 64; ++d) u[d] = (f16)(o[d] * il * (float)sg[d]);
}
__global__ void __launch_bounds__(256) nv_merged(Params P) {
    unsigned char* ws = P.ws; const size_t idx = (size_t)blockIdx.x * 256 + threadIdx.x; const int t = (int)(idx >> 10), n = (int)(idx & 1023);
    const f16* u = (const f16*)(ws + WS_U) + (size_t)t * 1024;
    const float ya = dot_h(u, (const f16*)(ws + WS_WBA) + (size_t)n * 512, 512), yb = dot_h(u + 512, (const f16*)(ws + WS_WBB) + (size_t)n * 512, 512);
    const f16* mg = (const f16*)(ws + WS_MG) + (size_t)t * 2048;
    ((f16*)(ws + WS_MERGED))[idx] = (f16)((float)mg[n] * ya + (float)mg[1024 + n] * yb);
}
__global__ void __launch_bounds__(256) nv_out(Params P) {
    unsigned char* ws = P.ws; const size_t idx = (size_t)blockIdx.x * 256 + threadIdx.x; const int t = (int)(idx >> 10), n = (int)(idx & 1023);
    const float v = dot_h((const f16*)(ws + WS_MERGED) + (size_t)t * 1024, (const f16*)(ws + WS_WO) + (size_t)n * 1024, 1024);
    ((f16*)(ws + WS_OUT16))[idx] = (f16)v; atomicAdd((float*)(ws + WS_ROWSQ) + t, v * v);
}
#if EW_LIFO
#define EW_LOOP(i, gt, GT, n8) const bool xc_ = ((GT) == (size_t)131072); const size_t gb_ = ((gt) >> 9), ib_ = ((gb_ & 7) * 8192 + (gb_ >> 3) * 4) * 128 + ((gt) & 511); \
    for (size_t k_ = xc_ ? 64 : ((n8) - (gt) + (GT) - 1) / (GT), i = 0; k_-- > 0 && ((i = xc_ ? ib_ + k_ * 16384 : (gt) + k_ * (GT)), true); )
#else
#define EW_LOOP(i, gt, GT, n8) for (size_t i = (gt); i < (n8); i += (GT))
#endif
__device__ __forceinline__ void ew_x1(const Params& P, size_t gt, size_t GT) {
    unsigned char* ws = P.ws; const size_t n8 = (size_t)T * D / 8;
#if XREC
    const int c8 = (int)(gt & 127); const float* xsc = (const float*)(ws + WS_ROWSQ) + 3 * T;
    const f32x4 ga = ((const f32x4*)P.g_post)[2 * c8], gb = ((const f32x4*)P.g_post)[2 * c8 + 1], pa = ((const f32x4*)P.g_pre)[2 * c8], pb = ((const f32x4*)P.g_pre)[2 * c8 + 1];
    const f32x4 ia = (f32x4){1.f / pa.x, 1.f / pa.y, 1.f / pa.z, 1.f / pa.w}, ib = (f32x4){1.f / pb.x, 1.f / pb.y, 1.f / pb.z, 1.f / pb.w};
    EW_LOOP(i, gt, GT, n8) { const int t = (int)(i >> 7);
        const float rstd = rsqrtf(((const float*)(ws + WS_ROWSQ))[t] * (1.f / D) + EPS), isc = xsc[t];
        const f16x8 o = ((const f16x8*)(ws + WS_OUT16))[i]; const f16x8 hv = __builtin_nontemporal_load((const f16x8*)(ws + WS_H16) + i);
        f16x8 r; r[0] = (f16)((float)hv[0] * (isc * ia.x) + (float)o[0] * rstd * ga.x); r[1] = (f16)((float)hv[1] * (isc * ia.y) + (float)o[1] * rstd * ga.y);
        r[2] = (f16)((float)hv[2] * (isc * ia.z) + (float)o[2] * rstd * ga.z); r[3] = (f16)((float)hv[3] * (isc * ia.w) + (float)o[3] * rstd * ga.w);
        r[4] = (f16)((float)hv[4] * (isc * ib.x) + (float)o[4] * rstd * gb.x); r[5] = (f16)((float)hv[5] * (isc * ib.y) + (float)o[5] * rstd * gb.y);
        r[6] = (f16)((float)hv[6] * (isc * ib.z) + (float)o[6] * rstd * gb.z); r[7] = (f16)((float)hv[7] * (isc * ib.w) + (float)o[7] * rstd * gb.w);
        ((f16x8*)(ws + WS_X116))[i] = r; }
#else
    EW_LOOP(i, gt, GT, n8) { const int t = (int)(i >> 7), c8 = (int)(i & 127);
        const float rstd = rsqrtf(((const float*)(ws + WS_ROWSQ))[t] * (1.f / D) + EPS);
        const f16x8 o = ((const f16x8*)(ws + WS_OUT16))[i]; const f32x4 xa = __builtin_nontemporal_load((const f32x4*)P.x + 2 * i), xb = __builtin_nontemporal_load((const f32x4*)P.x + 2 * i + 1);
        const f32x4 ga = ((const f32x4*)P.g_post)[2 * c8], gb = ((const f32x4*)P.g_post)[2 * c8 + 1];
        f16x8 r; r[0] = (f16)(xa.x + (float)o[0] * rstd * ga.x); r[1] = (f16)(xa.y + (float)o[1] * rstd * ga.y); r[2] = (f16)(xa.z + (float)o[2] * rstd * ga.z); r[3] = (f16)(xa.w + (float)o[3] * rstd * ga.w);
        r[4] = (f16)(xb.x + (float)o[4] * rstd * gb.x); r[5] = (f16)(xb.y + (float)o[5] * rstd * gb.y); r[6] = (f16)(xb.z + (float)o[6] * rstd * gb.z); r[7] = (f16)(xb.w + (float)o[7] * rstd * gb.w);
        ((f16x8*)(ws + WS_X116))[i] = r; }
#endif
}
__global__ void __launch_bounds__(256) k_x1(Params P) { ew_x1(P, (size_t)blockIdx.x * 256 + threadIdx.x, (size_t)gridDim.x * 256); }
__global__ void __launch_bounds__(256) nv_gate(Params P) {
    unsigned char* ws = P.ws; const size_t idx = (size_t)blockIdx.x * 256 + threadIdx.x; const int t = (int)(idx >> 10), n = (int)(idx & 1023);
    const float gz = dot_h((const f16*)(ws + WS_X116) + (size_t)t * 1024, (const f16*)(ws + WS_WPG) + (size_t)n * 1024, 1024);
    const float e = dot_h((const f16*)(ws + WS_P16) + (size_t)t * DPLE, (const f16*)(ws + WS_WPLE) + (size_t)n * DPLE, DPLE);
    const float v = sigmoidf_(gz) * e; ((f16*)(ws + WS_V16))[idx] = (f16)v; atomicAdd((float*)(ws + WS_ROWSQ) + T + t, v * v);
}
__device__ __forceinline__ void ew_final(const Params& P, size_t gt, size_t GT) {
    unsigned char* ws = P.ws; const size_t n8 = (size_t)T * D / 8;
    EW_LOOP(i, gt, GT, n8) { const int t = (int)(i >> 7), c8 = (int)(i & 127);
        const float r2 = rsqrtf(((const float*)(ws + WS_ROWSQ))[T + t] * (1.f / D) + EPS);
        const f16x8 x1 = ((const f16x8*)(ws + WS_X116))[i], v = ((const f16x8*)(ws + WS_V16))[i];
        const f32x4 ha = ((const f32x4*)P.g_ple)[2 * c8], hb = ((const f32x4*)P.g_ple)[2 * c8 + 1];
        f32x4 ya, yb;
        ya.x = (float)x1[0] + (float)v[0] * r2 * ha.x; ya.y = (float)x1[1] + (float)v[1] * r2 * ha.y; ya.z = (float)x1[2] + (float)v[2] * r2 * ha.z; ya.w = (float)x1[3] + (float)v[3] * r2 * ha.w;
        yb.x = (float)x1[4] + (float)v[4] * r2 * hb.x; yb.y = (float)x1[5] + (float)v[5] * r2 * hb.y; yb.z = (float)x1[6] + (float)v[6] * r2 * hb.z; yb.w = (float)x1[7] + (float)v[7] * r2 * hb.w;
        __builtin_nontemporal_store(ya, (f32x4*)P.out + 2 * i); __builtin_nontemporal_store(yb, (f32x4*)P.out + 2 * i + 1); }
}
__global__ void __launch_bounds__(256) k_final(Params P) { ew_final(P, (size_t)blockIdx.x * 256 + threadIdx.x, (size_t)gridDim.x * 256); }


#define XB_TMO      128
#define XB_XCNT(j)  (256  + 64 * (j))
#define XB_XSUB(j)  (1280 + 64 * (j))
#define XB_XGEN(j)  (2304 + 64 * (j))
#define XB_TOP      3328
#define XB_TOPGEN   3392
#define XCD_BAR_WORDS 3456
#define XB_SPIN_CAP (1u << 22)
__device__ __forceinline__ unsigned xb_ld(unsigned* p)              { return __hip_atomic_load(p, __ATOMIC_RELAXED, __HIP_MEMORY_SCOPE_AGENT); }
__device__ __forceinline__ unsigned xb_add(unsigned* p, unsigned v) { return __hip_atomic_fetch_add(p, v, __ATOMIC_RELAXED, __HIP_MEMORY_SCOPE_AGENT); }
__device__ __forceinline__ unsigned xb_xcc_id() { return (unsigned)__builtin_amdgcn_s_getreg((3 << 11) | 20) & 0xFu; }
#define XB_SPIN(cond, bar) do { unsigned _sp = 0; while (cond) { __builtin_amdgcn_s_sleep(1); \
    if ((++_sp & 255u) == 0u) { if (xb_ld(&(bar)[XB_TMO])) break; if (_sp > XB_SPIN_CAP) { atomicAdd(&(bar)[XB_TMO], 1u); break; } } } } while (0)
struct XcdBarrier { unsigned* bar; unsigned x; volatile LAS unsigned* st; };
__device__ __forceinline__ XcdBarrier xcd_barrier_post(unsigned* bar, volatile LAS unsigned* st) {
    XcdBarrier b; b.bar = bar; b.x = xb_xcc_id(); b.st = st;
    if (threadIdx.x == 0) (void)xb_add(&bar[XB_XCNT(b.x)], 1u);
    return b;
}
__device__ __forceinline__ void xcd_barrier_complete(unsigned* bar, unsigned x, unsigned& nloc, unsigned& nx) {
    const unsigned G = gridDim.x * gridDim.y * gridDim.z;
    unsigned sum, cnt, mine, sp = 0u;
    for (;;) {
        sum = 0u; cnt = 0u; mine = 0u;
#pragma unroll
        for (unsigned j = 0; j < 16; ++j) { const unsigned c = xb_ld(&bar[XB_XCNT(j)]); sum += c; cnt += (c > 0u) ? 1u : 0u; mine = (j == x) ? c : mine; }
        if (sum == G) break;
        __builtin_amdgcn_s_sleep(1);
        if ((++sp & 255u) == 0u) { if (xb_ld(&bar[XB_TMO])) break; if (sp > XB_SPIN_CAP) { atomicAdd(&bar[XB_TMO], 1u); break; } }
    }
    nloc = mine > 0u ? mine : 1u; nx = cnt > 0u ? cnt : 1u;
}
__device__ __forceinline__ void xcd_barrier(const XcdBarrier& b) {
    asm volatile("s_waitcnt vmcnt(0)" ::: "memory");
    __syncthreads();
    if (threadIdx.x == 0) {
        unsigned* bar = b.bar;
        __builtin_amdgcn_s_waitcnt(0);
        unsigned nloc = b.st[0], nx = b.st[1];
        if (nloc == 0u) { xcd_barrier_complete(bar, b.x, nloc, nx); b.st[0] = nloc; b.st[1] = nx; }
        const unsigned old = xb_add(&bar[XB_XSUB(b.x)], 1u);
        const unsigned gen = old / nloc;
        if (old + 1u == (gen + 1u) * nloc) {
            __builtin_amdgcn_fence(__ATOMIC_RELEASE, "agent");
            asm volatile("s_waitcnt vmcnt(0)" ::: "memory");
            const unsigned og = xb_add(&bar[XB_TOP], 1u);
            const unsigned tg = og / nx;
            if (og + 1u == (tg + 1u) * nx) xb_add(&bar[XB_TOPGEN], 1u);
            else XB_SPIN(xb_ld(&bar[XB_TOPGEN]) == tg, bar);
            __builtin_amdgcn_fence(__ATOMIC_ACQUIRE, "agent");
            xb_add(&bar[XB_XGEN(b.x)], 1u);
            asm volatile("s_waitcnt vmcnt(0)" ::: "memory");
        } else {
            XB_SPIN(xb_ld(&bar[XB_XGEN(b.x)]) == gen, bar);
            __builtin_amdgcn_fence(__ATOMIC_ACQUIRE, "agent");
            asm volatile("s_waitcnt vmcnt(0)" ::: "memory");
        }
    }
    __syncthreads();
}
constexpr int MISC_OFF = 131072 + 320;
constexpr size_t CTL_ZERO_BYTES = 65536;

namespace cg = cooperative_groups;
#ifndef STAGGER_TICKS
#define STAGGER_TICKS 350
#endif
__device__ __forceinline__ void stagger_xcd(int bx, int ticks) {
    const unsigned long long t0 = __builtin_amdgcn_s_memrealtime(), want = (unsigned long long)(((bx >> 6) & 3) * ticks);
    while (__builtin_amdgcn_s_memrealtime() - t0 < want) __builtin_amdgcn_s_sleep(8);
    __syncthreads();
}
__global__ void __launch_bounds__(512, 2) k_mega(Params P) {
    extern __shared__ __attribute__((aligned(16))) unsigned char lds[];
    cg::grid_group grid = cg::this_grid();
    const int G = gridDim.x, bx = blockIdx.x; const int vcu = (G % 8 == 0) ? (bx % 8) * (G / 8) + bx / 8 : bx;
    volatile LAS unsigned* MISC = (volatile LAS unsigned*)((LAS unsigned char*)lds + MISC_OFF);
    if (threadIdx.x < 32) MISC[threadIdx.x] = 0u;
    __syncthreads();
    const XcdBarrier xbar = xcd_barrier_post((unsigned*)(P.ws + WS_CTL) + 4096, MISC + 8);
#define SEAM() xcd_barrier(xbar)
    p0_prologue(P, (LAS unsigned char*)lds, bx, G);
#if PROBE_DUP & 1
#pragma unroll 1
    for (int rep_ = 0; rep_ < PROBE_REP; ++rep_) { __syncthreads(); p0_prologue(P, (LAS unsigned char*)lds, bx, G); }
#endif
    grid.sync();
    { pg8::Gemm g{(const f16*)(P.ws + WS_H16), (const f16*)(P.ws + WS_W1T), D, D, D}; pg8::StaticOrder So; So.init(T, N1, G, bx, G1_WGM); EpiG1 E{P.ws, P.b_forget};
      pg8::gemm_phase<EpiG1>((LAS unsigned char*)lds, g, So, E);
#if PROBE_DUP & 2
#pragma unroll 1
      for (int rep_ = 0; rep_ < PROBE_REP; ++rep_) pg8::gemm_phase<EpiG1>((LAS unsigned char*)lds, g, So, E);
#endif
#if PROBE_DUP & 4096
      { EpiNull En{(float*)(P.ws + WS_ROWSQ) + 2 * T}; pg8::gemm_phase<EpiNull>((LAS unsigned char*)lds, g, So, En); }
#endif
#if PROBE_DUP & 8192
      { EpiNull En{(float*)(P.ws + WS_ROWSQ) + 2 * T}; pg8::StaticOrder Sh = So; Sh.hot = true; pg8::gemm_phase<EpiNull>((LAS unsigned char*)lds, g, Sh, En); }
#endif
    }
    SEAM();
    ph_fox(P, (char*)lds, vcu, G);
#if PROBE_DUP & 4
#pragma unroll 1
    for (int rep_ = 0; rep_ < PROBE_REP; ++rep_) ph_fox(P, (char*)lds, vcu, G);
#endif
    ph_dsa(P, (char*)lds, vcu, G);
#if PROBE_DUP & 8
#pragma unroll 1
    for (int rep_ = 0; rep_ < PROBE_REP; ++rep_) ph_dsa(P, (char*)lds, vcu, G);
#endif
    SEAM();
    ph_merged(P, (LAS unsigned char*)lds, G, bx);
#if PROBE_DUP & 16
#pragma unroll 1
    for (int rep_ = 0; rep_ < PROBE_REP; ++rep_) ph_merged(P, (LAS unsigned char*)lds, G, bx);
#endif
    SEAM();
    ph_out(P, (LAS unsigned char*)lds, G, bx);
#if PROBE_DUP & 32
    ph_out(P, (LAS unsigned char*)lds, G, bx, 2 * T);
#endif
    SEAM();
    ew_x1(P, (size_t)bx * 512 + threadIdx.x, (size_t)G * 512);
#if PROBE_DUP & 128
#pragma unroll 1
    for (int rep_ = 0; rep_ < PROBE_REP; ++rep_) ew_x1(P, (size_t)bx * 512 + threadIdx.x, (size_t)G * 512);
#endif
    SEAM();
    ph_gate(P, (LAS unsigned char*)lds, G, bx);
#if PROBE_DUP & 64
    ph_gate(P, (LAS unsigned char*)lds, G, bx, 3 * T);
#endif
    SEAM();
    ew_final(P, (size_t)bx * 512 + threadIdx.x, (size_t)G * 512);
#if PROBE_DUP & 64
#pragma unroll 1
    for (int rep_ = 0; rep_ < PROBE_REP; ++rep_) ew_final(P, (size_t)bx * 512 + threadIdx.x, (size_t)G * 512);
#endif
}

extern "C" void kernel_launch(void* const* d_in, const int* in_sizes, int n_in, void* d_out, int out_size, void* d_ws, size_t ws_size, hipStream_t stream) {
    if (n_in != 13 || in_sizes[0] != T * D || out_size != T * D || ws_size < WS_END) { fprintf(stderr, "kernel_launch: unexpected shapes / workspace (n_in %d, ws %zu < %zu)\n", n_in, ws_size, (size_t)WS_END); return; }
    Params P{};
    P.x = (const float*)d_in[0]; P.p = (const float*)d_in[1]; P.w_in = (const float*)d_in[2]; P.b_forget = (const float*)d_in[3]; P.w_ba = (const float*)d_in[4]; P.w_bb = (const float*)d_in[5];
    P.w_merge = (const float*)d_in[6]; P.w_out = (const float*)d_in[7]; P.g_pre = (const float*)d_in[8]; P.g_post = (const float*)d_in[9]; P.w_ple = (const float*)d_in[10]; P.w_pg = (const float*)d_in[11]; P.g_ple = (const float*)d_in[12];
    P.out = (float*)d_out; P.ws = (unsigned char*)d_ws;
#if USE_MEGA
    static int grid_blocks = 0;
    if (!grid_blocks) {
        int dev = 0, cus = 0, per_cu = 0;
        (void)hipGetDevice(&dev); (void)hipDeviceGetAttribute(&cus, hipDeviceAttributeMultiprocessorCount, dev);
        if (hipFuncSetAttribute((const void*)k_mega, hipFuncAttributeMaxDynamicSharedMemorySize, GEMM_LDS) != hipSuccess) { fprintf(stderr, "kernel_launch: hipFuncSetAttribute failed\n"); grid_blocks = -1; return; }
        if (hipOccupancyMaxActiveBlocksPerMultiprocessor(&per_cu, (const void*)k_mega, 512, GEMM_LDS) != hipSuccess || per_cu < 1) { fprintf(stderr, "kernel_launch: occupancy query failed (%d)\n", per_cu); grid_blocks = -1; return; }
        grid_blocks = cus * per_cu;
    }
    if (grid_blocks < 0) return;
    (void)hipMemsetAsync((char*)d_ws + WS_CTL, 0, CTL_ZERO_BYTES, stream);
    void* args[] = {&P};
    const hipError_t e = hipLaunchCooperativeKernel((const void*)k_mega, dim3(grid_blocks), dim3(512), args, GEMM_LDS, stream);
    if (e != hipSuccess) fprintf(stderr, "cooperative launch failed: %s (grid %d)\n", hipGetErrorString(e), grid_blocks);
#else
    static bool attr = false;
    if (!attr) { (void)hipFuncSetAttribute((const void*)k_p0, hipFuncAttributeMaxDynamicSharedMemorySize, 8 * 8704); (void)hipFuncSetAttribute((const void*)k_gemm1, hipFuncAttributeMaxDynamicSharedMemorySize, GEMM_LDS);
        (void)hipFuncSetAttribute((const void*)k_merged, hipFuncAttributeMaxDynamicSharedMemorySize, GEMM_LDS); (void)hipFuncSetAttribute((const void*)k_out, hipFuncAttributeMaxDynamicSharedMemorySize, GEMM_LDS); (void)hipFuncSetAttribute((const void*)k_gate, hipFuncAttributeMaxDynamicSharedMemorySize, GEMM_LDS);
        (void)hipFuncSetAttribute((const void*)k_fox, hipFuncAttributeMaxDynamicSharedMemorySize, ATT_LDS); (void)hipFuncSetAttribute((const void*)k_dsa_attn, hipFuncAttributeMaxDynamicSharedMemorySize, ATT_LDS); (void)hipFuncSetAttribute((const void*)k_dsa, hipFuncAttributeMaxDynamicSharedMemorySize, ATT_LDS); attr = true; }
    hipLaunchKernelGGL(k_p0, dim3(256), dim3(512), 8 * 8704, stream, P);
#if USE_NV_GEMM1
    hipLaunchKernelGGL(nv_gemm1, dim3((unsigned)(((size_t)T * N1 + 255) / 256)), dim3(256), 0, stream, P);
#else
    hipLaunchKernelGGL(k_gemm1, dim3(256), dim3(512), GEMM_LDS, stream, P);
#endif
#if USE_NV_FOX
    hipLaunchKernelGGL(nv_cumsum, dim3(1), dim3(256), 0, stream, P);
    hipLaunchKernelGGL(nv_fox, dim3(T * 8 / 256), dim3(256), 0, stream, P);
#else
    hipLaunchKernelGGL(k_fox, dim3(256), dim3(512), ATT_LDS, stream, P);
#endif
#if USE_NV_IDX
    hipLaunchKernelGGL(nv_indexer, dim3(T), dim3(256), 0, stream, P);
#if USE_NV_DSA
    hipLaunchKernelGGL(nv_dsa, dim3(T * 8 / 256), dim3(256), 0, stream, P);
#else
    hipLaunchKernelGGL(k_dsa_attn, dim3(256), dim3(512), ATT_LDS, stream, P);
#endif
#else
    hipLaunchKernelGGL(k_dsa, dim3(256), dim3(512), ATT_LDS, stream, P);
#endif
#if USE_NV_POST
    hipLaunchKernelGGL(nv_merged, dim3(T * 1024 / 256), dim3(256), 0, stream, P);
    hipLaunchKernelGGL(nv_out, dim3(T * 1024 / 256), dim3(256), 0, stream, P);
#else
    hipLaunchKernelGGL(k_merged, dim3(256), dim3(512), GEMM_LDS, stream, P);
    hipLaunchKernelGGL(k_out, dim3(256), dim3(512), GEMM_LDS, stream, P);
#endif
    hipLaunchKernelGGL(k_x1, dim3(2048), dim3(256), 0, stream, P);
#if USE_NV_POST
    hipLaunchKernelGGL(nv_gate, dim3(T * 1024 / 256), dim3(256), 0, stream, P);
#else
    hipLaunchKernelGGL(k_gate, dim3(256), dim3(512), GEMM_LDS, stream, P);
#endif
    hipLaunchKernelGGL(k_final, dim3(2048), dim3(256), 0, stream, P);
#endif
}
```
